# Optimizing an MI355X kernel written in HIP

```python
import jax, jax.numpy as jnp
from jax import lax
import numpy as np

D_MODEL = 1024
BATCH = 8
SEQ = 2048
DEPTH = 1

CHUNK = 64
N_META = 16
CONV_WIDTH = D_MODEL // 2
CONV_K = 3
SB_HEADS = 8
SB_HEAD_DIM = 64
SB_WIDTH = SB_HEADS * SB_HEAD_DIM
Q_BLOCK = 128
PEER_HEADS = 8
PEER_N_KEYS = 128
PEER_N_EXPERTS = PEER_N_KEYS * PEER_N_KEYS
PEER_TOPK = 16
PEER_KEY_DIM = 256
PEER_HALF = PEER_KEY_DIM // 2
PEER_TOKEN_BLOCK = 128
IN_WIDTH = 3 * CONV_WIDTH + 3 * SB_WIDTH + 2 * D_MODEL
EPS = 1e-6

kernel_name = "hybrid_conv_stickbreak_peer_block"


def rmsnorm(x, g):
    xf = x.astype(jnp.float32)
    y = xf * lax.rsqrt(jnp.mean(xf * xf, axis=-1, keepdims=True) + EPS)
    return (y * g.astype(jnp.float32)).astype(x.dtype)


def causal_dwconv(u, w):
    k_width = w.shape[0]
    seq_len = u.shape[1]
    up = jnp.pad(u, ((0, 0), (k_width - 1, 0), (0, 0)))
    y = up[:, 0:seq_len] * w[0]
    for k in range(1, k_width):
        y = y + up[:, k:k + seq_len] * w[k]
    return y


def stick_breaking_attention(q, k, v):
    seq_len = q.shape[2]
    scale = q.shape[-1] ** -0.5
    outs = []
    for start in range(0, seq_len, Q_BLOCK):
        end = min(start + Q_BLOCK, seq_len)
        qb = q[:, :, start:end]
        kb = k[:, :, :end]
        vb = v[:, :, :end]
        z = jnp.einsum('bhqd,bhkd->bhqk', qb, kb).astype(jnp.float32) * scale
        t_pos = jnp.arange(start, end)[:, None]
        s_pos = jnp.arange(end)[None, :]
        past = s_pos < t_pos
        log_one_minus = jnp.where(past, jax.nn.log_sigmoid(-z), 0.0)
        suffix = lax.cumsum(log_one_minus, axis=3, reverse=True) - log_one_minus
        a = jnp.where(past, jnp.exp(jax.nn.log_sigmoid(z) + suffix), 0.0)
        outs.append(jnp.einsum('bhqk,bhkd->bhqd', a.astype(vb.dtype), vb))
    return jnp.concatenate(outs, axis=2)


def peer_layer(h, w_q, subkeys, u_tab, v_tab):
    bsz, seq_len, d = h.shape
    q = (h @ w_q).reshape(bsz, seq_len, PEER_HEADS, 2, PEER_HALF)
    s = jnp.einsum('blhpd,hpkd->blhpk', q, subkeys).astype(jnp.float32)
    s_top, i_top = lax.top_k(s, PEER_TOPK)
    cand = (s_top[..., 0, :, None] + s_top[..., 1, None, :]).reshape(
        bsz, seq_len, PEER_HEADS, PEER_TOPK * PEER_TOPK)
    score, ci = lax.top_k(cand, PEER_TOPK)
    i1 = jnp.take_along_axis(i_top[..., 0, :], ci // PEER_TOPK, axis=-1)
    i2 = jnp.take_along_axis(i_top[..., 1, :], ci % PEER_TOPK, axis=-1)
    idx = i1 * PEER_N_KEYS + i2
    gate = jax.nn.softmax(score, axis=-1)

    n_tok = bsz * seq_len
    n_sel = PEER_HEADS * PEER_TOPK
    pad = (-n_tok) % PEER_TOKEN_BLOCK
    hf = jnp.pad(h.reshape(n_tok, d), ((0, pad), (0, 0)))
    idf = jnp.pad(idx.reshape(n_tok, n_sel), ((0, pad), (0, 0)))
    gf = jnp.pad(gate.reshape(n_tok, n_sel).astype(h.dtype), ((0, pad), (0, 0)))
    n_blk = (n_tok + pad) // PEER_TOKEN_BLOCK
    hf = hf.reshape(n_blk, PEER_TOKEN_BLOCK, d)
    idf = idf.reshape(n_blk, PEER_TOKEN_BLOCK, n_sel)
    gf = gf.reshape(n_blk, PEER_TOKEN_BLOCK, n_sel)

    def expert_block(args):
        hb, ib, gb = args
        u = u_tab[ib]
        act = jax.nn.gelu(jnp.einsum('td,ted->te', hb, u))
        return jnp.einsum('te,ted->td', gb * act, v_tab[ib])

    y = lax.map(expert_block, (hf, idf, gf))
    return y.reshape(n_blk * PEER_TOKEN_BLOCK, d)[:n_tok].reshape(bsz, seq_len, d)


def setup_inputs(seed: int = 0) -> dict:
    key = jax.random.key(seed)
    ks = jax.random.split(key, 14)
    d = D_MODEL
    f32 = jnp.float32
    return {
        "x": jax.random.normal(ks[0], (BATCH, SEQ, d), f32),
        "meta": jax.random.normal(ks[1], (N_META, d), f32),
        "norm1_g": 1.0 + 0.05 * jax.random.normal(ks[2], (d,), f32),
        "w_in": jax.random.normal(ks[3], (d, IN_WIDTH), f32) * d ** -0.5,
        "conv_w": jax.random.normal(ks[4], (CONV_K, CONV_WIDTH), f32) * CONV_K ** -0.5,
        "w_branch_a": jax.random.normal(ks[5], (CONV_WIDTH, d), f32) * CONV_WIDTH ** -0.5,
        "w_branch_b": jax.random.normal(ks[6], (SB_WIDTH, d), f32) * SB_WIDTH ** -0.5,
        "w_out": jax.random.normal(ks[7], (d, d), f32) * d ** -0.5,
        "norm2_g": 1.0 + 0.05 * jax.random.normal(ks[8], (d,), f32),
        "peer_w_q": jax.random.normal(ks[9], (d, PEER_HEADS * PEER_KEY_DIM), f32) * d ** -0.5,
        "peer_subkeys": jax.random.normal(ks[10], (PEER_HEADS, 2, PEER_N_KEYS, PEER_HALF), f32) * PEER_HALF ** -0.5,
        "peer_u": jax.random.normal(ks[11], (PEER_N_EXPERTS, d), f32) * d ** -0.5,
        "peer_v": jax.random.normal(ks[12], (PEER_N_EXPERTS, d), f32) * 0.5,
        "final_g": 1.0 + 0.05 * jax.random.normal(ks[13], (d,), f32),
    }


def reference(x, meta, norm1_g, w_in, conv_w, w_branch_a, w_branch_b, w_out,
              norm2_g, peer_w_q, peer_subkeys, peer_u, peer_v, final_g):
    bsz = x.shape[0]
    meta_b = jnp.broadcast_to(meta.astype(x.dtype)[None], (bsz, N_META, D_MODEL))
    h_res = jnp.concatenate([meta_b, x], axis=1)
    seq_len = h_res.shape[1]

    for _ in range(DEPTH):
        h = rmsnorm(h_res, norm1_g)
        proj = h @ w_in
        c0 = 3 * CONV_WIDTH
        c1 = c0 + 3 * SB_WIDTH
        b_a, c_a, u_a = jnp.split(proj[..., :c0], 3, axis=-1)
        q, k, v = jnp.split(proj[..., c0:c1], 3, axis=-1)
        gate_a, gate_b = jnp.split(proj[..., c1:], 2, axis=-1)

        y_a = (b_a * causal_dwconv(c_a * u_a, conv_w)) @ w_branch_a

        def heads(t):
            return t.reshape(bsz, seq_len, SB_HEADS, SB_HEAD_DIM).transpose(0, 2, 1, 3)
        o = stick_breaking_attention(heads(q), heads(k), heads(v))
        o = o.transpose(0, 2, 1, 3).reshape(bsz, seq_len, SB_WIDTH)
        y_b = o @ w_branch_b

        mixed = jax.nn.sigmoid(gate_a) * y_a + jax.nn.sigmoid(gate_b) * y_b
        h_res = h_res + mixed @ w_out

        h2 = rmsnorm(h_res, norm2_g)
        h_res = h_res + peer_layer(h2, peer_w_q, peer_subkeys, peer_u, peer_v)

    out = rmsnorm(h_res, final_g)
    return out[:, N_META:]
```

```cpp
#include <hip/hip_runtime.h>
#include <cstdio>
#include <cstdint>

#ifndef MK_N_LAUNCHES
#define MK_N_LAUNCHES 1
#endif
#ifndef DUP_PHASE
#define DUP_PHASE -1
#endif
#ifndef NAIVE_GEMM
#define NAIVE_GEMM 0
#endif

#define LAS __attribute__((address_space(3)))
#define GAS __attribute__((address_space(1)))
typedef unsigned short bf16_t;
typedef unsigned short u16;
typedef _Float16 f16_t;
typedef short bf16x8 __attribute__((ext_vector_type(8)));
typedef _Float16 f16x8 __attribute__((ext_vector_type(8)));
typedef _Float16 f16x2 __attribute__((ext_vector_type(2)));
typedef float f32x4 __attribute__((ext_vector_type(4)));
typedef float f32x2 __attribute__((ext_vector_type(2)));
typedef unsigned u32x4 __attribute__((ext_vector_type(4)));
typedef unsigned u32x2 __attribute__((ext_vector_type(2)));
typedef float f32x16 __attribute__((ext_vector_type(16)));
typedef int i32x8 __attribute__((ext_vector_type(8)));
typedef int i32x4 __attribute__((ext_vector_type(4)));

constexpr int D = 1024, NB = 8, SEQ = 2048, M = NB * SEQ, NMETA = 16, CW = 512, NH = 8, HD = 64, INW = 5120;
constexpr int PH = 8, NKEY = 128, TOPK = 16, NSEL = 128, NEXP = 16384;
constexpr float EPS = 1e-6f;
constexpr float SB_THR = 44.0f;
constexpr int NWAVES = 8, NTHR = 512;

constexpr size_t MiB = 1u << 20;
constexpr size_t WS_CTL = 0, CTL_ZERO_BYTES = 64 * 1024;
constexpr size_t WS_W1T = 1 * MiB;
constexpr size_t WS_WG8 = 7 * MiB;
constexpr float GATE_WSCALE = 64.0f, XN8_SCALE = 8.0f;
constexpr size_t WS_WAT = 11 * MiB;
constexpr size_t WS_WBT = 12 * MiB;
constexpr size_t WS_WOT = 13 * MiB;
constexpr size_t WS_WQT = 15 * MiB;
constexpr size_t WS_SKB = 19 * MiB;
constexpr size_t WS_META = 19 * MiB + 512 * 1024;
constexpr size_t WS_SS2 = 20 * MiB;
constexpr size_t WS_A = 24 * MiB;
constexpr size_t WS_B = 56 * MiB;
constexpr size_t WS_KU = 104 * MiB;
constexpr size_t WS_VT = 121 * MiB;
constexpr int LP = 2080;
constexpr size_t WS_T = 140 * MiB;
constexpr size_t WS_X18 = 160 * MiB;
constexpr size_t WS_E = 200 * MiB;
constexpr size_t WS_GATE = WS_E + 4 * MiB, WS_WGT = WS_E + 12 * MiB;
constexpr size_t WS_SS3 = 21 * MiB;
constexpr size_t WS_END = 220 * MiB;

constexpr int LDS_BYTES = 147456;
constexpr int RING_BYTES = 131072;
constexpr int MISC_OFF = RING_BYTES + 320;

__device__ __forceinline__ unsigned f2bf(float f) { unsigned u = __builtin_bit_cast(unsigned, f); return (u + 0x7fffu + ((u >> 16) & 1u)) >> 16; }
__device__ __forceinline__ float bf2f(unsigned h) { return __builtin_bit_cast(float, (h & 0xffffu) << 16); }
typedef __bf16 bf16x2_t __attribute__((ext_vector_type(2)));
__device__ __forceinline__ unsigned pk2bf(float lo, float hi) { const f32x2 v = {lo, hi}; return __builtin_bit_cast(unsigned, __builtin_convertvector(v, bf16x2_t)); }
__device__ __forceinline__ unsigned pk2h(float lo, float hi) { f16x2 v = {(f16_t)lo, (f16_t)hi}; return __builtin_bit_cast(unsigned, v); }
__device__ __forceinline__ f16x2 as_h2(unsigned w) { return __builtin_bit_cast(f16x2, w); }
__device__ __forceinline__ float bflo(unsigned w) { return __builtin_bit_cast(float, w << 16); }
__device__ __forceinline__ float bfhi(unsigned w) { return __builtin_bit_cast(float, w & 0xffff0000u); }
__device__ __forceinline__ float wave_sum(float v) {
#pragma unroll
    for (int o = 1; o < 64; o <<= 1) v += __shfl_xor(v, o);
    return v;
}
__device__ __forceinline__ unsigned wave_max_u(unsigned v) {
#pragma unroll
    for (int o = 1; o < 64; o <<= 1) { unsigned t = (unsigned)__shfl_xor((int)v, o); v = t > v ? t : v; }
    return v;
}
__device__ __forceinline__ int lane_id() { int l; asm volatile("v_mbcnt_lo_u32_b32 %0, -1, 0\n\tv_mbcnt_hi_u32_b32 %0, -1, %0" : "=v"(l)); return l; }
__device__ __forceinline__ float sigmoidf_(float x) { return 1.0f / (1.0f + __expf(-x)); }

namespace pg8 {
constexpr int BM = 256, BK = 64, HALF = 128, HTB = HALF * BK * 2, STAGE_BYTES = 8 * HTB, NXCD = 8, WGM = 8;
__host__ __device__ __forceinline__ int lds_byte(int r, int c) { const int st = (r >> 4) * 2 + (c >> 5), rr = r & 15, cc = c & 31, ob = rr * 64 + cc * 2; return st * 1024 + (ob ^ (((ob >> 9) & 1) << 5)); }
__host__ __device__ __forceinline__ void stage_rc(int b, int& R, int& C) { const int st = b / 1024, sb = b % 1024, swz = sb ^ (((sb >> 9) & 1) << 5); R = (st >> 1) * 16 + swz / 64; C = (st & 1) * 32 + (swz % 64) / 2; }
__host__ __device__ __forceinline__ int perm32(int rho) { const int n = rho >> 4, i = rho & 15; return 8 * (i >> 2) + 4 * n + (i & 3); }
struct Unit { int pm, pn, which; };
struct Gemm { const u16* A; const u16* Bt; int M, N, K; const u16* A2; const u16* Bt2; };
struct StaticOrder {
    int nM, nN, nwg, G, c;
    __host__ __device__ void init(int M_, int N_, int G_, int c_) { nM = M_ / BM; nN = N_ / BM; nwg = nM * nN; G = G_; c = c_; }
    __host__ __device__ bool next(int i, Unit& u) const {
        const long L = (long)i * G + c; if (L >= nwg) return false;
        int wgid = (int)L; { const int q = nwg / NXCD, r = nwg % NXCD, xcd = wgid % NXCD, off = wgid / NXCD; wgid = (xcd < r ? xcd * (q + 1) : r * (q + 1) + (xcd - r) * q) + off; }
        const int nig = WGM * nN, gid = wgid / nig, fm = gid * WGM, gsz = (nM - fm) < WGM ? (nM - fm) : WGM;
        u.pm = fm + ((wgid % nig) % gsz); u.pn = (wgid % nig) / gsz; u.which = 0; return true;
    }
    __device__ __forceinline__ void a_ready(const Unit&) const {}
    __device__ __forceinline__ void done(const Unit&) const {}
};
struct PairOrder {
    StaticOrder S;
    __host__ __device__ bool next(int i, Unit& u) const { if (!S.next(i >> 1, u)) return false; u.which = i & 1; return true; }
    __device__ __forceinline__ void a_ready(const Unit&) const {}
    __device__ __forceinline__ void done(const Unit&) const {}
};

template <class F> struct EpiAdapt {
    static constexpr bool PERM = true, AFTER_DRAIN = false;
    F f;
    __device__ __forceinline__ void operator()(const f32x4 (&acc)[2][2][4][2], const Unit& u, int wr, int wc, int fr, int fq) const {
        int fr2 = fr; asm volatile("" : "+v"(fr2), "+v"(fq));
        const int col = u.pn * BM + wc * 32 + 8 * fq;
#pragma unroll
        for (int ai = 0; ai < 2; ++ai)
#pragma unroll
            for (int m = 0; m < 4; ++m) {
                const int row = u.pm * BM + ai * HALF + wr * 64 + m * 16 + fr2;
                f(row, col, u.pn + 64 * u.which, wc, acc[ai][0][m][0], acc[ai][0][m][1], acc[ai][1][m][0], acc[ai][1][m][1]);
            }
    }
};

#if NAIVE_GEMM
template <bool F16> __device__ __forceinline__ float dot8(u32x4 a, u32x4 b) {
    float s = 0.f;
#pragma unroll
    for (int i = 0; i < 4; ++i) {
        if (F16) { f16x2 x = as_h2(a[i]), y = as_h2(b[i]); s += (float)x[0] * (float)y[0] + (float)x[1] * (float)y[1]; }
        else s += bflo(a[i]) * bflo(b[i]) + bfhi(a[i]) * bfhi(b[i]);
    }
    return s;
}
template <class Epi, class Sched, int FMT>
__device__ __forceinline__ void gemm_phase(LAS unsigned char* lds, const Gemm g, const Sched& S, const Epi& E, const int wid) {
    constexpr bool F16 = FMT == 1;
    const int lane = lane_id(), tid = wid * 64 + lane, wr = wid >> 2, wc = wid & 3, fr = lane & 15, fq = lane >> 4;
    Unit u;
    for (int ui = 0; S.next(ui, u); ++ui) {
        f32x4 acc[2][2][4][2];
        for (int ai = 0; ai < 2; ++ai) for (int m = 0; m < 4; ++m) {
            const int row = u.pm * BM + ai * HALF + wr * 64 + m * 16 + fr;
            float a16[16];
            for (int j = 0; j < 16; ++j) a16[j] = 0.f;
            const u32x4* ap = (const u32x4*)(g.A + (size_t)row * g.K);
            for (int k8 = 0; k8 < g.K / 8; ++k8) {
                const u32x4 av = ap[k8];
#pragma unroll
                for (int j = 0; j < 16; ++j) {
                    const int col = u.pn * BM + (j >> 3) * HALF + wc * 32 + 8 * fq + (j & 7);
                    const u32x4 bv = ((const u32x4*)(g.Bt + (size_t)col * g.K))[k8];
                    a16[j] += dot8<F16>(av, bv);
                }
            }
            acc[ai][0][m][0] = (f32x4){a16[0], a16[1], a16[2], a16[3]}; acc[ai][0][m][1] = (f32x4){a16[4], a16[5], a16[6], a16[7]};
            acc[ai][1][m][0] = (f32x4){a16[8], a16[9], a16[10], a16[11]}; acc[ai][1][m][1] = (f32x4){a16[12], a16[13], a16[14], a16[15]};
        }
        E(acc, u, wr, wc, fr, fq);
    }
    __syncthreads();
}
#else
template <class Epi, class Sched, int FMT>
__device__ __forceinline__ void gemm_phase(LAS unsigned char* lds, const Gemm g, const Sched& S, const Epi& E, const int wid) {
    constexpr bool ALIGN_EPI = true; constexpr bool F16 = FMT == 1;
    const int lane = lane_id(), tid = wid * 64 + lane, wr = wid >> 2, wc = wid & 3, fr = lane & 15, fq = lane >> 4;
    const int K = g.K; int nt = K / BK;
    if constexpr (FMT == 2) asm volatile("" : "+s"(nt));
    unsigned voffA[2], voffB[2];
#pragma unroll
    for (int i = 0; i < 2; ++i) { int R, C; stage_rc(tid * 16 + i * 8192, R, C); const int Rb = Epi::PERM ? ((R & ~31) + perm32(R & 31)) : R;
        voffA[i] = (unsigned)(R * K + C) * 2u; voffB[i] = (unsigned)(Rb * K + C) * 2u; }
    const unsigned kstep = (unsigned)(BK * 2);
    const unsigned hstep = (unsigned)HALF * (unsigned)K * 2u;
    const unsigned tstep = 2u * hstep;
    const unsigned ldsw = (unsigned)wid * 1024u;
    const int aoff = lds_byte(wr * 64 + fr, fq * 8), boff = lds_byte(wc * 32 + fr, fq * 8);
#define PG8_SA(b, h) (((b) * 2 + (h)) * HTB)
#define PG8_SB(b, h) ((4 + (b) * 2 + (h)) * HTB)
#define PG8_STAGE(bufoff, gbase, goff, voff) do { unsigned _go = (goff); asm volatile("" : "+s"(_go));   \
        _Pragma("unroll") for (int _i = 0; _i < 2; ++_i) \
        __builtin_amdgcn_global_load_lds((const unsigned*)((gbase) + (_go + (voff)[_i])), (LAS unsigned*)(lds + (bufoff) + ldsw + _i * 8192), 16, 0, 0); } while (0)
#define PG8_LDA(dst, b, h) do { _Pragma("unroll") for (int m = 0; m < 4; ++m) _Pragma("unroll") for (int k = 0; k < 2; ++k) dst[m][k] = *(const LAS bf16x8*)(lds + PG8_SA(b, h) + aoff + m * 2048 + k * 1024); } while (0)
#define PG8_LDB(dst, b, h) do { _Pragma("unroll") for (int n = 0; n < 2; ++n) _Pragma("unroll") for (int k = 0; k < 2; ++k) dst[n][k] = *(const LAS bf16x8*)(lds + PG8_SB(b, h) + boff + n * 2048 + k * 1024); } while (0)
#define PG8_MMA(ai, bj, At, Bt) do { __builtin_amdgcn_s_setprio(1); _Pragma("unroll") for (int m = 0; m < 4; ++m) _Pragma("unroll") for (int n = 0; n < 2; ++n) { \
        if constexpr (FMT == 2) { const i32x8 _a = __builtin_shufflevector(__builtin_bit_cast(i32x4, Bt[n][0]), __builtin_bit_cast(i32x4, Bt[n][1]), 0, 1, 2, 3, 4, 5, 6, 7), \
                                      _b = __builtin_shufflevector(__builtin_bit_cast(i32x4, At[m][0]), __builtin_bit_cast(i32x4, At[m][1]), 0, 1, 2, 3, 4, 5, 6, 7); \
            acc[ai][bj][m][n] = __builtin_amdgcn_mfma_scale_f32_16x16x128_f8f6f4(_a, _b, acc[ai][bj][m][n], 0, 0, 0, 0, 0, 0); } \
        else { _Pragma("unroll") for (int k = 0; k < 2; ++k) { \
        if (F16) acc[ai][bj][m][n] = __builtin_amdgcn_mfma_f32_16x16x32_f16(__builtin_bit_cast(f16x8, Bt[n][k]), __builtin_bit_cast(f16x8, At[m][k]), acc[ai][bj][m][n], 0, 0, 0); \
        else acc[ai][bj][m][n] = __builtin_amdgcn_mfma_f32_16x16x32_bf16(Bt[n][k], At[m][k], acc[ai][bj][m][n], 0, 0, 0); } } } __builtin_amdgcn_s_setprio(0); } while (0)
#define PG8_WAIT_V(n) asm volatile("s_waitcnt vmcnt(" #n ")" ::: "memory")
#define PG8_WAIT_L(n) asm volatile("s_waitcnt lgkmcnt(" #n ")" ::: "memory")
#define PG8_BAR __builtin_amdgcn_s_barrier()
#define PG8_SCHED __builtin_amdgcn_sched_barrier(0)
    Unit cur, nxt; int ui = 0;
    if (!S.next(0, cur)) return;
    f32x4 acc[2][2][4][2];
#pragma unroll
    for (int a = 0; a < 2; ++a)
#pragma unroll
        for (int b = 0; b < 2; ++b)
#pragma unroll
            for (int m = 0; m < 4; ++m)
#pragma unroll
                for (int n = 0; n < 2; ++n) acc[a][b][m][n] = (f32x4){0.f, 0.f, 0.f, 0.f};
    bf16x8 At[4][2], B0[2][2], B1[2][2];
    const char* pA = (const char*)(cur.which ? g.A2 : g.A); const char* pB = (const char*)(cur.which ? g.Bt2 : g.Bt);
    unsigned cA = (unsigned)cur.pm * tstep, cB = (unsigned)cur.pn * tstep;
    S.a_ready(cur);
    {
        PG8_STAGE(PG8_SB(0, 0), pB, cB, voffB); PG8_STAGE(PG8_SB(0, 1), pB, cB + hstep, voffB); PG8_STAGE(PG8_SA(0, 0), pA, cA, voffA); PG8_STAGE(PG8_SA(0, 1), pA, cA + hstep, voffA);
        if (wr == 1) PG8_BAR;
        PG8_WAIT_V(2); PG8_BAR;
        PG8_STAGE(PG8_SB(1, 0), pB, cB + kstep, voffB); PG8_STAGE(PG8_SA(1, 0), pA, cA + kstep, voffA); PG8_STAGE(PG8_SB(1, 1), pB, cB + hstep + kstep, voffB);
        PG8_WAIT_V(6); PG8_BAR;
    }
    for (;;) {
        const bool has_next = S.next(ui + 1, nxt);
        const char* qA = has_next ? (const char*)(nxt.which ? g.A2 : g.A) : pA; const char* qB = has_next ? (const char*)(nxt.which ? g.Bt2 : g.Bt) : pB;
        const unsigned nA = has_next ? (unsigned)nxt.pm * tstep : cA, nB = has_next ? (unsigned)nxt.pn * tstep : cB;
        for (int t = 0; t < nt; t += 2) {
            const bool last = (t == nt - 2);
            const unsigned a1 = cA + (unsigned)(t + 1) * kstep;
            const char* rA = last ? qA : pA; const char* rB = last ? qB : pB;
            const unsigned a2 = last ? nA : cA + (unsigned)(t + 2) * kstep, b2 = last ? nB : cB + (unsigned)(t + 2) * kstep;
            const unsigned a3 = a2 + kstep, b3 = b2 + kstep;
            if (last && has_next) S.a_ready(nxt);
            PG8_LDB(B0, 0, 0); PG8_LDB(B1, 0, 1); PG8_SCHED; PG8_LDA(At, 0, 0); PG8_STAGE(PG8_SA(1, 1), pA, a1 + hstep, voffA);
            PG8_WAIT_V(8); PG8_WAIT_L(0); PG8_BAR; PG8_MMA(0, 0, At, B0); PG8_MMA(0, 1, At, B1); PG8_BAR; PG8_SCHED;
            PG8_LDA(At, 0, 1); PG8_STAGE(PG8_SB(0, 0), rB, b2, voffB); PG8_STAGE(PG8_SB(0, 1), rB, b2 + hstep, voffB); PG8_STAGE(PG8_SA(0, 0), rA, a2, voffA);
            PG8_WAIT_V(8); PG8_WAIT_L(0); PG8_BAR; PG8_MMA(1, 0, At, B0); PG8_MMA(1, 1, At, B1); PG8_BAR; PG8_SCHED;
            PG8_LDB(B0, 1, 0); PG8_LDB(B1, 1, 1); PG8_SCHED; PG8_LDA(At, 1, 0); PG8_STAGE(PG8_SA(0, 1), rA, a2 + hstep, voffA);
            PG8_WAIT_V(8); PG8_WAIT_L(0); PG8_BAR; PG8_MMA(0, 0, At, B0); PG8_MMA(0, 1, At, B1); PG8_BAR; PG8_SCHED;
            PG8_LDA(At, 1, 1); PG8_STAGE(PG8_SB(1, 0), rB, b3, voffB); PG8_STAGE(PG8_SB(1, 1), rB, b3 + hstep, voffB); PG8_STAGE(PG8_SA(1, 0), rA, a3, voffA);
            PG8_WAIT_V(8); PG8_WAIT_L(0); PG8_BAR; PG8_MMA(1, 0, At, B0); PG8_MMA(1, 1, At, B1); PG8_BAR; PG8_SCHED;
        }
        if constexpr (ALIGN_EPI) { if (wr == 0) PG8_BAR; }
        E(acc, cur, wr, wc, fr, fq); S.done(cur);
        if (!has_next) break;
#pragma unroll
        for (int a = 0; a < 2; ++a)
#pragma unroll
            for (int b = 0; b < 2; ++b)
#pragma unroll
                for (int m = 0; m < 4; ++m)
#pragma unroll
                    for (int n = 0; n < 2; ++n) acc[a][b][m][n] = (f32x4){0.f, 0.f, 0.f, 0.f};
        cur = nxt; cA = nA; cB = nB; pA = qA; pB = qB; ++ui;
        if constexpr (ALIGN_EPI) { if (wr == 1) PG8_BAR; }
    }
    PG8_WAIT_V(0);
    if constexpr (!ALIGN_EPI) { if (wr == 0) PG8_BAR; }
    PG8_BAR;
#undef PG8_SA
#undef PG8_SB
#undef PG8_STAGE
#undef PG8_LDA
#undef PG8_LDB
#undef PG8_MMA
#undef PG8_WAIT_V
#undef PG8_WAIT_L
#undef PG8_BAR
#undef PG8_SCHED
}
#endif
}

#define XB_TMO      128
#define XB_XCNT(j)  (256  + 64 * (j))
#define XB_XSUB(j)  (1280 + 64 * (j))
#define XB_XGEN(j)  (2304 + 64 * (j))
#define XB_TOP      3328
#define XB_TOPGEN   3392
#define XCD_BAR_WORDS 3456
#define XB_SPIN_CAP (1u << 20)
__device__ __forceinline__ unsigned xb_ld(unsigned* p)              { return __hip_atomic_load(p, __ATOMIC_RELAXED, __HIP_MEMORY_SCOPE_AGENT); }
__device__ __forceinline__ unsigned xb_add(unsigned* p, unsigned v) { return __hip_atomic_fetch_add(p, v, __ATOMIC_RELAXED, __HIP_MEMORY_SCOPE_AGENT); }
__device__ __forceinline__ unsigned xb_xcc_id() { return (unsigned)__builtin_amdgcn_s_getreg((3 << 11) | 20) & 0xFu; }
#define XB_SPIN(cond, bar) do { unsigned _sp = 0; while (cond) { __builtin_amdgcn_s_sleep(1); \
    if ((++_sp & 255u) == 0u) { if (xb_ld(&(bar)[XB_TMO])) break; if (_sp > XB_SPIN_CAP) { atomicAdd(&(bar)[XB_TMO], 1u); break; } } } } while (0)
struct XcdBarrier { unsigned* bar; unsigned x; volatile LAS unsigned* st; int wave; };
__device__ __forceinline__ XcdBarrier xcd_barrier_post(unsigned* bar, volatile LAS unsigned* st, int wave) {
    XcdBarrier b; b.bar = bar; b.x = xb_xcc_id(); b.st = st; b.wave = wave;
    if (wave == 0 && lane_id() == 0) (void)xb_add(&bar[XB_XCNT(b.x)], 1u);
    return b;
}
__device__ __forceinline__ void xcd_barrier_complete(unsigned* bar, unsigned x, unsigned& nloc, unsigned& nx) {
    const unsigned G = gridDim.x * gridDim.y * gridDim.z;
    unsigned sum, cnt, mine, sp = 0u;
    for (;;) {
        sum = 0u; cnt = 0u; mine = 0u;
#pragma unroll
        for (unsigned j = 0; j < 16; ++j) { const unsigned c = xb_ld(&bar[XB_XCNT(j)]); sum += c; cnt += (c > 0u) ? 1u : 0u; mine = (j == x) ? c : mine; }
        if (sum == G) break;
        __builtin_amdgcn_s_sleep(1);
        if ((++sp & 255u) == 0u) { if (xb_ld(&bar[XB_TMO])) break; if (sp > XB_SPIN_CAP) { atomicAdd(&bar[XB_TMO], 1u); break; } }
    }
    nloc = mine > 0u ? mine : 1u; nx = cnt > 0u ? cnt : 1u;
}
__device__ __forceinline__ void xcd_barrier(const XcdBarrier& b) {
    asm volatile("s_waitcnt vmcnt(0)" ::: "memory");
    __syncthreads();
    if (b.wave == 0 && lane_id() == 0) {
        unsigned* bar = b.bar;
        __builtin_amdgcn_s_waitcnt(0);
        unsigned nloc = b.st[0], nx = b.st[1];
        if (nloc == 0u) { xcd_barrier_complete(bar, b.x, nloc, nx); b.st[0] = nloc; b.st[1] = nx; }
        const unsigned old = xb_add(&bar[XB_XSUB(b.x)], 1u);
        const unsigned gen = old / nloc;
        if (old + 1u == (gen + 1u) * nloc) {
            __builtin_amdgcn_fence(__ATOMIC_RELEASE, "agent");
            asm volatile("s_waitcnt vmcnt(0)" ::: "memory");
            const unsigned og = xb_add(&bar[XB_TOP], 1u);
            const unsigned tg = og / nx;
            if (og + 1u == (tg + 1u) * nx) xb_add(&bar[XB_TOPGEN], 1u);
            else XB_SPIN(xb_ld(&bar[XB_TOPGEN]) == tg, bar);
            __builtin_amdgcn_fence(__ATOMIC_ACQUIRE, "agent");
            xb_add(&bar[XB_XGEN(b.x)], 1u);
            asm volatile("s_waitcnt vmcnt(0)" ::: "memory");
        } else {
            XB_SPIN(xb_ld(&bar[XB_XGEN(b.x)]) == gen, bar);
            __builtin_amdgcn_fence(__ATOMIC_ACQUIRE, "agent");
            asm volatile("s_waitcnt vmcnt(0)" ::: "memory");
        }
    }
    __syncthreads();
}

struct Args { const float* in[14]; float* out; unsigned char* ws; int ph_lo, ph_hi; };
struct Ctx {
    LAS unsigned char* lds;
    int tid, lane, wave, G, gw, NGW;
    const float *x, *meta, *g1, *w_in, *conv_w, *w_a, *w_b, *w_out, *g2, *w_q, *subk, *pu, *pv, *gf;
    float* out; unsigned char* ws;
};

__device__ __forceinline__ float one_or(const float* s, int i) { return s ? s[i] : 1.0f; }
template <bool F16>
__device__ __forceinline__ void p0_transpose_item(const float* W, int K, int N, const float* scale, u16* WT, int scol0, int drow0, int k0, LAS float* scr, int lane) {
#pragma unroll
    for (int i = 0; i < 32; ++i) { const int kk = 2 * i + (lane >> 5); scr[kk * 33 + (lane & 31)] = W[(size_t)(k0 + kk) * N + scol0 + (lane & 31)] * one_or(scale, k0 + kk); }
    asm volatile("s_waitcnt lgkmcnt(0)" ::: "memory");
    const int c = lane & 7;
#pragma unroll
    for (int j = 0; j < 4; ++j) { const int n = (lane >> 3) + 8 * j; const LAS float* s = scr + (8 * c) * 33 + n;
        u32x4 o;
        if (F16) { o.x = pk2h(s[0 * 33], s[1 * 33]); o.y = pk2h(s[2 * 33], s[3 * 33]); o.z = pk2h(s[4 * 33], s[5 * 33]); o.w = pk2h(s[6 * 33], s[7 * 33]); }
        else { o.x = pk2bf(s[0 * 33], s[1 * 33]); o.y = pk2bf(s[2 * 33], s[3 * 33]); o.z = pk2bf(s[4 * 33], s[5 * 33]); o.w = pk2bf(s[6 * 33], s[7 * 33]); }
        *(u32x4*)(WT + (size_t)(drow0 + n) * K + k0 + 8 * c) = o; }
    asm volatile("s_waitcnt lgkmcnt(0)" ::: "memory");
}
__device__ __forceinline__ void p0_transpose_item8(const float* W, int K, int N, const float* scale, float mul, unsigned char* WT8, int scol0, int drow0, int k0, LAS float* scr, int lane) {
#pragma unroll
    for (int i = 0; i < 32; ++i) { const int kk = 2 * i + (lane >> 5); scr[kk * 33 + (lane & 31)] = W[(size_t)(k0 + kk) * N + scol0 + (lane & 31)] * (mul * one_or(scale, k0 + kk)); }
    asm volatile("s_waitcnt lgkmcnt(0)" ::: "memory");
    const int n = lane & 31, hf = lane >> 5; const LAS float* s = scr + (32 * hf) * 33 + n;
    unsigned w[8];
#pragma unroll
    for (int j = 0; j < 8; ++j) w[j] = (unsigned)__builtin_amdgcn_cvt_pk_fp8_f32(s[(4 * j + 2) * 33], s[(4 * j + 3) * 33], __builtin_amdgcn_cvt_pk_fp8_f32(s[(4 * j) * 33], s[(4 * j + 1) * 33], 0, false), true);
    u32x4* op = (u32x4*)(WT8 + (size_t)(drow0 + n) * K + k0 + 32 * hf);
    op[0] = (u32x4){w[0], w[1], w[2], w[3]}; op[1] = (u32x4){w[4], w[5], w[6], w[7]};
    asm volatile("s_waitcnt lgkmcnt(0)" ::: "memory");
}
__device__ __forceinline__ int w1_srccol(int n) {
    if (n < 512 || n >= 1536) return n;
    const int t = (n - 512) >> 8, r = (n - 512) & 255;
    return r < 128 ? 512 + 128 * t + r : 1024 + 128 * t + (r - 128);
}

__device__ __forceinline__ void phase0(Ctx& F) {
    f32x4 xv[4][4]; int xr[4];
#pragma unroll
    for (int u = 0; u < 4; ++u) { xr[u] = min(F.gw + u * F.NGW, M - 1); const f32x4* xp = (const f32x4*)(F.x + (size_t)xr[u] * D) + F.lane;
#pragma unroll
        for (int j = 0; j < 4; ++j) xv[u][j] = __builtin_nontemporal_load(xp + 64 * j); }
    {
        LAS float* mn = (LAS float*)F.lds;
        LAS float* red = (LAS float*)(F.lds + 65536);
        for (int r = F.wave * 2; r < F.wave * 2 + 2; ++r) {
            float v[16]; float s = 0.f;
#pragma unroll
            for (int j = 0; j < 16; ++j) { v[j] = F.meta[r * D + j * 64 + F.lane]; s += v[j] * v[j]; }
            const float rstd = 1.0f / sqrtf(wave_sum(s) * (1.0f / D) + EPS);
#pragma unroll
            for (int j = 0; j < 16; ++j) { const int k = j * 64 + F.lane; mn[k * 16 + r] = v[j] * rstd * F.g1[k]; }
        }
        __syncthreads();
        bf16_t* MK = (bf16_t*)(F.ws + WS_META); bf16_t* MV = MK + 16 * 512; float* MCA = (float*)(MV + 16 * 512); float* MUA = MCA + 16 * 512;
        for (int cg = blockIdx.x; cg < 256; cg += F.G) {
            const int j = F.tid & 7, kq = F.tid >> 3;
            const int gc = cg * 8 + j, which = gc >> 9, cc = gc & 511;
            const int scol = which == 0 ? 2048 + cc : which == 1 ? 2560 + cc : which == 2 ? 512 + cc : 1024 + cc;
            float wv[16];
#pragma unroll
            for (int kk = 0; kk < 16; ++kk) wv[kk] = F.w_in[(size_t)(kq * 16 + kk) * INW + scol];
            float acc[16];
#pragma unroll
            for (int r = 0; r < 16; ++r) acc[r] = 0.f;
#pragma unroll
            for (int kk = 0; kk < 16; ++kk) {
#pragma unroll
                for (int r4 = 0; r4 < 4; ++r4) { const f32x4 mv = *(const LAS f32x4*)(mn + (kq * 16 + kk) * 16 + r4 * 4);
                    acc[r4 * 4 + 0] += mv.x * wv[kk]; acc[r4 * 4 + 1] += mv.y * wv[kk]; acc[r4 * 4 + 2] += mv.z * wv[kk]; acc[r4 * 4 + 3] += mv.w * wv[kk]; }
            }
#pragma unroll
            for (int r = 0; r < 16; ++r) red[(kq * 16 + r) * 8 + j] = acc[r];
            __syncthreads();
            if (F.tid < 128) {
                const int r = F.tid >> 3, jj = F.tid & 7; float sm = 0.f;
                for (int q = 0; q < 64; ++q) sm += red[(q * 16 + r) * 8 + jj];
                const int gc2 = cg * 8 + jj, wh = gc2 >> 9, c2 = gc2 & 511;
                if (wh == 0) { MK[r * 512 + c2] = (bf16_t)f2bf(sm); bf16_t* KU = (bf16_t*)(F.ws + WS_KU);
                    for (int b = 0; b < NB; ++b) KU[((size_t)(b * NH + (c2 >> 6)) * LP + 16 + r) * HD + (c2 & 63)] = (bf16_t)f2bf(sm); }
                else if (wh == 1) { MV[r * 512 + c2] = (bf16_t)f2bf(sm); bf16_t* VT = (bf16_t*)(F.ws + WS_VT);
                    for (int b = 0; b < NB; ++b) VT[((size_t)(b * NH + (c2 >> 6)) * HD + (c2 & 63)) * LP + 16 + r] = (bf16_t)f2bf(sm); }
                else if (wh == 2) MCA[r * 512 + c2] = sm; else MUA[r * 512 + c2] = sm;
            }
            __syncthreads();
        }
    }
    {
        bf16_t* KU = (bf16_t*)(F.ws + WS_KU); bf16_t* VT = (bf16_t*)(F.ws + WS_VT);
        for (int i = blockIdx.x * NTHR + F.tid; i < 64 * 16 * 64; i += F.G * NTHR) {
            const int bh = i >> 10, rr = (i >> 6) & 15, dd = i & 63;
            KU[((size_t)bh * LP + rr) * HD + dd] = 0; VT[((size_t)bh * HD + dd) * LP + rr] = 0;
        }
    }
    {
        LAS float* scr = (LAS float*)(F.lds + F.wave * 16384);
        constexpr int I1 = 16 * 160;
        for (int it = F.gw; it < I1; it += F.NGW) { const int kb = it / 160, nb = it % 160;
            if (nb < 96) p0_transpose_item<false>(F.w_in, D, INW, F.g1, (u16*)(F.ws + WS_W1T), w1_srccol(nb * 32), nb * 32, kb * 64, scr, F.lane);
            else p0_transpose_item8(F.w_in, D, INW, F.g1, GATE_WSCALE, F.ws + WS_WG8, nb * 32, (nb - 96) * 32, kb * 64, scr, F.lane); }
    }
    {
        bf16_t* XN = (bf16_t*)(F.ws + WS_A); unsigned char* XN8 = F.ws + WS_X18;
        for (int m0 = F.gw; m0 < M; m0 += 4 * F.NGW) {
            f32x4 v[4][4]; int mr[4];
#pragma unroll
            for (int u = 0; u < 4; ++u) {
#pragma unroll
                for (int j = 0; j < 4; ++j) v[u][j] = xv[u][j];
                mr[u] = xr[u]; }
            const int m1 = m0 + 4 * F.NGW;
            if (m1 < M) {
#pragma unroll
                for (int u = 0; u < 4; ++u) { xr[u] = min(m1 + u * F.NGW, M - 1); const f32x4* xp = (const f32x4*)(F.x + (size_t)xr[u] * D) + F.lane;
#pragma unroll
                    for (int j = 0; j < 4; ++j) xv[u][j] = __builtin_nontemporal_load(xp + 64 * j); }
            }
#pragma unroll
            for (int u = 0; u < 4; ++u) {
                float s = 0.f;
#pragma unroll
                for (int j = 0; j < 4; ++j) s += (v[u][j].x * v[u][j].x + v[u][j].y * v[u][j].y) + (v[u][j].z * v[u][j].z + v[u][j].w * v[u][j].w);
                const float rstd = 1.0f / sqrtf(wave_sum(s) * (1.0f / D) + EPS);
                u32x2* o8 = (u32x2*)(XN + (size_t)mr[u] * D) + F.lane; unsigned* o4 = (unsigned*)(XN8 + (size_t)mr[u] * D) + F.lane; const float r8 = rstd * XN8_SCALE;
#pragma unroll
                for (int j = 0; j < 4; ++j) { u32x2 o; o.x = pk2bf(v[u][j].x * rstd, v[u][j].y * rstd); o.y = pk2bf(v[u][j].z * rstd, v[u][j].w * rstd); o8[64 * j] = o;
                    o4[64 * j] = (unsigned)__builtin_amdgcn_cvt_pk_fp8_f32(v[u][j].z * r8, v[u][j].w * r8, __builtin_amdgcn_cvt_pk_fp8_f32(v[u][j].x * r8, v[u][j].y * r8, 0, false), true); }
            }
        }
    }
}
__device__ __forceinline__ void convert_weights_late(Ctx& F) {
    LAS float* scr = (LAS float*)(F.lds + 32768 + F.wave * 12288);
    constexpr int IA = 8 * 32, IB = 8 * 32, IO = 16 * 32, IQ = 16 * 64, NIT = IA + IB + IO + IQ;
    for (int it = F.gw; it < NIT; it += F.NGW) {
        int r = it;
        if (r < IA) { const int kb = r / 32, nb = r % 32; p0_transpose_item<false>(F.w_a, CW, D, nullptr, (u16*)(F.ws + WS_WAT), nb * 32, nb * 32, kb * 64, scr, F.lane); continue; } r -= IA;
        if (r < IB) { const int kb = r / 32, nb = r % 32; p0_transpose_item<false>(F.w_b, CW, D, nullptr, (u16*)(F.ws + WS_WBT), nb * 32, nb * 32, kb * 64, scr, F.lane); continue; } r -= IB;
        if (r < IO) { const int kb = r / 32, nb = r % 32; p0_transpose_item<false>(F.w_out, D, D, nullptr, (u16*)(F.ws + WS_WOT), nb * 32, nb * 32, kb * 64, scr, F.lane); continue; } r -= IO;
        { const int kb = r / 64, nb = r % 64; p0_transpose_item<true>(F.w_q, D, 2048, F.g2, (u16*)(F.ws + WS_WQT), nb * 32, nb * 32, kb * 64, scr, F.lane); }
    }
    const int gt = blockIdx.x * NTHR + F.tid, NT = F.G * NTHR;
    f16_t* SKB = (f16_t*)(F.ws + WS_SKB);
    for (int i = gt; i < 16 * 128 * 128 / 4; i += NT) { const f32x4 v = ((const f32x4*)F.subk)[i]; u32x2 o; o.x = pk2h(v.x, v.y); o.y = pk2h(v.z, v.w); ((u32x2*)SKB)[i] = o; }
}
__device__ __forceinline__ unsigned fp4_code(float x, float inv) {
    const float a = fabsf(x) * inv;
    const unsigned idx = (unsigned)(a >= 0.25f) + (unsigned)(a >= 0.75f) + (unsigned)(a >= 1.25f) + (unsigned)(a >= 1.75f) + (unsigned)(a >= 2.5f) + (unsigned)(a >= 3.5f) + (unsigned)(a >= 5.0f);
    return idx | (x < 0.f ? 8u : 0u);
}
__device__ __forceinline__ float clamp6(float x) { return __builtin_fminf(__builtin_fmaxf(x, -6.0f), 6.0f); }
__device__ __forceinline__ unsigned fp4_pack8(f32x4 a, f32x4 b, float inv) {
    unsigned w = 0;
    w = __builtin_amdgcn_cvt_scalef32_pk_fp4_f32(w, clamp6(a.x * inv), clamp6(a.y * inv), 1.0f, 0);
    w = __builtin_amdgcn_cvt_scalef32_pk_fp4_f32(w, clamp6(a.z * inv), clamp6(a.w * inv), 1.0f, 1);
    w = __builtin_amdgcn_cvt_scalef32_pk_fp4_f32(w, clamp6(b.x * inv), clamp6(b.y * inv), 1.0f, 2);
    w = __builtin_amdgcn_cvt_scalef32_pk_fp4_f32(w, clamp6(b.z * inv), clamp6(b.w * inv), 1.0f, 3);
    return w;
}
__device__ __forceinline__ float wave_max(float v) {
#pragma unroll
    for (int o = 1; o < 64; o <<= 1) v = fmaxf(v, __shfl_xor(v, o));
    return v;
}
__device__ __forceinline__ void convert_tables(Ctx& F) {
    unsigned char* U4 = F.ws + WS_T; unsigned char* V4 = F.ws + WS_T + 8 * MiB; float* SU = (float*)(F.ws + WS_T + 16 * MiB); float* SV = SU + NEXP;
    f32x4 g[4];
#pragma unroll
    for (int j = 0; j < 4; ++j) g[j] = *(const f32x4*)(F.g2 + 256 * j + 4 * F.lane);
    for (int t0 = F.gw; t0 < 2 * NEXP; t0 += 4 * F.NGW) {
        f32x4 v[4][4];
#pragma unroll
        for (int u = 0; u < 4; ++u) { const int t = min(t0 + u * F.NGW, 2 * NEXP - 1); const float* src = (t < NEXP ? F.pu : F.pv) + (size_t)(t & (NEXP - 1)) * D + 4 * F.lane;
#pragma unroll
            for (int j = 0; j < 4; ++j) v[u][j] = __builtin_nontemporal_load((const f32x4*)(src + 256 * j)); }
#pragma unroll
        for (int u = 0; u < 4; ++u) {
            const int t = t0 + u * F.NGW; const bool isu = t < NEXP; const int row = t & (NEXP - 1);
            float m = 0.f;
#pragma unroll
            for (int j = 0; j < 4; ++j) { if (isu) v[u][j] = v[u][j] * g[j]; m = fmaxf(m, fmaxf(fmaxf(fabsf(v[u][j].x), fabsf(v[u][j].y)), fmaxf(fabsf(v[u][j].z), fabsf(v[u][j].w)))); }
            m = fmaxf(wave_max(m), 1.0e-30f);
            const float sc = m * 0.125f, inv = 8.0f / m;
            if (t < 2 * NEXP) {
                unsigned char* dst = (isu ? U4 : V4) + (size_t)row * 128 + 2 * F.lane;
#pragma unroll
                for (int j = 0; j < 4; ++j) { unsigned w = 0;
                    w = __builtin_amdgcn_cvt_scalef32_pk_fp4_f32(w, clamp6(v[u][j].x * inv), clamp6(v[u][j].y * inv), 1.0f, 0);
                    w = __builtin_amdgcn_cvt_scalef32_pk_fp4_f32(w, clamp6(v[u][j].z * inv), clamp6(v[u][j].w * inv), 1.0f, 1);
                    *(u16*)(dst + (size_t)j * (NEXP * 128)) = (u16)w; }
                if (F.lane == 0) (isu ? SU : SV)[row] = sc;
            }
        }
    }
}

__device__ __forceinline__ u32x4 pack8bf(f32x4 a, f32x4 b) { u32x4 w; w.x = pk2bf(a.x, a.y); w.y = pk2bf(a.z, a.w); w.z = pk2bf(b.x, b.y); w.w = pk2bf(b.z, b.w); return w; }
__device__ __forceinline__ u32x4 pack8h(f32x4 a, f32x4 b) { u32x4 w; w.x = pk2h(a.x, a.y); w.y = pk2h(a.z, a.w); w.z = pk2h(b.x, b.y); w.w = pk2h(b.z, b.w); return w; }
__device__ __forceinline__ void unpack8bf(u32x4 w, f32x4& a, f32x4& b) { a = (f32x4){bflo(w.x), bfhi(w.x), bflo(w.y), bfhi(w.y)}; b = (f32x4){bflo(w.z), bfhi(w.z), bflo(w.w), bfhi(w.w)}; }
__device__ __forceinline__ unsigned sig4u8(f32x4 v) {
    const unsigned a = (unsigned)(sigmoidf_(v.x) * 255.f + 0.5f), b = (unsigned)(sigmoidf_(v.y) * 255.f + 0.5f), c = (unsigned)(sigmoidf_(v.z) * 255.f + 0.5f), d = (unsigned)(sigmoidf_(v.w) * 255.f + 0.5f);
    return a | (b << 8) | (c << 16) | (d << 24); }
__device__ __forceinline__ f32x4 u8x4f(unsigned w) { return (f32x4){(float)(w & 0xffu), (float)((w >> 8) & 0xffu), (float)((w >> 16) & 0xffu), (float)(w >> 24)} * (1.0f / 255.0f); }
__device__ __forceinline__ f32x4 sig4(f32x4 v) { return (f32x4){sigmoidf_(v.x), sigmoidf_(v.y), sigmoidf_(v.z), sigmoidf_(v.w)}; }

struct Epi1 {
    bf16_t *BA, *CU, *Q, *K, *V;
    __device__ __forceinline__ void operator()(int row, int col, int pn, int wc, f32x4 l0, f32x4 l1, f32x4 h0, f32x4 h1) const {
        if (pn < 2) { bf16_t* p = BA + (size_t)row * CW + col; *(u32x4*)p = pack8bf(l0, l1); *(u32x4*)(p + 128) = pack8bf(h0, h1); }
        else if (pn < 6) { bf16_t* p = CU + (size_t)row * CW + (pn - 2) * 128 + (col & 255); *(u32x4*)p = pack8bf(l0 * h0, l1 * h1); }
        else if (pn < 8) { bf16_t* p = Q + (size_t)row * CW + (col - 1536); *(u32x4*)p = pack8bf(l0 * 0.125f, l1 * 0.125f); *(u32x4*)(p + 128) = pack8bf(h0 * 0.125f, h1 * 0.125f); }
        else if (pn < 10) { const int c = col - 2048, b = row >> 11, t = row & (SEQ - 1);
            *(u32x4*)(K + ((size_t)(b * NH + (c >> 6)) * LP + 32 + t) * HD + (c & 63)) = pack8bf(l0, l1);
            *(u32x4*)(K + ((size_t)(b * NH + ((c + 128) >> 6)) * LP + 32 + t) * HD + (c & 63)) = pack8bf(h0, h1); }
        else { const int c = col - 2560, b = row >> 11, t = row & (SEQ - 1);
            bf16_t* p0 = V + ((size_t)(b * NH + (c >> 6)) * HD + (c & 63)) * LP + 32 + t; bf16_t* p1 = V + ((size_t)(b * NH + ((c + 128) >> 6)) * HD + (c & 63)) * LP + 32 + t;
            p0[0] = (bf16_t)f2bf(l0.x); p0[LP] = (bf16_t)f2bf(l0.y); p0[2 * LP] = (bf16_t)f2bf(l0.z); p0[3 * LP] = (bf16_t)f2bf(l0.w);
            p0[4 * LP] = (bf16_t)f2bf(l1.x); p0[5 * LP] = (bf16_t)f2bf(l1.y); p0[6 * LP] = (bf16_t)f2bf(l1.z); p0[7 * LP] = (bf16_t)f2bf(l1.w);
            p1[0] = (bf16_t)f2bf(h0.x); p1[LP] = (bf16_t)f2bf(h0.y); p1[2 * LP] = (bf16_t)f2bf(h0.z); p1[3 * LP] = (bf16_t)f2bf(h0.w);
            p1[4 * LP] = (bf16_t)f2bf(h1.x); p1[5 * LP] = (bf16_t)f2bf(h1.y); p1[6 * LP] = (bf16_t)f2bf(h1.z); p1[7 * LP] = (bf16_t)f2bf(h1.w); }
    }
};
struct Epi1g {
    unsigned char *SGA, *SGB;
    __device__ __forceinline__ void operator()(int row, int col, int pn, int wc, f32x4 l0, f32x4 l1, f32x4 h0, f32x4 h1) const {
        constexpr float r = 1.0f / (GATE_WSCALE * XN8_SCALE);
        unsigned char* p = (pn < 4 ? SGA : SGB) + (size_t)row * D + (col & 1023); u32x2 a, b; a.x = sig4u8(l0 * r); a.y = sig4u8(l1 * r); b.x = sig4u8(h0 * r); b.y = sig4u8(h1 * r); *(u32x2*)p = a; *(u32x2*)(p + 128) = b;
    }
};
struct EpiNull { float* sink; __device__ __forceinline__ void operator()(int row, int col, int pn, int wc, f32x4 l0, f32x4 l1, f32x4 h0, f32x4 h1) const { const f32x4 t = l0 + l1 + h0 + h1; if (t.x == 1234.5f) sink[0] = t.y; } };
struct Epi3a {
    bf16_t* MIX; const unsigned char* SGA; const unsigned char* SGB;
    __device__ __forceinline__ void operator()(int row, int col, int pn, int wc, f32x4 l0, f32x4 l1, f32x4 h0, f32x4 h1) const {
        const bool add = pn >= 64;
        bf16_t* p = MIX + (size_t)row * D + col; const unsigned char* s = (add ? SGB : SGA) + (size_t)row * D + col;
        const u32x2 ga = *(const u32x2*)s, gb = *(const u32x2*)(s + 128);
        l0 = l0 * u8x4f(ga.x); l1 = l1 * u8x4f(ga.y); h0 = h0 * u8x4f(gb.x); h1 = h1 * u8x4f(gb.y);
        if (add) { f32x4 a, b, c, d; unpack8bf(*(const u32x4*)p, a, b); unpack8bf(*(const u32x4*)(p + 128), c, d); l0 += a; l1 += b; h0 += c; h1 += d; }
        *(u32x4*)p = pack8bf(l0, l1); *(u32x4*)(p + 128) = pack8bf(h0, h1);
    }
};
struct Epi3b {
    const float* x; f16_t* X1H; float* SS2; unsigned char* X18;
    __device__ __forceinline__ void operator()(int row, int col, int pn, int wc, f32x4 l0, f32x4 l1, f32x4 h0, f32x4 h1) const {
        const float* xp = x + (size_t)row * D + col; f16_t* hp = X1H + (size_t)row * D + col;
        l0 += *(const f32x4*)xp; l1 += *(const f32x4*)(xp + 4); h0 += *(const f32x4*)(xp + 128); h1 += *(const f32x4*)(xp + 132);
        *(u32x4*)hp = pack8h(l0, l1); *(u32x4*)(hp + 128) = pack8h(h0, h1);
        { unsigned char* bp = X18 + (size_t)row * D + col; u32x2 a, b; const f32x4 m0 = l0 * 4.f, m1 = l1 * 4.f, m2 = h0 * 4.f, m3 = h1 * 4.f;
          a.x = (unsigned)__builtin_amdgcn_cvt_pk_fp8_f32(m0.z, m0.w, __builtin_amdgcn_cvt_pk_fp8_f32(m0.x, m0.y, 0, false), true); a.y = (unsigned)__builtin_amdgcn_cvt_pk_fp8_f32(m1.z, m1.w, __builtin_amdgcn_cvt_pk_fp8_f32(m1.x, m1.y, 0, false), true);
          b.x = (unsigned)__builtin_amdgcn_cvt_pk_fp8_f32(m2.z, m2.w, __builtin_amdgcn_cvt_pk_fp8_f32(m2.x, m2.y, 0, false), true); b.y = (unsigned)__builtin_amdgcn_cvt_pk_fp8_f32(m3.z, m3.w, __builtin_amdgcn_cvt_pk_fp8_f32(m3.x, m3.y, 0, false), true);
          *(u32x2*)bp = a; *(u32x2*)(bp + 128) = b; }
        float s = (l0.x * l0.x + l0.y * l0.y) + (l0.z * l0.z + l0.w * l0.w) + (l1.x * l1.x + l1.y * l1.y) + (l1.z * l1.z + l1.w * l1.w)
                + (h0.x * h0.x + h0.y * h0.y) + (h0.z * h0.z + h0.w * h0.w) + (h1.x * h1.x + h1.y * h1.y) + (h1.z * h1.z + h1.w * h1.w);
        s += __shfl_xor(s, 16); s += __shfl_xor(s, 32);
        if (lane_id() < 16) SS2[(size_t)row * 16 + pn * 4 + wc] = s;
    }
};
__device__ __forceinline__ float rstd2_of(const float* SS2, int row) {
    const f32x4* p = (const f32x4*)(SS2 + (size_t)row * 16); const f32x4 a = p[0], b = p[1], c = p[2], d = p[3];
    const float s = ((a.x + a.y) + (a.z + a.w)) + ((b.x + b.y) + (b.z + b.w)) + ((c.x + c.y) + (c.z + c.w)) + ((d.x + d.y) + (d.z + d.w));
    return 1.0f / sqrtf(s * (1.0f / D) + EPS);
}
struct Epi4 {
    f16_t* QP;
    __device__ __forceinline__ void operator()(int row, int col, int pn, int wc, f32x4 l0, f32x4 l1, f32x4 h0, f32x4 h1) const {
        f16_t* p = QP + (size_t)row * 2048 + col;
        *(u32x4*)p = pack8h(l0, l1); *(u32x4*)(p + 128) = pack8h(h0, h1);
    }
};

__device__ __forceinline__ void phase2(Ctx& F) {
    const bf16_t* BA = (const bf16_t*)(F.ws + WS_B); const bf16_t* CU = BA + (size_t)M * CW; const bf16_t* Q = CU + (size_t)M * CW;
    bf16_t* O = (bf16_t*)(F.ws + WS_A); bf16_t* YA = O + (size_t)M * CW;
    const bf16_t* MK = (const bf16_t*)(F.ws + WS_META); const bf16_t* MV = MK + 16 * 512; const float* MCA = (const float*)(MV + 16 * 512); const float* MUA = MCA + 16 * 512;
    {
        const int gt = blockIdx.x * NTHR + F.tid, NT = F.G * NTHR;
        for (int it = gt; it < (M / 8) * 64; it += NT) {
            const int strip = it >> 6, c = (it & 63) * 8, r0 = strip * 8, t0 = r0 & (SEQ - 1);
            u32x4 cu[8], ba[8];
#pragma unroll
            for (int q = 0; q < 8; ++q) { cu[q] = *(const u32x4*)(CU + (size_t)(r0 + q) * CW + c); ba[q] = *(const u32x4*)(BA + (size_t)(r0 + q) * CW + c); }
            const f32x4 wa0 = *(const f32x4*)(F.conv_w + c), wa1 = *(const f32x4*)(F.conv_w + c + 4), wb0 = *(const f32x4*)(F.conv_w + CW + c), wb1 = *(const f32x4*)(F.conv_w + CW + c + 4),
                        wc0 = *(const f32x4*)(F.conv_w + 2 * CW + c), wc1 = *(const f32x4*)(F.conv_w + 2 * CW + c + 4);
            f32x4 p2a, p2b, p1a, p1b;
            if (t0 != 0) { unpack8bf(*(const u32x4*)(CU + (size_t)(r0 - 2) * CW + c), p2a, p2b); unpack8bf(*(const u32x4*)(CU + (size_t)(r0 - 1) * CW + c), p1a, p1b); }
            else { p2a = *(const f32x4*)(MCA + 14 * 512 + c) * *(const f32x4*)(MUA + 14 * 512 + c); p2b = *(const f32x4*)(MCA + 14 * 512 + c + 4) * *(const f32x4*)(MUA + 14 * 512 + c + 4);
                   p1a = *(const f32x4*)(MCA + 15 * 512 + c) * *(const f32x4*)(MUA + 15 * 512 + c); p1b = *(const f32x4*)(MCA + 15 * 512 + c + 4) * *(const f32x4*)(MUA + 15 * 512 + c + 4); }
#pragma unroll
            for (int q = 0; q < 8; ++q) {
                f32x4 ca, cb, ga, gb; unpack8bf(cu[q], ca, cb); unpack8bf(ba[q], ga, gb);
                const f32x4 ya = ga * (wa0 * p2a + wb0 * p1a + wc0 * ca), yb = gb * (wa1 * p2b + wb1 * p1b + wc1 * cb);
                *(u32x4*)(YA + (size_t)(r0 + q) * CW + c) = pack8bf(ya, yb);
                p2a = p1a; p2b = p1b; p1a = ca; p1b = cb;
            }
        }
    }
    {
        const bf16_t* KU = (const bf16_t*)(F.ws + WS_KU); const bf16_t* VT = (const bf16_t*)(F.ws + WS_VT);
        const int r = F.lane & 31, hh = F.lane >> 5;
        for (int item = F.gw; item < 64 * 64; item += F.NGW) {
            const int bh = item >> 6, a = item & 63, b = bh >> 3, h = bh & 7;
            const bf16_t* qp = Q + (size_t)(b * SEQ + 32 * a + r) * CW + h * HD + 8 * hh;
            bf16x8 qf[4];
#pragma unroll
            for (int kk = 0; kk < 4; ++kk) qf[kk] = *(const bf16x8*)(qp + 16 * kk);
            const bf16_t* kb = KU + (size_t)bh * LP * HD + (size_t)r * HD + 8 * hh;
            const bf16_t* vb0 = VT + ((size_t)bh * HD + r) * LP + 4 * hh;
            f32x16 o0, o1;
#pragma unroll
            for (int i = 0; i < 16; ++i) { o0[i] = 0.f; o1[i] = 0.f; }
            float carry = 0.f;
            bf16x8 kA[4], kB[4]; u32x2 vA[8], vB[8];
#define AT_LOAD(jj, KF, VF) do { const int _j = (jj); _Pragma("unroll") for (int kk = 0; kk < 4; ++kk) KF[kk] = *(const bf16x8*)(kb + (size_t)(32 * _j) * HD + 16 * kk); \
                _Pragma("unroll") for (int mt = 0; mt < 2; ++mt) _Pragma("unroll") for (int st = 0; st < 2; ++st) { const bf16_t* vp = vb0 + (size_t)mt * 32 * LP + 32 * _j + 16 * st; \
                    VF[(mt * 2 + st) * 2] = *(const u32x2*)vp; VF[(mt * 2 + st) * 2 + 1] = *(const u32x2*)(vp + 8); } } while (0)
#define AT_TILE(jj, KF, VF) do { const int jt = (jj); f32x16 sc; \
                _Pragma("unroll") for (int i = 0; i < 16; ++i) sc[i] = 0.f; \
                _Pragma("unroll") for (int kk = 0; kk < 4; ++kk) sc = __builtin_amdgcn_mfma_f32_32x32x16_bf16(KF[kk], qf[kk], sc, 0, 0, 0); \
                float lm[16], ls[16], ex[16], gs[4], pg[4]; \
                const bool diag = (jt == a + 1), first = (jt == 0); \
                _Pragma("unroll") for (int i = 0; i < 16; ++i) { \
                    const int key = (i & 3) + 8 * (i >> 2) + 4 * hh; \
                    const bool valid = diag ? (key < r) : (first ? (key >= 16) : true); \
                    const float z = sc[i]; \
                    const float sp = fmaxf(z, 0.f) + __logf(1.0f + __expf(-fabsf(z))); \
                    lm[i] = valid ? -sp : 0.f; ls[i] = valid ? (z - sp) : -1.0e30f; } \
                _Pragma("unroll") for (int g = 0; g < 4; ++g) { ex[4 * g + 3] = 0.f; ex[4 * g + 2] = lm[4 * g + 3]; ex[4 * g + 1] = ex[4 * g + 2] + lm[4 * g + 2]; ex[4 * g] = ex[4 * g + 1] + lm[4 * g + 1]; gs[g] = ex[4 * g] + lm[4 * g]; } \
                _Pragma("unroll") for (int g = 0; g < 4; ++g) pg[g] = __shfl_xor(gs[g], 32); \
                float os[4], pi[4], off[4]; \
                os[3] = 0.f; os[2] = gs[3]; os[1] = os[2] + gs[2]; os[0] = os[1] + gs[1]; \
                pi[3] = pg[3]; pi[2] = pi[3] + pg[2]; pi[1] = pi[2] + pg[1]; pi[0] = pi[1] + pg[0]; \
                _Pragma("unroll") for (int g = 0; g < 4; ++g) off[g] = carry + os[g] + (hh == 0 ? pi[g] : (pi[g] - pg[g])); \
                const float total = os[0] + gs[0] + pi[0]; \
                float pv[16]; \
                _Pragma("unroll") for (int i = 0; i < 16; ++i) pv[i] = __expf(ls[i] + off[i >> 2] + ex[i]); \
                carry += total; \
                bf16x8 pf[2]; \
                _Pragma("unroll") for (int st = 0; st < 2; ++st) { u32x4 w; w.x = pk2bf(pv[8 * st], pv[8 * st + 1]); w.y = pk2bf(pv[8 * st + 2], pv[8 * st + 3]); w.z = pk2bf(pv[8 * st + 4], pv[8 * st + 5]); w.w = pk2bf(pv[8 * st + 6], pv[8 * st + 7]); pf[st] = __builtin_bit_cast(bf16x8, w); } \
                _Pragma("unroll") for (int st = 0; st < 2; ++st) { \
                    u32x4 w0; w0.x = VF[st * 2].x; w0.y = VF[st * 2].y; w0.z = VF[st * 2 + 1].x; w0.w = VF[st * 2 + 1].y; \
                    u32x4 w1; w1.x = VF[(2 + st) * 2].x; w1.y = VF[(2 + st) * 2].y; w1.z = VF[(2 + st) * 2 + 1].x; w1.w = VF[(2 + st) * 2 + 1].y; \
                    o0 = __builtin_amdgcn_mfma_f32_32x32x16_bf16(__builtin_bit_cast(bf16x8, w0), pf[st], o0, 0, 0, 0); \
                    o1 = __builtin_amdgcn_mfma_f32_32x32x16_bf16(__builtin_bit_cast(bf16x8, w1), pf[st], o1, 0, 0, 0); } \
            } while (0)
            int j = a + 1;
            AT_LOAD(j, kA, vA);
            for (;;) {
                AT_LOAD(j > 0 ? j - 1 : 0, kB, vB);
                AT_TILE(j, kA, vA);
                if (j == 0 || __all(carry < -SB_THR)) break;
                --j;
                AT_LOAD(j > 0 ? j - 1 : 0, kA, vA);
                AT_TILE(j, kB, vB);
                if (j == 0 || __all(carry < -SB_THR)) break;
                --j;
            }
#undef AT_LOAD
#undef AT_TILE
            bf16_t* op = O + (size_t)(b * SEQ + 32 * a + r) * CW + h * HD + 4 * hh;
#pragma unroll
            for (int g = 0; g < 4; ++g) {
                u32x2 w0, w1; w0.x = pk2bf(o0[4 * g], o0[4 * g + 1]); w0.y = pk2bf(o0[4 * g + 2], o0[4 * g + 3]); w1.x = pk2bf(o1[4 * g], o1[4 * g + 1]); w1.y = pk2bf(o1[4 * g + 2], o1[4 * g + 3]);
                *(u32x2*)(op + 8 * g) = w0; *(u32x2*)(op + 32 + 8 * g) = w1;
            }
        }
    }
}

__device__ __forceinline__ unsigned ord_key(float s) { const unsigned u = __builtin_bit_cast(unsigned, s); return u ^ ((unsigned)((int)u >> 31) | 0x80000000u); }
__device__ __forceinline__ float ord_val(unsigned k) { const unsigned u = (k & 0x80000000u) ? (k ^ 0x80000000u) : ~k; return __builtin_bit_cast(float, u); }
#define CE(a, b) do { const unsigned _x = (a), _y = (b); (a) = _x > _y ? _x : _y; (b) = _x > _y ? _y : _x; } while (0)
#define SORT16(v) do { CE(v[0], v[1]); CE(v[2], v[3]); CE(v[0], v[2]); CE(v[1], v[3]); CE(v[1], v[2]); CE(v[4], v[5]); CE(v[6], v[7]); CE(v[4], v[6]); CE(v[5], v[7]); CE(v[5], v[6]); CE(v[0], v[4]); CE(v[2], v[6]); CE(v[2], v[4]); CE(v[1], v[5]); CE(v[3], v[7]); CE(v[3], v[5]); CE(v[1], v[2]); CE(v[3], v[4]); CE(v[5], v[6]); CE(v[8], v[9]); CE(v[10], v[11]); CE(v[8], v[10]); CE(v[9], v[11]); CE(v[9], v[10]); CE(v[12], v[13]); CE(v[14], v[15]); CE(v[12], v[14]); CE(v[13], v[15]); CE(v[13], v[14]); CE(v[8], v[12]); CE(v[10], v[14]); CE(v[10], v[12]); CE(v[9], v[13]); CE(v[11], v[15]); CE(v[11], v[13]); CE(v[9], v[10]); CE(v[11], v[12]); CE(v[13], v[14]); CE(v[0], v[8]); CE(v[4], v[12]); CE(v[4], v[8]); CE(v[2], v[10]); CE(v[6], v[14]); CE(v[6], v[10]); CE(v[2], v[4]); CE(v[6], v[8]); CE(v[10], v[12]); CE(v[1], v[9]); CE(v[5], v[13]); CE(v[5], v[9]); CE(v[3], v[11]); CE(v[7], v[15]); CE(v[7], v[11]); CE(v[3], v[5]); CE(v[7], v[9]); CE(v[11], v[13]); CE(v[1], v[2]); CE(v[3], v[4]); CE(v[5], v[6]); CE(v[7], v[8]); CE(v[9], v[10]); CE(v[11], v[12]); CE(v[13], v[14]); } while (0)
#define BMERGE16(v) do { CE(v[0], v[8]); CE(v[1], v[9]); CE(v[2], v[10]); CE(v[3], v[11]); CE(v[4], v[12]); CE(v[5], v[13]); CE(v[6], v[14]); CE(v[7], v[15]); CE(v[0], v[4]); CE(v[1], v[5]); CE(v[2], v[6]); CE(v[3], v[7]); CE(v[8], v[12]); CE(v[9], v[13]); CE(v[10], v[14]); CE(v[11], v[15]); CE(v[0], v[2]); CE(v[1], v[3]); CE(v[4], v[6]); CE(v[5], v[7]); CE(v[8], v[10]); CE(v[9], v[11]); CE(v[12], v[14]); CE(v[13], v[15]); CE(v[0], v[1]); CE(v[2], v[3]); CE(v[4], v[5]); CE(v[6], v[7]); CE(v[8], v[9]); CE(v[10], v[11]); CE(v[12], v[13]); CE(v[14], v[15]); } while (0)

#define MERGE_TOP16(a, b) do { _Pragma("unroll") for (int _i = 0; _i < 16; ++_i) { const unsigned _p = (a)[_i], _q = (b)[15 - _i]; (a)[_i] = _p > _q ? _p : _q; } BMERGE16(a); } while (0)
__device__ static constexpr int CAND_I[50] = {0, 0, 0, 0, 0, 0, 0, 0, 0, 0, 0, 0, 0, 0, 0, 0, 1, 1, 1, 1, 1, 1, 1, 1, 2, 2, 2, 2, 2, 3, 3, 3, 3, 4, 4, 4, 5, 5, 6, 6, 7, 7, 8, 9, 10, 11, 12, 13, 14, 15};
__device__ static constexpr int CAND_J[50] = {0, 1, 2, 3, 4, 5, 6, 7, 8, 9, 10, 11, 12, 13, 14, 15, 0, 1, 2, 3, 4, 5, 6, 7, 0, 1, 2, 3, 4, 0, 1, 2, 3, 0, 1, 2, 0, 1, 0, 1, 0, 1, 0, 0, 0, 0, 0, 0, 0, 0};

__device__ __forceinline__ void phase5_stage(Ctx& F) {
    const f16_t* SKB = (const f16_t*)(F.ws + WS_SKB);
    const int h = blockIdx.x & 7;
    const u32x4* src = (const u32x4*)(SKB + (size_t)(h * 2) * 128 * 128);
    u32x4 t[8];
#pragma unroll
    for (int i = 0; i < 8; ++i) t[i] = src[F.tid + NTHR * i];
#pragma unroll
    for (int i = 0; i < 8; ++i) { const int c = F.tid + NTHR * i, row = c >> 4, ch = c & 15; *(LAS u32x4*)(F.lds + row * 272 + ch * 16) = t[i]; }
    __syncthreads();
}
__device__ __forceinline__ void phase5(Ctx& F) {
    const f16_t* QP = (const f16_t*)(F.ws + WS_B);
    u16* EIDX = (u16*)(F.ws + WS_E); float* GATE = (float*)(F.ws + WS_GATE);
    const int r = F.lane & 31, hh = F.lane >> 5;
    LAS unsigned char* tab = F.lds + 73728 + F.wave * 2048 + F.lane * 32;
    const int h = blockIdx.x & 7, nbh = F.G >> 3;
    for (int tg = (blockIdx.x >> 3) + nbh * F.wave; tg < 512; tg += nbh * NWAVES) {
        const int tok = tg * 32 + r;
        unsigned T0[16], T1[16];
#pragma unroll
        for (int p = 0; p < 2; ++p) {
            const int g = h * 2 + p;
            f32x16 acc[4];
#pragma unroll
            for (int mt = 0; mt < 4; ++mt)
#pragma unroll
                for (int i = 0; i < 16; ++i) acc[mt][i] = 0.f;
            const f16_t* qp = QP + (size_t)tok * 2048 + g * 128 + 8 * hh;
            const LAS unsigned char* kp = F.lds + (p * 128 + r) * 272 + 16 * hh;
#pragma unroll
            for (int kk = 0; kk < 8; ++kk) {
                const f16x8 qf = *(const f16x8*)(qp + 16 * kk);
#pragma unroll
                for (int mt = 0; mt < 4; ++mt) { const f16x8 kf = *(const LAS f16x8*)(kp + mt * 32 * 272 + 32 * kk); acc[mt] = __builtin_amdgcn_mfma_f32_32x32x16_f16(kf, qf, acc[mt], 0, 0, 0); }
            }
            unsigned cur[16], nxt[16];
#pragma unroll
            for (int mt = 0; mt < 4; ++mt) {
#pragma unroll
                for (int i = 0; i < 16; ++i) { const int kc = 127 - (32 * mt + (i & 3) + 8 * (i >> 2)); nxt[i] = (ord_key(acc[mt][i]) & ~127u) | (unsigned)(kc - 4 * hh); }
                SORT16(nxt);
                if (mt == 0) {
#pragma unroll
                    for (int i = 0; i < 16; ++i) cur[i] = nxt[i];
                } else MERGE_TOP16(cur, nxt);
            }
#pragma unroll
            for (int i = 0; i < 16; ++i) nxt[i] = (unsigned)__shfl_xor((int)cur[i], 32);
            MERGE_TOP16(cur, nxt);
#pragma unroll
            for (int i = 0; i < 16; ++i) { if (p == 0) T0[i] = cur[i]; else T1[i] = cur[i]; }
        }
        {
            u32x4 w0, w1, w2, w3;
            w0.x = (T0[0] & 127u) | ((T0[1] & 127u) << 8) | ((T0[2] & 127u) << 16) | ((T0[3] & 127u) << 24); w0.y = (T0[4] & 127u) | ((T0[5] & 127u) << 8) | ((T0[6] & 127u) << 16) | ((T0[7] & 127u) << 24);
            w0.z = (T0[8] & 127u) | ((T0[9] & 127u) << 8) | ((T0[10] & 127u) << 16) | ((T0[11] & 127u) << 24); w0.w = (T0[12] & 127u) | ((T0[13] & 127u) << 8) | ((T0[14] & 127u) << 16) | ((T0[15] & 127u) << 24);
            w1.x = (T1[0] & 127u) | ((T1[1] & 127u) << 8) | ((T1[2] & 127u) << 16) | ((T1[3] & 127u) << 24); w1.y = (T1[4] & 127u) | ((T1[5] & 127u) << 8) | ((T1[6] & 127u) << 16) | ((T1[7] & 127u) << 24);
            w1.z = (T1[8] & 127u) | ((T1[9] & 127u) << 8) | ((T1[10] & 127u) << 16) | ((T1[11] & 127u) << 24); w1.w = (T1[12] & 127u) | ((T1[13] & 127u) << 8) | ((T1[14] & 127u) << 16) | ((T1[15] & 127u) << 24);
            *(LAS u32x4*)tab = w0; *(LAS u32x4*)(tab + 16) = w1; (void)w2; (void)w3;
        }
        float s0[16], s1[16];
#pragma unroll
        for (int i = 0; i < 16; ++i) { s0[i] = ord_val(T0[i] & ~127u); s1[i] = ord_val(T1[i] & ~127u); }
        unsigned c0[16], c1[16];
#pragma unroll
        for (int c = 0; c < 16; ++c) c0[c] = (ord_key(s0[CAND_I[c]] + s1[CAND_J[c]]) & ~255u) | (unsigned)(255 - (CAND_I[c] * 16 + CAND_J[c]));
        SORT16(c0);
#pragma unroll
        for (int c = 0; c < 16; ++c) c1[c] = (ord_key(s0[CAND_I[16 + c]] + s1[CAND_J[16 + c]]) & ~255u) | (unsigned)(255 - (CAND_I[16 + c] * 16 + CAND_J[16 + c]));
        SORT16(c1); MERGE_TOP16(c0, c1);
#pragma unroll
        for (int c = 0; c < 16; ++c) c1[c] = (ord_key(s0[CAND_I[32 + c]] + s1[CAND_J[32 + c]]) & ~255u) | (unsigned)(255 - (CAND_I[32 + c] * 16 + CAND_J[32 + c]));
        SORT16(c1); MERGE_TOP16(c0, c1);
#pragma unroll
        for (int c = 0; c < 16; ++c) c1[c] = 0u;
        c1[0] = (ord_key(s0[CAND_I[48]] + s1[CAND_J[48]]) & ~255u) | (unsigned)(255 - (CAND_I[48] * 16 + CAND_J[48]));
        c1[1] = (ord_key(s0[CAND_I[49]] + s1[CAND_J[49]]) & ~255u) | (unsigned)(255 - (CAND_I[49] * 16 + CAND_J[49]));
        CE(c1[0], c1[1]); MERGE_TOP16(c0, c1);
        float sc[16]; unsigned eid[16];
        asm volatile("s_waitcnt lgkmcnt(0)" ::: "memory");
#pragma unroll
        for (int k = 0; k < 16; ++k) {
            const unsigned ci = 255u - (c0[k] & 255u);
            const unsigned b0 = tab[ci >> 4], b1 = tab[16 + (ci & 15u)];
            eid[k] = (127u - b0) * 128u + (127u - b1);
            sc[k] = ord_val(c0[k] & ~255u);
        }
        float sum = 0.f; const float mx = sc[0], r2 = rstd2_of((const float*)(F.ws + WS_SS2), tok);
#pragma unroll
        for (int k = 0; k < 16; ++k) { sc[k] = __expf((sc[k] - mx) * r2); sum += sc[k]; }
        const float inv = 1.0f / sum;
        if (hh == 0) {
            u32x4 w0, w1;
            w0.x = eid[0] | (eid[1] << 16); w0.y = eid[2] | (eid[3] << 16); w0.z = eid[4] | (eid[5] << 16); w0.w = eid[6] | (eid[7] << 16);
            w1.x = eid[8] | (eid[9] << 16); w1.y = eid[10] | (eid[11] << 16); w1.z = eid[12] | (eid[13] << 16); w1.w = eid[14] | (eid[15] << 16);
            u32x4* ep = (u32x4*)(EIDX + (size_t)tok * NSEL + h * 16); ep[0] = w0; ep[1] = w1;
        } else {
            f32x4* gp = (f32x4*)(GATE + (size_t)tok * NSEL + h * 16);
            gp[0] = (f32x4){sc[0] * inv, sc[1] * inv, sc[2] * inv, sc[3] * inv}; gp[1] = (f32x4){sc[4] * inv, sc[5] * inv, sc[6] * inv, sc[7] * inv};
            gp[2] = (f32x4){sc[8] * inv, sc[9] * inv, sc[10] * inv, sc[11] * inv}; gp[3] = (f32x4){sc[12] * inv, sc[13] * inv, sc[14] * inv, sc[15] * inv};
        }
    }
}

__device__ __forceinline__ float gelu_tanh(float x) { const float u = 0.7978845608028654f * (x + 0.044715f * x * x * x); return 0.5f * x * (1.0f + tanhf(u)); }
__device__ __forceinline__ unsigned e16_of(const u32x4& a, const u32x4& b, int i) {
    const unsigned w = (i < 8) ? ((i >> 1) == 0 ? a.x : (i >> 1) == 1 ? a.y : (i >> 1) == 2 ? a.z : a.w) : (((i - 8) >> 1) == 0 ? b.x : ((i - 8) >> 1) == 1 ? b.y : ((i - 8) >> 1) == 2 ? b.z : b.w);
    return (i & 1) ? (w >> 16) : (w & 0xffffu);
}
#ifndef FP4_SWAP
#define FP4_SWAP 0
#endif
__device__ __forceinline__ f16x2 fp4h2(unsigned w, int b) {
    const f16x2 r = b == 0 ? __builtin_amdgcn_cvt_scalef32_pk_f16_fp4(w, 1.0f, 0) : b == 1 ? __builtin_amdgcn_cvt_scalef32_pk_f16_fp4(w, 1.0f, 1) : b == 2 ? __builtin_amdgcn_cvt_scalef32_pk_f16_fp4(w, 1.0f, 2) : __builtin_amdgcn_cvt_scalef32_pk_f16_fp4(w, 1.0f, 3);
    return FP4_SWAP ? (f16x2){r[1], r[0]} : r;
}
#define UM_IDX(k, E) do { E = *(const u32x4*)(EIDX + (size_t)(tok0 + (k) * nws) * NSEL + 8 * cA); } while (0)
#define UM_ISSUE(k, UV, XB, E) do { const u32x4* _xp = (const u32x4*)(X18 + (size_t)(tok0 + (k) * nws) * D + slice * 256 + xoff); \
        _Pragma("unroll") for (int _g = 0; _g < 8; ++_g) { const unsigned _w = (_g >> 1) == 0 ? E.x : (_g >> 1) == 1 ? E.y : (_g >> 1) == 2 ? E.z : E.w; \
            const unsigned char* _r = ub + (size_t)((_g & 1) ? (_w >> 16) : (_w & 0xffffu)) * 128; UV[2 * _g] = *(const u32x4*)_r; UV[2 * _g + 1] = *(const u32x4*)(_r + 64); } \
        XB[0] = _xp[0]; XB[1] = _xp[8]; } while (0)
#define UM_CONSUME(k, UV, XB) do { float dv[8]; \
        i32x8 bx0, bx1; \
        bx0[0] = inLo ? XB[0].x : 0u; bx0[1] = inLo ? XB[0].y : 0u; bx0[2] = inLo ? XB[0].z : 0u; bx0[3] = inLo ? XB[0].w : 0u; bx0[4] = inHi ? XB[0].x : 0u; bx0[5] = inHi ? XB[0].y : 0u; bx0[6] = inHi ? XB[0].z : 0u; bx0[7] = inHi ? XB[0].w : 0u; \
        bx1[0] = inLo ? XB[1].x : 0u; bx1[1] = inLo ? XB[1].y : 0u; bx1[2] = inLo ? XB[1].z : 0u; bx1[3] = inLo ? XB[1].w : 0u; bx1[4] = inHi ? XB[1].x : 0u; bx1[5] = inHi ? XB[1].y : 0u; bx1[6] = inHi ? XB[1].z : 0u; bx1[7] = inHi ? XB[1].w : 0u; \
        _Pragma("unroll") for (int _g = 0; _g < 8; ++_g) { \
            i32x8 ax; ax[0] = UV[2 * _g].x; ax[1] = UV[2 * _g].y; ax[2] = UV[2 * _g].z; ax[3] = UV[2 * _g].w; ax[4] = 0; ax[5] = 0; ax[6] = 0; ax[7] = 0; \
            f32x4 z = {0.f, 0.f, 0.f, 0.f}; \
            z = __builtin_amdgcn_mfma_scale_f32_16x16x128_f8f6f4(ax, bx0, z, 4, 0, 0, 0, 0, 0); \
            ax[0] = UV[2 * _g + 1].x; ax[1] = UV[2 * _g + 1].y; ax[2] = UV[2 * _g + 1].z; ax[3] = UV[2 * _g + 1].w; \
            z = __builtin_amdgcn_mfma_scale_f32_16x16x128_f8f6f4(ax, bx1, z, 4, 0, 0, 0, 0, 0); \
            float v = bq == 0 ? z.x : bq == 1 ? z.y : bq == 2 ? z.z : z.w; \
            v += __builtin_bit_cast(float, __builtin_amdgcn_update_dpp(0, __builtin_bit_cast(int, v), 0xB1, 0xf, 0xf, true)); \
            v += __builtin_bit_cast(float, __builtin_amdgcn_update_dpp(0, __builtin_bit_cast(int, v), 0x4E, 0xf, 0xf, true)); \
            dv[_g] = v; } \
        if (storer) { u32x4 o0; o0.x = pk2h(dv[0], dv[1]); o0.y = pk2h(dv[2], dv[3]); o0.z = pk2h(dv[4], dv[5]); o0.w = pk2h(dv[6], dv[7]); \
            *(u32x4*)(DOTP + ((size_t)(tok0 + (k) * nws) * 4 + slice) * NSEL + 8 * cD) = o0; } } while (0)
__device__ __forceinline__ void phaseU(Ctx& F) {
    const unsigned char* U4 = F.ws + WS_T; const u16* EIDX = (const u16*)(F.ws + WS_E); f16_t* DOTP = (f16_t*)(F.ws + WS_B); const unsigned char* X18 = F.ws + WS_X18;
    const int xl = blockIdx.x & 7, slice = xl & 3, nws = (F.G >> 3) * NWAVES, tok0 = (xl >> 2) * (M / 2) + (blockIdx.x >> 3) * NWAVES + F.wave;
    const int rho = F.lane & 15, kg = F.lane >> 4, bq = rho & 3, aq = rho >> 2;
    const int cA = 4 * aq + kg;
    const int cD = 4 * kg + aq;
    const bool inLo = aq == (kg >> 1), inHi = aq == 2 + (kg >> 1);
    const int xoff = 32 * bq + 16 * (kg & 1);
    const bool storer = bq == 0;
    const unsigned char* ub = U4 + (size_t)slice * (NEXP * 128) + bq * 16;
    const int N = (M / 2 - ((blockIdx.x >> 3) * NWAVES + F.wave) + nws - 1) / nws;
    if (N <= 0) return;
    u32x4 uvA[16], uvB[16]; u32x4 xA[2], xB[2]; u32x4 eA, eB;
    int k0 = 0;
    if (N & 1) { UM_IDX(0, eA); UM_ISSUE(0, uvA, xA, eA); UM_CONSUME(0, uvA, xA); k0 = 1; if (N == 1) return; }
    const int L = N - 1;
    UM_IDX(k0, eA);
    UM_IDX(k0 + 1, eB);
    UM_ISSUE(k0, uvA, xA, eA);
    for (int n = k0; n < N; n += 2) {
        UM_IDX(min(n + 2, L), eA);
        UM_ISSUE(n + 1, uvB, xB, eB);
        UM_CONSUME(n, uvA, xA);
        UM_IDX(min(n + 3, L), eB);
        UM_ISSUE(min(n + 2, L), uvA, xA, eA);
        UM_CONSUME(n + 1, uvB, xB);
    }
}
__device__ __forceinline__ void phaseW(Ctx& F) {
    const f16_t* DOTP = (const f16_t*)(F.ws + WS_B); const float* GATE = (const float*)(F.ws + WS_GATE); const float* SS2 = (const float*)(F.ws + WS_SS2); unsigned char* W8 = F.ws + WS_WGT;
    const u16* EIDX = (const u16*)(F.ws + WS_E); const float* SU = (const float*)(F.ws + WS_T + 16 * MiB); const float* SV = SU + NEXP;
    for (int tok0 = F.gw; tok0 < M; tok0 += 4 * F.NGW) {
        unsigned dp[4][4], ee[4]; f32x2 gt[4]; f32x4 ss[4][4];
#pragma unroll
        for (int u = 0; u < 4; ++u) {
            const int tok = min(tok0 + u * F.NGW, M - 1);
#pragma unroll
            for (int sl = 0; sl < 4; ++sl) dp[u][sl] = *(const unsigned*)(DOTP + ((size_t)tok * 4 + sl) * NSEL + 2 * F.lane);
            gt[u] = *(const f32x2*)(GATE + (size_t)tok * NSEL + 2 * F.lane);
            ee[u] = *(const unsigned*)(EIDX + (size_t)tok * NSEL + 2 * F.lane);
#pragma unroll
            for (int q = 0; q < 4; ++q) ss[u][q] = ((const f32x4*)(SS2 + (size_t)tok * 16))[q];
        }
        float su0[4], su1[4], sv0[4], sv1[4];
#pragma unroll
        for (int u = 0; u < 4; ++u) { const unsigned e0 = ee[u] & 0xffffu, e1 = ee[u] >> 16; su0[u] = SU[e0]; su1[u] = SU[e1]; sv0[u] = SV[e0]; sv1[u] = SV[e1]; }
#pragma unroll
        for (int u = 0; u < 4; ++u) {
            const int tok = tok0 + u * F.NGW;
            const f32x4 a = ss[u][0], b = ss[u][1], c = ss[u][2], d = ss[u][3];
            const float sq = ((a.x + a.y) + (a.z + a.w)) + ((b.x + b.y) + (b.z + b.w)) + ((c.x + c.y) + (c.z + c.w)) + ((d.x + d.y) + (d.z + d.w));
            const float r2 = (1.0f / 4.0f) / sqrtf(sq * (1.0f / D) + EPS);
            float d0 = 0.f, d1 = 0.f;
#pragma unroll
            for (int sl = 0; sl < 4; ++sl) { const f16x2 h = as_h2(dp[u][sl]); d0 += (float)h[0]; d1 += (float)h[1]; }
            if (tok < M) {
                const unsigned pk = (unsigned)__builtin_amdgcn_cvt_pk_fp8_f32(128.f * gt[u].x * gelu_tanh(d0 * r2 * su0[u]) * sv0[u], 128.f * gt[u].y * gelu_tanh(d1 * r2 * su1[u]) * sv1[u], 0, false);
                unsigned char* wp = W8 + (size_t)tok * NSEL + 16 * (F.lane & 7) + (F.lane >> 3);
                wp[0] = (unsigned char)(pk & 0xffu); wp[8] = (unsigned char)((pk >> 8) & 0xffu);
            }
        }
    }
}
typedef int v2i_t __attribute__((ext_vector_type(2)));
__device__ __forceinline__ void phaseV(Ctx& F) {
    const unsigned char* V4 = F.ws + WS_T + 8 * MiB; const u16* EIDX = (const u16*)(F.ws + WS_E); const unsigned char* W8 = F.ws + WS_WGT; const f16_t* X1H = (const f16_t*)(F.ws + WS_A); f16_t* X2 = (f16_t*)(F.ws + WS_B);
    const int xl = blockIdx.x & 7, slice = xl & 3, nws = (F.G >> 3) * NWAVES, tok0 = (xl >> 2) * (M / 2) + (blockIdx.x >> 3) * NWAVES + F.wave;
    const int p = F.lane >> 3, c = F.lane & 7;
    const int j = F.lane & 15, kg = F.lane >> 4;
    const unsigned char* vb = V4 + (size_t)slice * (NEXP * 128) + ((c ^ p) * 16);
    const int N = (M / 2 - ((blockIdx.x >> 3) * NWAVES + F.wave) + nws - 1) / nws;
    if (N <= 0) return;
    LAS unsigned char* fifo = F.lds + F.wave * 16384;
    const int ra = 32 * kg + j, rb = ra + 16;
    const LAS unsigned char* pa = fifo + ra * 128; const LAS unsigned char* pb = fifo + rb * 128;
    const int sa = ra & 7, sb = rb & 7;
    const int L = N - 1;
#define VT_IDX(k, EA, EB) do { const u32x4* _ep = (const u32x4*)(EIDX + (size_t)(tok0 + (k) * nws) * NSEL + p * 16); EA = _ep[0]; EB = _ep[1]; } while (0)
#define VT_DMA(EA, EB) do { _Pragma("unroll") for (int _i = 0; _i < 16; ++_i) \
        __builtin_amdgcn_global_load_lds((const unsigned*)(vb + (size_t)e16_of(EA, EB, _i) * 128), (LAS unsigned*)(fifo + 1024 * _i), 16, 0, 0); } while (0)
#define VT_META(k, WA, WB, X) do { const size_t _t = (size_t)(tok0 + (k) * nws); const u32x4* _wp = (const u32x4*)(W8 + _t * NSEL + 16 * kg); WA = _wp[0]; WB = _wp[4]; \
        const f16_t* _xp = X1H + _t * D + slice * 256 + 64 * kg + j; X[0] = *(const u16*)(_xp); X[1] = *(const u16*)(_xp + 16); X[2] = *(const u16*)(_xp + 32); X[3] = *(const u16*)(_xp + 48); } while (0)
    u32x4 e1a, e1b, wa, wb, wna, wnb; unsigned xc[4], xn[4];
    { u32x4 e0a, e0b; VT_IDX(0, e0a, e0b); VT_DMA(e0a, e0b); }
    VT_IDX(min(1, L), e1a, e1b);
    VT_META(0, wa, wb, xc);
#pragma unroll 1
    for (int n = 0; n < N; ++n) {
        asm volatile("s_waitcnt vmcnt(0)" ::: "memory");
        v2i_t ta[16], tb[16];
#pragma unroll
        for (int q = 0; q < 16; ++q) {
            ta[q] = __builtin_amdgcn_ds_read_tr4_b64_v2i32((LAS v2i_t*)(pa + (((q >> 1) ^ sa) << 4) + ((q & 1) << 3)));
            tb[q] = __builtin_amdgcn_ds_read_tr4_b64_v2i32((LAS v2i_t*)(pb + (((q >> 1) ^ sb) << 4) + ((q & 1) << 3)));
        }
        asm volatile("s_waitcnt lgkmcnt(0)" ::: "memory");
        VT_DMA(e1a, e1b);
        VT_IDX(min(n + 2, L), e1a, e1b);
        VT_META(min(n + 1, L), wna, wnb, xn);
        i32x8 aw; aw[0] = wa.x; aw[1] = wa.y; aw[2] = wa.z; aw[3] = wa.w; aw[4] = wb.x; aw[5] = wb.y; aw[6] = wb.z; aw[7] = wb.w;
        float yv[4] = {0.f, 0.f, 0.f, 0.f};
#pragma unroll
        for (int q = 0; q < 16; ++q) {
            i32x8 bv; bv[0] = ta[q].x; bv[1] = ta[q].y; bv[2] = tb[q].x; bv[3] = tb[q].y; bv[4] = 0; bv[5] = 0; bv[6] = 0; bv[7] = 0;
            f32x4 z = {0.f, 0.f, 0.f, 0.f};
            z = __builtin_amdgcn_mfma_scale_f32_16x16x128_f8f6f4(aw, bv, z, 0, 4, 0, 0, 0, 0);
            yv[q & 3] = ((q >> 2) == kg) ? z.x : yv[q & 3];
        }
        const size_t t = (size_t)(tok0 + n * nws);
        f16_t* op = X2 + t * D + slice * 256 + 64 * kg + j;
#pragma unroll
        for (int m = 0; m < 4; ++m) { const f16_t xh = __builtin_bit_cast(f16_t, (u16)xc[m]); op[16 * m] = (f16_t)((float)xh + yv[m] * (1.0f / 128.0f)); }
        wa = wna; wb = wnb;
#pragma unroll
        for (int m = 0; m < 4; ++m) xc[m] = xn[m];
    }
    asm volatile("s_waitcnt vmcnt(0)" ::: "memory");
#undef VT_IDX
#undef VT_DMA
#undef VT_META
}
__device__ __forceinline__ void phaseN(Ctx& F) {
    const f16_t* X2 = (const f16_t*)(F.ws + WS_B);
    f32x4 g[4];
#pragma unroll
    for (int c = 0; c < 4; ++c) g[c] = *(const f32x4*)(F.gf + 256 * c + 4 * F.lane);
    for (int tok0 = F.gw; tok0 < M; tok0 += 4 * F.NGW) {
        u32x2 xa[4][4];
#pragma unroll
        for (int u = 0; u < 4; ++u) {
            const int tok = min(tok0 + u * F.NGW, M - 1);
#pragma unroll
            for (int c = 0; c < 4; ++c) xa[u][c] = *(const u32x2*)(X2 + (size_t)tok * D + 256 * c + 4 * F.lane);
        }
#pragma unroll
        for (int u = 0; u < 4; ++u) {
            const int tok = tok0 + u * F.NGW;
            f32x4 a[4]; float sq = 0.f;
#pragma unroll
            for (int c = 0; c < 4; ++c) { const f16x2 p0 = as_h2(xa[u][c].x), p1 = as_h2(xa[u][c].y); a[c] = (f32x4){(float)p0[0], (float)p0[1], (float)p1[0], (float)p1[1]};
                sq += (a[c].x * a[c].x + a[c].y * a[c].y) + (a[c].z * a[c].z + a[c].w * a[c].w); }
            const float r3 = 1.0f / sqrtf(wave_sum(sq) * (1.0f / D) + EPS);
            if (tok < M) {
#pragma unroll
                for (int c = 0; c < 4; ++c) *(f32x4*)(F.out + (size_t)tok * D + 256 * c + 4 * F.lane) = a[c] * r3 * g[c];
            }
        }
    }
}

constexpr int NPHASE = 11;
__global__ void __launch_bounds__(NTHR, 2) fwd_kernel(Args args) {
    extern __shared__ __attribute__((aligned(16))) unsigned char lds[];
    Ctx F;
    F.lds = (LAS unsigned char*)lds;
    F.tid = threadIdx.x; F.lane = F.tid & 63; F.wave = __builtin_amdgcn_readfirstlane(F.tid >> 6);
    F.G = gridDim.x; F.gw = blockIdx.x * NWAVES + F.wave; F.NGW = F.G * NWAVES;
    F.x = args.in[0]; F.meta = args.in[1]; F.g1 = args.in[2]; F.w_in = args.in[3]; F.conv_w = args.in[4]; F.w_a = args.in[5]; F.w_b = args.in[6]; F.w_out = args.in[7];
    F.g2 = args.in[8]; F.w_q = args.in[9]; F.subk = args.in[10]; F.pu = args.in[11]; F.pv = args.in[12]; F.gf = args.in[13];
    F.out = args.out; F.ws = args.ws;
    volatile LAS unsigned* MISC = (volatile LAS unsigned*)(F.lds + MISC_OFF);
    if (F.tid < 32) MISC[F.tid] = 0u;
    __syncthreads();
    const int lo = args.ph_lo, hi = args.ph_hi;
    const bool multi = (hi - lo) > 1;
    XcdBarrier bar; bar.bar = (unsigned*)(F.ws + WS_CTL); bar.x = 0; bar.st = nullptr; bar.wave = F.wave;
    if (multi) bar = xcd_barrier_post((unsigned*)(F.ws + WS_CTL), MISC + 8, F.wave);
#define IN(k) (F.lane = lane_id(), F.tid = F.wave * 64 + F.lane, lo <= (k) && (k) < hi)
#define SEAM(k) do { if (IN(k) && IN((k) + 1)) xcd_barrier(bar); } while (0)

    bf16_t* BA = (bf16_t*)(F.ws + WS_B); bf16_t* CU = BA + (size_t)M * CW; bf16_t* Qb = CU + (size_t)M * CW; bf16_t* Kb = (bf16_t*)(F.ws + WS_KU); bf16_t* Vb = (bf16_t*)(F.ws + WS_VT);
    unsigned char* SGA = (unsigned char*)F.out; unsigned char* SGB = SGA + (size_t)M * D;
    bf16_t* MIX = (bf16_t*)(F.ws + WS_B);
    if (IN(0)) { phase0(F); if (DUP_PHASE == 0) { xcd_barrier(bar); phase0(F); } SEAM(0); }
    if (IN(1)) {
        pg8::Gemm g{(const u16*)(F.ws + WS_A), (const u16*)(F.ws + WS_W1T), M, 3072, D, nullptr, nullptr}; pg8::StaticOrder S; S.init(M, 3072, F.G, (int)blockIdx.x);
        pg8::EpiAdapt<Epi1> E{Epi1{BA, CU, Qb, Kb, Vb}};
        pg8::Gemm g8{(const u16*)(F.ws + WS_X18), (const u16*)(F.ws + WS_WG8), M, 2048, D / 2, nullptr, nullptr}; pg8::StaticOrder S8; S8.init(M, 2048, F.G, (int)blockIdx.x);
        pg8::EpiAdapt<Epi1g> E8{Epi1g{SGA, SGB}};
        pg8::gemm_phase<pg8::EpiAdapt<Epi1>, pg8::StaticOrder, 0>(F.lds, g, S, E, F.wave);
        pg8::gemm_phase<pg8::EpiAdapt<Epi1g>, pg8::StaticOrder, 2>(F.lds, g8, S8, E8, F.wave);
        if (DUP_PHASE == 1) { xcd_barrier(bar); pg8::gemm_phase<pg8::EpiAdapt<Epi1>, pg8::StaticOrder, 0>(F.lds, g, S, E, F.wave); }
        if (DUP_PHASE == 102) { xcd_barrier(bar); pg8::gemm_phase<pg8::EpiAdapt<Epi1g>, pg8::StaticOrder, 2>(F.lds, g8, S8, E8, F.wave); }
        SEAM(1);
    }
    if (IN(2)) { if (F.wave & 1) convert_weights_late(F); phase2(F); if (!(F.wave & 1)) convert_weights_late(F); if (DUP_PHASE == 2) { xcd_barrier(bar); phase2(F); } SEAM(2); }
    if (IN(3)) {
        pg8::PairOrder S; S.S.init(M, D, F.G, (int)blockIdx.x);
        pg8::Gemm g{(const u16*)(F.ws + WS_A + (size_t)M * CW * 2), (const u16*)(F.ws + WS_WAT), M, D, CW, (const u16*)(F.ws + WS_A), (const u16*)(F.ws + WS_WBT)};
        pg8::EpiAdapt<Epi3a> E{Epi3a{MIX, SGA, SGB}};
        pg8::gemm_phase<pg8::EpiAdapt<Epi3a>, pg8::PairOrder, 0>(F.lds, g, S, E, F.wave);
        if (DUP_PHASE == 3) { xcd_barrier(bar); pg8::gemm_phase<pg8::EpiAdapt<Epi3a>, pg8::PairOrder, 0>(F.lds, g, S, E, F.wave); }
        SEAM(3);
    }
    if (IN(4)) {
        pg8::Gemm g{(const u16*)MIX, (const u16*)(F.ws + WS_WOT), M, D, D, nullptr, nullptr}; pg8::StaticOrder S; S.init(M, D, F.G, (int)blockIdx.x);
        pg8::EpiAdapt<Epi3b> E{Epi3b{F.x, (f16_t*)(F.ws + WS_A), (float*)(F.ws + WS_SS2), F.ws + WS_X18}};
        pg8::gemm_phase<pg8::EpiAdapt<Epi3b>, pg8::StaticOrder, 0>(F.lds, g, S, E, F.wave);
        if (DUP_PHASE == 4) { xcd_barrier(bar); pg8::gemm_phase<pg8::EpiAdapt<Epi3b>, pg8::StaticOrder, 0>(F.lds, g, S, E, F.wave); }
        SEAM(4);
    }
    if (IN(5)) {
        pg8::Gemm g{(const u16*)(F.ws + WS_A), (const u16*)(F.ws + WS_WQT), M, 2048, D, nullptr, nullptr}; pg8::StaticOrder S; S.init(M, 2048, F.G, (int)blockIdx.x);
        pg8::EpiAdapt<Epi4> E{Epi4{(f16_t*)(F.ws + WS_B)}};
        pg8::gemm_phase<pg8::EpiAdapt<Epi4>, pg8::StaticOrder, 1>(F.lds, g, S, E, F.wave);
        if (DUP_PHASE == 5) { xcd_barrier(bar); pg8::gemm_phase<pg8::EpiAdapt<Epi4>, pg8::StaticOrder, 1>(F.lds, g, S, E, F.wave); }
        SEAM(5);
    }
    if (IN(6)) { phase5_stage(F); if (F.wave & 1) convert_tables(F); phase5(F); if (!(F.wave & 1)) convert_tables(F); if (DUP_PHASE == 66) { xcd_barrier(bar); convert_tables(F); } if (DUP_PHASE == 6) { xcd_barrier(bar); phase5(F); } SEAM(6); }
    if (IN(7)) { phaseU(F); if (DUP_PHASE == 7) { xcd_barrier(bar); phaseU(F); } SEAM(7); }
    if (IN(8)) { phaseW(F); if (DUP_PHASE == 8) { xcd_barrier(bar); phaseW(F); } SEAM(8); }
    if (IN(9)) { phaseV(F); if (DUP_PHASE == 9) { xcd_barrier(bar); phaseV(F); } SEAM(9); }
    if (DUP_PHASE == 200) { for (int q = 0; q < 10; ++q) xcd_barrier(bar); }
    if (IN(10)) { phaseN(F); if (DUP_PHASE == 10) { xcd_barrier(bar); phaseN(F); } }
#undef IN
#undef SEAM
}

extern "C" void kernel_launch(void* const* d_in, const int* in_sizes, int n_in, void* d_out, int out_size, void* d_ws, size_t ws_size, hipStream_t stream) {
    static int grid = 0;
    if (grid == 0) {
        if (n_in != 14 || out_size != M * D || ws_size < WS_END) { fprintf(stderr, "kernel_launch: unexpected shapes (n_in %d out %d ws %zu)\n", n_in, out_size, ws_size); grid = -1; return; }
        int dev = 0, cus = 0, per_cu = 0;
        if (hipGetDevice(&dev) != hipSuccess || hipDeviceGetAttribute(&cus, hipDeviceAttributeMultiprocessorCount, dev) != hipSuccess) { grid = -1; return; }
        if (hipFuncSetAttribute((const void*)fwd_kernel, hipFuncAttributeMaxDynamicSharedMemorySize, LDS_BYTES) != hipSuccess) { fprintf(stderr, "kernel_launch: hipFuncSetAttribute failed\n"); grid = -1; return; }
        if (hipOccupancyMaxActiveBlocksPerMultiprocessor(&per_cu, (const void*)fwd_kernel, NTHR, LDS_BYTES) != hipSuccess || per_cu < 1) { fprintf(stderr, "kernel_launch: occupancy query says %d\n", per_cu); (void)hipGetLastError(); per_cu = 1; }
        grid = cus;
    }
    if (grid < 0) return;
    (void)hipMemsetAsync((char*)d_ws + WS_CTL, 0, CTL_ZERO_BYTES, stream);
    Args a{};
    for (int i = 0; i < 14; ++i) a.in[i] = (const float*)d_in[i];
    a.out = (float*)d_out; a.ws = (unsigned char*)d_ws;
#if MK_N_LAUNCHES == 1
    a.ph_lo = 0; a.ph_hi = NPHASE;
    hipLaunchKernelGGL(fwd_kernel, dim3(grid), dim3(NTHR), LDS_BYTES, stream, a);
#else
    for (int p = 0; p < NPHASE; ++p) { a.ph_lo = p; a.ph_hi = p + 1; hipLaunchKernelGGL(fwd_kernel, dim3(grid), dim3(NTHR), LDS_BYTES, stream, a); }
#endif
}
```

```cpp
#include <hip/hip_runtime.h>
#include <cstdio>
#include <cstdint>

#ifndef MK_N_LAUNCHES
#define MK_N_LAUNCHES 1
#endif
#ifndef DUP_PHASE
#define DUP_PHASE -1
#endif
#ifndef NAIVE_GEMM
#define NAIVE_GEMM 0
#endif

#define LAS __attribute__((address_space(3)))
#define GAS __attribute__((address_space(1)))
typedef unsigned short bf16_t;
typedef unsigned short u16;
typedef _Float16 f16_t;
typedef short bf16x8 __attribute__((ext_vector_type(8)));
typedef _Float16 f16x8 __attribute__((ext_vector_type(8)));
typedef _Float16 f16x2 __attribute__((ext_vector_type(2)));
typedef float f32x4 __attribute__((ext_vector_type(4)));
typedef float f32x2 __attribute__((ext_vector_type(2)));
typedef unsigned u32x4 __attribute__((ext_vector_type(4)));
typedef unsigned u32x2 __attribute__((ext_vector_type(2)));
typedef float f32x16 __attribute__((ext_vector_type(16)));
typedef int i32x8 __attribute__((ext_vector_type(8)));
typedef int i32x4 __attribute__((ext_vector_type(4)));

constexpr int D = 1024, NB = 8, SEQ = 2048, M = NB * SEQ, NMETA = 16, CW = 512, NH = 8, HD = 64, INW = 5120;
constexpr int PH = 8, NKEY = 128, TOPK = 16, NSEL = 128, NEXP = 16384;
constexpr float EPS = 1e-6f;
constexpr float SB_THR = 44.0f;
constexpr int NWAVES = 8, NTHR = 512;

constexpr size_t MiB = 1u << 20;
constexpr size_t WS_CTL = 0, CTL_ZERO_BYTES = 64 * 1024;
constexpr size_t WS_W1T = 1 * MiB;
constexpr size_t WS_WG8 = 7 * MiB;
constexpr float GATE_WSCALE = 64.0f, XN8_SCALE = 8.0f;
constexpr size_t WS_WAT = 11 * MiB;
constexpr size_t WS_WBT = 12 * MiB;
constexpr size_t WS_WOT = 13 * MiB;
constexpr size_t WS_WQT = 15 * MiB;
constexpr size_t WS_SKB = 19 * MiB;
constexpr size_t WS_META = 19 * MiB + 512 * 1024;
constexpr size_t WS_SS2 = 20 * MiB;
constexpr size_t WS_A = 24 * MiB;
constexpr size_t WS_B = 56 * MiB;
constexpr size_t WS_KU = 104 * MiB;
constexpr size_t WS_VT = 121 * MiB;
constexpr int LP = 2080;
constexpr size_t WS_T = 140 * MiB;
constexpr size_t WS_X18 = 160 * MiB;
constexpr size_t WS_E = 200 * MiB;
constexpr size_t WS_GATE = WS_E + 4 * MiB, WS_WGT = WS_E + 12 * MiB;
constexpr size_t WS_SS3 = 21 * MiB;
constexpr size_t WS_END = 220 * MiB;

constexpr int LDS_BYTES = 147456;
constexpr int RING_BYTES = 131072;
constexpr int MISC_OFF = RING_BYTES + 320;

__device__ __forceinline__ unsigned f2bf(float f) { unsigned u = __builtin_bit_cast(unsigned, f); return (u + 0x7fffu + ((u >> 16) & 1u)) >> 16; }
__device__ __forceinline__ float bf2f(unsigned h) { return __builtin_bit_cast(float, (h & 0xffffu) << 16); }
typedef __bf16 bf16x2_t __attribute__((ext_vector_type(2)));
__device__ __forceinline__ unsigned pk2bf(float lo, float hi) { const f32x2 v = {lo, hi}; return __builtin_bit_cast(unsigned, __builtin_convertvector(v, bf16x2_t)); }
__device__ __forceinline__ unsigned pk2h(float lo, float hi) { f16x2 v = {(f16_t)lo, (f16_t)hi}; return __builtin_bit_cast(unsigned, v); }
__device__ __forceinline__ f16x2 as_h2(unsigned w) { return __builtin_bit_cast(f16x2, w); }
__device__ __forceinline__ float bflo(unsigned w) { return __builtin_bit_cast(float, w << 16); }
__device__ __forceinline__ float bfhi(unsigned w) { return __builtin_bit_cast(float, w & 0xffff0000u); }
__device__ __forceinline__ float wave_sum(float v) {
#pragma unroll
    for (int o = 1; o < 64; o <<= 1) v += __shfl_xor(v, o);
    return v;
}
__device__ __forceinline__ unsigned wave_max_u(unsigned v) {
#pragma unroll
    for (int o = 1; o < 64; o <<= 1) { unsigned t = (unsigned)__shfl_xor((int)v, o); v = t > v ? t : v; }
    return v;
}
__device__ __forceinline__ int lane_id() { int l; asm volatile("v_mbcnt_lo_u32_b32 %0, -1, 0\n\tv_mbcnt_hi_u32_b32 %0, -1, %0" : "=v"(l)); return l; }
__device__ __forceinline__ float sigmoidf_(float x) { return 1.0f / (1.0f + __expf(-x)); }

namespace pg8 {
constexpr int BM = 256, BK = 64, HALF = 128, HTB = HALF * BK * 2, STAGE_BYTES = 8 * HTB, NXCD = 8, WGM = 8;
__host__ __device__ __forceinline__ int lds_byte(int r, int c) { const int st = (r >> 4) * 2 + (c >> 5), rr = r & 15, cc = c & 31, ob = rr * 64 + cc * 2; return st * 1024 + (ob ^ (((ob >> 9) & 1) << 5)); }
__host__ __device__ __forceinline__ void stage_rc(int b, int& R, int& C) { const int st = b / 1024, sb = b % 1024, swz = sb ^ (((sb >> 9) & 1) << 5); R = (st >> 1) * 16 + swz / 64; C = (st & 1) * 32 + (swz % 64) / 2; }
__host__ __device__ __forceinline__ int perm32(int rho) { const int n = rho >> 4, i = rho & 15; return 8 * (i >> 2) + 4 * n + (i & 3); }
struct Unit { int pm, pn, which; };
struct Gemm { const u16* A; const u16* Bt; int M, N, K; const u16* A2; const u16* Bt2; };
struct StaticOrder {
    int nM, nN, nwg, G, c;
    __host__ __device__ void init(int M_, int N_, int G_, int c_) { nM = M_ / BM; nN = N_ / BM; nwg = nM * nN; G = G_; c = c_; }
    __host__ __device__ bool next(int i, Unit& u) const {
        const long L = (long)i * G + c; if (L >= nwg) return false;
        int wgid = (int)L; { const int q = nwg / NXCD, r = nwg % NXCD, xcd = wgid % NXCD, off = wgid / NXCD; wgid = (xcd < r ? xcd * (q + 1) : r * (q + 1) + (xcd - r) * q) + off; }
        const int nig = WGM * nN, gid = wgid / nig, fm = gid * WGM, gsz = (nM - fm) < WGM ? (nM - fm) : WGM;
        u.pm = fm + ((wgid % nig) % gsz); u.pn = (wgid % nig) / gsz; u.which = 0; return true;
    }
    __device__ __forceinline__ void a_ready(const Unit&) const {}
    __device__ __forceinline__ void done(const Unit&) const {}
};
struct PairOrder {
    StaticOrder S;
    __host__ __device__ bool next(int i, Unit& u) const { if (!S.next(i >> 1, u)) return false; u.which = i & 1; return true; }
    __device__ __forceinline__ void a_ready(const Unit&) const {}
    __device__ __forceinline__ void done(const Unit&) const {}
};

template <class F> struct EpiAdapt {
    static constexpr bool PERM = true, AFTER_DRAIN = false;
    F f;
    __device__ __forceinline__ void operator()(const f32x4 (&acc)[2][2][4][2], const Unit& u, int wr, int wc, int fr, int fq) const {
        int fr2 = fr; asm volatile("" : "+v"(fr2), "+v"(fq));
        const int col = u.pn * BM + wc * 32 + 8 * fq;
#pragma unroll
        for (int ai = 0; ai < 2; ++ai)
#pragma unroll
            for (int m = 0; m < 4; ++m) {
                const int row = u.pm * BM + ai * HALF + wr * 64 + m * 16 + fr2;
                f(row, col, u.pn + 64 * u.which, wc, acc[ai][0][m][0], acc[ai][0][m][1], acc[ai][1][m][0], acc[ai][1][m][1]);
            }
    }
};

#if NAIVE_GEMM
template <bool F16> __device__ __forceinline__ float dot8(u32x4 a, u32x4 b) {
    float s = 0.f;
#pragma unroll
    for (int i = 0; i < 4; ++i) {
        if (F16) { f16x2 x = as_h2(a[i]), y = as_h2(b[i]); s += (float)x[0] * (float)y[0] + (float)x[1] * (float)y[1]; }
        else s += bflo(a[i]) * bflo(b[i]) + bfhi(a[i]) * bfhi(b[i]);
    }
    return s;
}
template <class Epi, class Sched, int FMT>
__device__ __forceinline__ void gemm_phase(LAS unsigned char* lds, const Gemm g, const Sched& S, const Epi& E, const int wid) {
    constexpr bool F16 = FMT == 1;
    const int lane = lane_id(), tid = wid * 64 + lane, wr = wid >> 2, wc = wid & 3, fr = lane & 15, fq = lane >> 4;
    Unit u;
    for (int ui = 0; S.next(ui, u); ++ui) {
        f32x4 acc[2][2][4][2];
        for (int ai = 0; ai < 2; ++ai) for (int m = 0; m < 4; ++m) {
            const int row = u.pm * BM + ai * HALF + wr * 64 + m * 16 + fr;
            float a16[16];
            for (int j = 0; j < 16; ++j) a16[j] = 0.f;
            const u32x4* ap = (const u32x4*)(g.A + (size_t)row * g.K);
            for (int k8 = 0; k8 < g.K / 8; ++k8) {
                const u32x4 av = ap[k8];
#pragma unroll
                for (int j = 0; j < 16; ++j) {
                    const int col = u.pn * BM + (j >> 3) * HALF + wc * 32 + 8 * fq + (j & 7);
                    const u32x4 bv = ((const u32x4*)(g.Bt + (size_t)col * g.K))[k8];
                    a16[j] += dot8<F16>(av, bv);
                }
            }
            acc[ai][0][m][0] = (f32x4){a16[0], a16[1], a16[2], a16[3]}; acc[ai][0][m][1] = (f32x4){a16[4], a16[5], a16[6], a16[7]};
            acc[ai][1][m][0] = (f32x4){a16[8], a16[9], a16[10], a16[11]}; acc[ai][1][m][1] = (f32x4){a16[12], a16[13], a16[14], a16[15]};
        }
        E(acc, u, wr, wc, fr, fq);
    }
    __syncthreads();
}
#else
template <class Epi, class Sched, int FMT>
__device__ __forceinline__ void gemm_phase(LAS unsigned char* lds, const Gemm g, const Sched& S, const Epi& E, const int wid) {
    constexpr bool ALIGN_EPI = true; constexpr bool F16 = FMT == 1;
    const int lane = lane_id(), tid = wid * 64 + lane, wr = wid >> 2, wc = wid & 3, fr = lane & 15, fq = lane >> 4;
    const int K = g.K; int nt = K / BK;
    if constexpr (FMT == 2) asm volatile("" : "+s"(nt));
    unsigned voffA[2], voffB[2];
#pragma unroll
    for (int i = 0; i < 2; ++i) { int R, C; stage_rc(tid * 16 + i * 8192, R, C); const int Rb = Epi::PERM ? ((R & ~31) + perm32(R & 31)) : R;
        voffA[i] = (unsigned)(R * K + C) * 2u; voffB[i] = (unsigned)(Rb * K + C) * 2u; }
    const unsigned kstep = (unsigned)(BK * 2);
    const unsigned hstep = (unsigned)HALF * (unsigned)K * 2u;
    const unsigned tstep = 2u * hstep;
    const unsigned ldsw = (unsigned)wid * 1024u;
    const int aoff = lds_byte(wr * 64 + fr, fq * 8), boff = lds_byte(wc * 32 + fr, fq * 8);
#define PG8_SA(b, h) (((b) * 2 + (h)) * HTB)
#define PG8_SB(b, h) ((4 + (b) * 2 + (h)) * HTB)
#define PG8_STAGE(bufoff, gbase, goff, voff) do { unsigned _go = (goff); asm volatile("" : "+s"(_go));   \
        _Pragma("unroll") for (int _i = 0; _i < 2; ++_i) \
        __builtin_amdgcn_global_load_lds((const unsigned*)((gbase) + (_go + (voff)[_i])), (LAS unsigned*)(lds + (bufoff) + ldsw + _i * 8192), 16, 0, 0); } while (0)
#define PG8_LDA(dst, b, h) do { _Pragma("unroll") for (int m = 0; m < 4; ++m) _Pragma("unroll") for (int k = 0; k < 2; ++k) dst[m][k] = *(const LAS bf16x8*)(lds + PG8_SA(b, h) + aoff + m * 2048 + k * 1024); } while (0)
#define PG8_LDB(dst, b, h) do { _Pragma("unroll") for (int n = 0; n < 2; ++n) _Pragma("unroll") for (int k = 0; k < 2; ++k) dst[n][k] = *(const LAS bf16x8*)(lds + PG8_SB(b, h) + boff + n * 2048 + k * 1024); } while (0)
#define PG8_MMA(ai, bj, At, Bt) do { __builtin_amdgcn_s_setprio(1); _Pragma("unroll") for (int m = 0; m < 4; ++m) _Pragma("unroll") for (int n = 0; n < 2; ++n) { \
        if constexpr (FMT == 2) { const i32x8 _a = __builtin_shufflevector(__builtin_bit_cast(i32x4, Bt[n][0]), __builtin_bit_cast(i32x4, Bt[n][1]), 0, 1, 2, 3, 4, 5, 6, 7), \
                                      _b = __builtin_shufflevector(__builtin_bit_cast(i32x4, At[m][0]), __builtin_bit_cast(i32x4, At[m][1]), 0, 1, 2, 3, 4, 5, 6, 7); \
            acc[ai][bj][m][n] = __builtin_amdgcn_mfma_scale_f32_16x16x128_f8f6f4(_a, _b, acc[ai][bj][m][n], 0, 0, 0, 0, 0, 0); } \
        else { _Pragma("unroll") for (int k = 0; k < 2; ++k) { \
        if (F16) acc[ai][bj][m][n] = __builtin_amdgcn_mfma_f32_16x16x32_f16(__builtin_bit_cast(f16x8, Bt[n][k]), __builtin_bit_cast(f16x8, At[m][k]), acc[ai][bj][m][n], 0, 0, 0); \
        else acc[ai][bj][m][n] = __builtin_amdgcn_mfma_f32_16x16x32_bf16(Bt[n][k], At[m][k], acc[ai][bj][m][n], 0, 0, 0); } } } __builtin_amdgcn_s_setprio(0); } while (0)
#define PG8_WAIT_V(n) asm volatile("s_waitcnt vmcnt(" #n ")" ::: "memory")
#define PG8_WAIT_L(n) asm volatile("s_waitcnt lgkmcnt(" #n ")" ::: "memory")
#define PG8_BAR __builtin_amdgcn_s_barrier()
#define PG8_SCHED __builtin_amdgcn_sched_barrier(0)
    Unit cur, nxt; int ui = 0;
    if (!S.next(0, cur)) return;
    f32x4 acc[2][2][4][2];
#pragma unroll
    for (int a = 0; a < 2; ++a)
#pragma unroll
        for (int b = 0; b < 2; ++b)
#pragma unroll
            for (int m = 0; m < 4; ++m)
#pragma unroll
                for (int n = 0; n < 2; ++n) acc[a][b][m][n] = (f32x4){0.f, 0.f, 0.f, 0.f};
    bf16x8 At[4][2], B0[2][2], B1[2][2];
    const char* pA = (const char*)(cur.which ? g.A2 : g.A); const char* pB = (const char*)(cur.which ? g.Bt2 : g.Bt);
    unsigned cA = (unsigned)cur.pm * tstep, cB = (unsigned)cur.pn * tstep;
    S.a_ready(cur);
    {
        PG8_STAGE(PG8_SB(0, 0), pB, cB, voffB); PG8_STAGE(PG8_SB(0, 1), pB, cB + hstep, voffB); PG8_STAGE(PG8_SA(0, 0), pA, cA, voffA); PG8_STAGE(PG8_SA(0, 1), pA, cA + hstep, voffA);
        if (wr == 1) PG8_BAR;
        PG8_WAIT_V(2); PG8_BAR;
        PG8_STAGE(PG8_SB(1, 0), pB, cB + kstep, voffB); PG8_STAGE(PG8_SA(1, 0), pA, cA + kstep, voffA); PG8_STAGE(PG8_SB(1, 1), pB, cB + hstep + kstep, voffB);
        PG8_WAIT_V(6); PG8_BAR;
    }
    for (;;) {
        const bool has_next = S.next(ui + 1, nxt);
        const char* qA = has_next ? (const char*)(nxt.which ? g.A2 : g.A) : pA; const char* qB = has_next ? (const char*)(nxt.which ? g.Bt2 : g.Bt) : pB;
        const unsigned nA = has_next ? (unsigned)nxt.pm * tstep : cA, nB = has_next ? (unsigned)nxt.pn * tstep : cB;
        for (int t = 0; t < nt; t += 2) {
            const bool last = (t == nt - 2);
            const unsigned a1 = cA + (unsigned)(t + 1) * kstep;
            const char* rA = last ? qA : pA; const char* rB = last ? qB : pB;
            const unsigned a2 = last ? nA : cA + (unsigned)(t + 2) * kstep, b2 = last ? nB : cB + (unsigned)(t + 2) * kstep;
            const unsigned a3 = a2 + kstep, b3 = b2 + kstep;
            if (last && has_next) S.a_ready(nxt);
            PG8_LDB(B0, 0, 0); PG8_LDB(B1, 0, 1); PG8_SCHED; PG8_LDA(At, 0, 0); PG8_STAGE(PG8_SA(1, 1), pA, a1 + hstep, voffA);
            PG8_WAIT_V(8); PG8_WAIT_L(0); PG8_BAR; PG8_MMA(0, 0, At, B0); PG8_MMA(0, 1, At, B1); PG8_BAR; PG8_SCHED;
            PG8_LDA(At, 0, 1); PG8_STAGE(PG8_SB(0, 0), rB, b2, voffB); PG8_STAGE(PG8_SB(0, 1), rB, b2 + hstep, voffB); PG8_STAGE(PG8_SA(0, 0), rA, a2, voffA);
            PG8_WAIT_V(8); PG8_WAIT_L(0); PG8_BAR; PG8_MMA(1, 0, At, B0); PG8_MMA(1, 1, At, B1); PG8_BAR; PG8_SCHED;
            PG8_LDB(B0, 1, 0); PG8_LDB(B1, 1, 1); PG8_SCHED; PG8_LDA(At, 1, 0); PG8_STAGE(PG8_SA(0, 1), rA, a2 + hstep, voffA);
            PG8_WAIT_V(8); PG8_WAIT_L(0); PG8_BAR; PG8_MMA(0, 0, At, B0); PG8_MMA(0, 1, At, B1); PG8_BAR; PG8_SCHED;
            PG8_LDA(At, 1, 1); PG8_STAGE(PG8_SB(1, 0), rB, b3, voffB); PG8_STAGE(PG8_SB(1, 1), rB, b3 + hstep, voffB); PG8_STAGE(PG8_SA(1, 0), rA, a3, voffA);
            PG8_WAIT_V(8); PG8_WAIT_L(0); PG8_BAR; PG8_MMA(1, 0, At, B0); PG8_MMA(1, 1, At, B1); PG8_BAR; PG8_SCHED;
        }
        if constexpr (ALIGN_EPI) { if (wr == 0) PG8_BAR; }
        E(acc, cur, wr, wc, fr, fq); S.done(cur);
        if (!has_next) break;
#pragma unroll
        for (int a = 0; a < 2; ++a)
#pragma unroll
            for (int b = 0; b < 2; ++b)
#pragma unroll
                for (int m = 0; m < 4; ++m)
#pragma unroll
                    for (int n = 0; n < 2; ++n) acc[a][b][m][n] = (f32x4){0.f, 0.f, 0.f, 0.f};
        cur = nxt; cA = nA; cB = nB; pA = qA; pB = qB; ++ui;
        if constexpr (ALIGN_EPI) { if (wr == 1) PG8_BAR; }
    }
    PG8_WAIT_V(0);
    if constexpr (!ALIGN_EPI) { if (wr == 0) PG8_BAR; }
    PG8_BAR;
#undef PG8_SA
#undef PG8_SB
#undef PG8_STAGE
#undef PG8_LDA
#undef PG8_LDB
#undef PG8_MMA
#undef PG8_WAIT_V
#undef PG8_WAIT_L
#undef PG8_BAR
#undef PG8_SCHED
}
#endif
}

#define XB_TMO      128
#define XB_XCNT(j)  (256  + 64 * (j))
#define XB_XSUB(j)  (1280 + 64 * (j))
#define XB_XGEN(j)  (2304 + 64 * (j))
#define XB_TOP      3328
#define XB_TOPGEN   3392
#define XCD_BAR_WORDS 3456
#define XB_SPIN_CAP (1u << 20)
__device__ __forceinline__ unsigned xb_ld(unsigned* p)              { return __hip_atomic_load(p, __ATOMIC_RELAXED, __HIP_MEMORY_SCOPE_AGENT); }
__device__ __forceinline__ unsigned xb_add(unsigned* p, unsigned v) { return __hip_atomic_fetch_add(p, v, __ATOMIC_RELAXED, __HIP_MEMORY_SCOPE_AGENT); }
__device__ __forceinline__ unsigned xb_xcc_id() { return (unsigned)__builtin_amdgcn_s_getreg((3 << 11) | 20) & 0xFu; }
#define XB_SPIN(cond, bar) do { unsigned _sp = 0; while (cond) { __builtin_amdgcn_s_sleep(1); \
    if ((++_sp & 255u) == 0u) { if (xb_ld(&(bar)[XB_TMO])) break; if (_sp > XB_SPIN_CAP) { atomicAdd(&(bar)[XB_TMO], 1u); break; } } } } while (0)
struct XcdBarrier { unsigned* bar; unsigned x; volatile LAS unsigned* st; int wave; };
__device__ __forceinline__ XcdBarrier xcd_barrier_post(unsigned* bar, volatile LAS unsigned* st, int wave) {
    XcdBarrier b; b.bar = bar; b.x = xb_xcc_id(); b.st = st; b.wave = wave;
    if (wave == 0 && lane_id() == 0) (void)xb_add(&bar[XB_XCNT(b.x)], 1u);
    return b;
}
__device__ __forceinline__ void xcd_barrier_complete(unsigned* bar, unsigned x, unsigned& nloc, unsigned& nx) {
    const unsigned G = gridDim.x * gridDim.y * gridDim.z;
    unsigned sum, cnt, mine, sp = 0u;
    for (;;) {
        sum = 0u; cnt = 0u; mine = 0u;
#pragma unroll
        for (unsigned j = 0; j < 16; ++j) { const unsigned c = xb_ld(&bar[XB_XCNT(j)]); sum += c; cnt += (c > 0u) ? 1u : 0u; mine = (j == x) ? c : mine; }
        if (sum == G) break;
        __builtin_amdgcn_s_sleep(1);
        if ((++sp & 255u) == 0u) { if (xb_ld(&bar[XB_TMO])) break; if (sp > XB_SPIN_CAP) { atomicAdd(&bar[XB_TMO], 1u); break; } }
    }
    nloc = mine > 0u ? mine : 1u; nx = cnt > 0u ? cnt : 1u;
}
__device__ __forceinline__ void xcd_barrier(const XcdBarrier& b) {
    asm volatile("s_waitcnt vmcnt(0)" ::: "memory");
    __syncthreads();
    if (b.wave == 0 && lane_id() == 0) {
        unsigned* bar = b.bar;
        __builtin_amdgcn_s_waitcnt(0);
        unsigned nloc = b.st[0], nx = b.st[1];
        if (nloc == 0u) { xcd_barrier_complete(bar, b.x, nloc, nx); b.st[0] = nloc; b.st[1] = nx; }
        const unsigned old = xb_add(&bar[XB_XSUB(b.x)], 1u);
        const unsigned gen = old / nloc;
        if (old + 1u == (gen + 1u) * nloc) {
            __builtin_amdgcn_fence(__ATOMIC_RELEASE, "agent");
            asm volatile("s_waitcnt vmcnt(0)" ::: "memory");
            const unsigned og = xb_add(&bar[XB_TOP], 1u);
            const unsigned tg = og / nx;
            if (og + 1u == (tg + 1u) * nx) xb_add(&bar[XB_TOPGEN], 1u);
            else XB_SPIN(xb_ld(&bar[XB_TOPGEN]) == tg, bar);
            __builtin_amdgcn_fence(__ATOMIC_ACQUIRE, "agent");
            xb_add(&bar[XB_XGEN(b.x)], 1u);
            asm volatile("s_waitcnt vmcnt(0)" ::: "memory");
        } else {
            XB_SPIN(xb_ld(&bar[XB_XGEN(b.x)]) == gen, bar);
            __builtin_amdgcn_fence(__ATOMIC_ACQUIRE, "agent");
            asm volatile("s_waitcnt vmcnt(0)" ::: "memory");
        }
    }
    __syncthreads();
}

struct Args { const float* in[14]; float* out; unsigned char* ws; int ph_lo, ph_hi; };
struct Ctx {
    LAS unsigned char* lds;
    int tid, lane, wave, G, gw, NGW;
    const float *x, *meta, *g1, *w_in, *conv_w, *w_a, *w_b, *w_out, *g2, *w_q, *subk, *pu, *pv, *gf;
    float* out; unsigned char* ws;
};

__device__ __forceinline__ float one_or(const float* s, int i) { return s ? s[i] : 1.0f; }
template <bool F16>
__device__ __forceinline__ void p0_transpose_item(const float* W, int K, int N, const float* scale, u16* WT, int scol0, int drow0, int k0, LAS float* scr, int lane) {
#pragma unroll
    for (int i = 0; i < 32; ++i) { const int kk = 2 * i + (lane >> 5); scr[kk * 33 + (lane & 31)] = W[(size_t)(k0 + kk) * N + scol0 + (lane & 31)] * one_or(scale, k0 + kk); }
    asm volatile("s_waitcnt lgkmcnt(0)" ::: "memory");
    const int c = lane & 7;
#pragma unroll
    for (int j = 0; j < 4; ++j) { const int n = (lane >> 3) + 8 * j; const LAS float* s = scr + (8 * c) * 33 + n;
        u32x4 o;
        if (F16) { o.x = pk2h(s[0 * 33], s[1 * 33]); o.y = pk2h(s[2 * 33], s[3 * 33]); o.z = pk2h(s[4 * 33], s[5 * 33]); o.w = pk2h(s[6 * 33], s[7 * 33]); }
        else { o.x = pk2bf(s[0 * 33], s[1 * 33]); o.y = pk2bf(s[2 * 33], s[3 * 33]); o.z = pk2bf(s[4 * 33], s[5 * 33]); o.w = pk2bf(s[6 * 33], s[7 * 33]); }
        *(u32x4*)(WT + (size_t)(drow0 + n) * K + k0 + 8 * c) = o; }
    asm volatile("s_waitcnt lgkmcnt(0)" ::: "memory");
}
__device__ __forceinline__ void p0_transpose_item8(const float* W, int K, int N, const float* scale, float mul, unsigned char* WT8, int scol0, int drow0, int k0, LAS float* scr, int lane) {
#pragma unroll
    for (int i = 0; i < 32; ++i) { const int kk = 2 * i + (lane >> 5); scr[kk * 33 + (lane & 31)] = W[(size_t)(k0 + kk) * N + scol0 + (lane & 31)] * (mul * one_or(scale, k0 + kk)); }
    asm volatile("s_waitcnt lgkmcnt(0)" ::: "memory");
    const int n = lane & 31, hf = lane >> 5; const LAS float* s = scr + (32 * hf) * 33 + n;
    unsigned w[8];
#pragma unroll
    for (int j = 0; j < 8; ++j) w[j] = (unsigned)__builtin_amdgcn_cvt_pk_fp8_f32(s[(4 * j + 2) * 33], s[(4 * j + 3) * 33], __builtin_amdgcn_cvt_pk_fp8_f32(s[(4 * j) * 33], s[(4 * j + 1) * 33], 0, false), true);
    u32x4* op = (u32x4*)(WT8 + (size_t)(drow0 + n) * K + k0 + 32 * hf);
    op[0] = (u32x4){w[0], w[1], w[2], w[3]}; op[1] = (u32x4){w[4], w[5], w[6], w[7]};
    asm volatile("s_waitcnt lgkmcnt(0)" ::: "memory");
}
template <int KR> __device__ __forceinline__ void tr_load(const float* W, int N, int scol0, int k0, int lane, float (&t)[KR / 2]) {
#pragma unroll
    for (int i = 0; i < KR / 2; ++i) t[i] = W[(size_t)(k0 + 2 * i + (lane >> 5)) * N + scol0 + (lane & 31)];
}
template <int KR, bool FP8> __device__ __forceinline__ void tr_finish(const float (&t)[KR / 2], const float* scale, float mul, void* WT, int ldk, int drow0, int k0, LAS float* scr, int lane) {
#pragma unroll
    for (int i = 0; i < KR / 2; ++i) scr[(2 * i + (lane >> 5)) * 33 + (lane & 31)] = t[i];
    asm volatile("s_waitcnt lgkmcnt(0)" ::: "memory");
    if constexpr (!FP8) {
        constexpr int NJ = KR / 16;
        const int c = lane & (KR / 8 - 1), nl = lane / (KR / 8);
        const f32x4 ga = *(const f32x4*)(scale + k0 + 8 * c), gb = *(const f32x4*)(scale + k0 + 8 * c + 4);
#pragma unroll
        for (int j = 0; j < NJ; ++j) { const int n = nl + (512 / KR) * j; const LAS float* s = scr + (8 * c) * 33 + n;
            u32x4 o; o.x = pk2bf(s[0 * 33] * ga.x, s[1 * 33] * ga.y); o.y = pk2bf(s[2 * 33] * ga.z, s[3 * 33] * ga.w); o.z = pk2bf(s[4 * 33] * gb.x, s[5 * 33] * gb.y); o.w = pk2bf(s[6 * 33] * gb.z, s[7 * 33] * gb.w);
            *(u32x4*)((u16*)WT + (size_t)(drow0 + n) * ldk + k0 + 8 * c) = o; }
    } else {
        constexpr int KL = KR / 2;
        const int n = lane & 31, hf = lane >> 5; const LAS float* s = scr + (KL * hf) * 33 + n;
        unsigned w[KL / 4];
#pragma unroll
        for (int j = 0; j < KL / 4; ++j) { const f32x4 gq = *(const f32x4*)(scale + k0 + KL * hf + 4 * j) * mul;
            w[j] = (unsigned)__builtin_amdgcn_cvt_pk_fp8_f32(s[(4 * j + 2) * 33] * gq.z, s[(4 * j + 3) * 33] * gq.w, __builtin_amdgcn_cvt_pk_fp8_f32(s[(4 * j) * 33] * gq.x, s[(4 * j + 1) * 33] * gq.y, 0, false), true); }
        unsigned char* op = (unsigned char*)WT + (size_t)(drow0 + n) * ldk + k0 + KL * hf;
        if constexpr (KL == 32) { ((u32x4*)op)[0] = (u32x4){w[0], w[1], w[2], w[3]}; ((u32x4*)op)[1] = (u32x4){w[4], w[5], w[6], w[7]}; }
        else { *(u32x2*)op = (u32x2){w[0], w[1]}; }
    }
    asm volatile("s_waitcnt lgkmcnt(0)" ::: "memory");
}
__device__ __forceinline__ int w1_srccol(int n) {
    if (n < 512 || n >= 1536) return n;
    const int t = (n - 512) >> 8, r = (n - 512) & 255;
    return r < 128 ? 512 + 128 * t + r : 1024 + 128 * t + (r - 128);
}

__device__ __forceinline__ void phase0(Ctx& F) {
    f32x4 xv[4][4]; int xr[4];
#pragma unroll
    for (int u = 0; u < 4; ++u) { xr[u] = min(F.gw + u * F.NGW, M - 1); const f32x4* xp = (const f32x4*)(F.x + (size_t)xr[u] * D) + F.lane;
#pragma unroll
        for (int j = 0; j < 4; ++j) xv[u][j] = __builtin_nontemporal_load(xp + 64 * j); }
    const bool trfast = F.NGW == 2048;
    float tA[32], tB[8];
    const int itA = F.gw, kbA = itA / 160, nbA = itA % 160, itB = 2048 + (F.gw >> 2), kbB = itB / 160, nbB = itB % 160, k0B = kbB * 64 + 16 * (F.gw & 3);
    if (trfast) { tr_load<64>(F.w_in, INW, nbA < 96 ? w1_srccol(nbA * 32) : nbA * 32, kbA * 64, F.lane, tA); tr_load<16>(F.w_in, INW, nbB < 96 ? w1_srccol(nbB * 32) : nbB * 32, k0B, F.lane, tB); }
    {
        LAS float* mn = (LAS float*)F.lds;
        LAS float* red = (LAS float*)(F.lds + 65536);
        {
            const int r = F.wave * 2; float va[16], vb[16], gg[16]; float sa = 0.f, sb = 0.f;
#pragma unroll
            for (int j = 0; j < 16; ++j) { va[j] = F.meta[r * D + j * 64 + F.lane]; vb[j] = F.meta[(r + 1) * D + j * 64 + F.lane]; gg[j] = F.g1[j * 64 + F.lane]; }
#pragma unroll
            for (int j = 0; j < 16; ++j) { sa += va[j] * va[j]; sb += vb[j] * vb[j]; }
            const float ra = 1.0f / sqrtf(wave_sum(sa) * (1.0f / D) + EPS), rb = 1.0f / sqrtf(wave_sum(sb) * (1.0f / D) + EPS);
#pragma unroll
            for (int j = 0; j < 16; ++j) { const int k = j * 64 + F.lane; *(LAS f32x2*)(mn + k * 16 + r) = (f32x2){va[j] * ra * gg[j], vb[j] * rb * gg[j]}; }
        }
        __syncthreads();
        bf16_t* MK = (bf16_t*)(F.ws + WS_META); bf16_t* MV = MK + 16 * 512; float* MCA = (float*)(MV + 16 * 512); float* MUA = MCA + 16 * 512;
        for (int cgx = blockIdx.x; cgx < 256; cgx += F.G) {
            const int cg = (cgx & 7) * 32 + (cgx >> 3);
            const int j = F.tid & 7, kq = F.tid >> 3;
            const int gc = cg * 8 + j, which = gc >> 9, cc = gc & 511;
            const int scol = which == 0 ? 2048 + cc : which == 1 ? 2560 + cc : which == 2 ? 512 + cc : 1024 + cc;
            float wv[16];
#pragma unroll
            for (int kk = 0; kk < 16; ++kk) wv[kk] = F.w_in[(size_t)(kq * 16 + kk) * INW + scol];
            float acc[16];
#pragma unroll
            for (int r = 0; r < 16; ++r) acc[r] = 0.f;
#pragma unroll
            for (int kk = 0; kk < 16; ++kk) {
#pragma unroll
                for (int r4 = 0; r4 < 4; ++r4) { const f32x4 mv = *(const LAS f32x4*)(mn + (kq * 16 + kk) * 16 + r4 * 4);
                    acc[r4 * 4 + 0] += mv.x * wv[kk]; acc[r4 * 4 + 1] += mv.y * wv[kk]; acc[r4 * 4 + 2] += mv.z * wv[kk]; acc[r4 * 4 + 3] += mv.w * wv[kk]; }
            }
#pragma unroll
            for (int r = 0; r < 16; ++r) red[(kq * 16 + r) * 8 + j] = acc[r];
            __syncthreads();
            if (F.tid < 128) {
                const int r = F.tid >> 3, jj = F.tid & 7; float sm = 0.f;
                for (int q = 0; q < 64; ++q) sm += red[(q * 16 + r) * 8 + jj];
                const int gc2 = cg * 8 + jj, wh = gc2 >> 9, c2 = gc2 & 511;
                if (wh == 0) { MK[r * 512 + c2] = (bf16_t)f2bf(sm); bf16_t* KU = (bf16_t*)(F.ws + WS_KU);
                    for (int b = 0; b < NB; ++b) KU[((size_t)(b * NH + (c2 >> 6)) * LP + 16 + r) * HD + (c2 & 63)] = (bf16_t)f2bf(sm); }
                else if (wh == 1) { MV[r * 512 + c2] = (bf16_t)f2bf(sm); bf16_t* VT = (bf16_t*)(F.ws + WS_VT);
                    for (int b = 0; b < NB; ++b) VT[((size_t)(b * NH + (c2 >> 6)) * HD + (c2 & 63)) * LP + 16 + r] = (bf16_t)f2bf(sm); }
                else if (wh == 2) MCA[r * 512 + c2] = sm; else MUA[r * 512 + c2] = sm;
            }
            __syncthreads();
        }
    }
    {
        bf16_t* KU = (bf16_t*)(F.ws + WS_KU); bf16_t* VT = (bf16_t*)(F.ws + WS_VT);
        for (int i = blockIdx.x * NTHR + F.tid; i < 64 * 16 * 64; i += F.G * NTHR) {
            const int bh = i >> 10, rr = (i >> 6) & 15, dd = i & 63;
            KU[((size_t)bh * LP + rr) * HD + dd] = 0; VT[((size_t)bh * HD + dd) * LP + rr] = 0;
        }
    }
    {
        LAS float* scr = (LAS float*)(F.lds + F.wave * 16384);
        constexpr int I1 = 16 * 160;
        if (trfast) {
            if (nbA < 96) tr_finish<64, false>(tA, F.g1, 1.0f, F.ws + WS_W1T, D, nbA * 32, kbA * 64, scr, F.lane); else tr_finish<64, true>(tA, F.g1, GATE_WSCALE, F.ws + WS_WG8, D, (nbA - 96) * 32, kbA * 64, scr, F.lane);
            if (nbB < 96) tr_finish<16, false>(tB, F.g1, 1.0f, F.ws + WS_W1T, D, nbB * 32, k0B, scr, F.lane); else tr_finish<16, true>(tB, F.g1, GATE_WSCALE, F.ws + WS_WG8, D, (nbB - 96) * 32, k0B, scr, F.lane);
        } else
        for (int it = F.gw; it < I1; it += F.NGW) { const int kb = it / 160, nb = it % 160;
            if (nb < 96) p0_transpose_item<false>(F.w_in, D, INW, F.g1, (u16*)(F.ws + WS_W1T), w1_srccol(nb * 32), nb * 32, kb * 64, scr, F.lane);
            else p0_transpose_item8(F.w_in, D, INW, F.g1, GATE_WSCALE, F.ws + WS_WG8, nb * 32, (nb - 96) * 32, kb * 64, scr, F.lane); }
    }
    {
        bf16_t* XN = (bf16_t*)(F.ws + WS_A); unsigned char* XN8 = F.ws + WS_X18;
        for (int m0 = F.gw; m0 < M; m0 += 4 * F.NGW) {
            f32x4 v[4][4]; int mr[4];
#pragma unroll
            for (int u = 0; u < 4; ++u) {
#pragma unroll
                for (int j = 0; j < 4; ++j) v[u][j] = xv[u][j];
                mr[u] = xr[u]; }
            const int m1 = m0 + 4 * F.NGW;
            if (m1 < M) {
#pragma unroll
                for (int u = 0; u < 4; ++u) { xr[u] = min(m1 + u * F.NGW, M - 1); const f32x4* xp = (const f32x4*)(F.x + (size_t)xr[u] * D) + F.lane;
#pragma unroll
                    for (int j = 0; j < 4; ++j) xv[u][j] = __builtin_nontemporal_load(xp + 64 * j); }
            }
#pragma unroll
            for (int u = 0; u < 4; ++u) {
                float s = 0.f;
#pragma unroll
                for (int j = 0; j < 4; ++j) s += (v[u][j].x * v[u][j].x + v[u][j].y * v[u][j].y) + (v[u][j].z * v[u][j].z + v[u][j].w * v[u][j].w);
                const float rstd = 1.0f / sqrtf(wave_sum(s) * (1.0f / D) + EPS);
                u32x2* o8 = (u32x2*)(XN + (size_t)mr[u] * D) + F.lane; unsigned* o4 = (unsigned*)(XN8 + (size_t)mr[u] * D) + F.lane; const float r8 = rstd * XN8_SCALE;
#pragma unroll
                for (int j = 0; j < 4; ++j) { u32x2 o; o.x = pk2bf(v[u][j].x * rstd, v[u][j].y * rstd); o.y = pk2bf(v[u][j].z * rstd, v[u][j].w * rstd); o8[64 * j] = o;
                    o4[64 * j] = (unsigned)__builtin_amdgcn_cvt_pk_fp8_f32(v[u][j].z * r8, v[u][j].w * r8, __builtin_amdgcn_cvt_pk_fp8_f32(v[u][j].x * r8, v[u][j].y * r8, 0, false), true); }
            }
        }
    }
}
__device__ __forceinline__ void convert_weights_late(Ctx& F) {
    LAS float* scr = (LAS float*)(F.lds + 32768 + F.wave * 12288);
    constexpr int IA = 8 * 32, IB = 8 * 32, IO = 16 * 32, IQ = 16 * 64, NIT = IA + IB + IO + IQ;
    for (int it = F.gw; it < NIT; it += F.NGW) {
        int r = it;
        if (r < IA) { const int kb = r / 32, nb = r % 32; p0_transpose_item<false>(F.w_a, CW, D, nullptr, (u16*)(F.ws + WS_WAT), nb * 32, nb * 32, kb * 64, scr, F.lane); continue; } r -= IA;
        if (r < IB) { const int kb = r / 32, nb = r % 32; p0_transpose_item<false>(F.w_b, CW, D, nullptr, (u16*)(F.ws + WS_WBT), nb * 32, nb * 32, kb * 64, scr, F.lane); continue; } r -= IB;
        if (r < IO) { const int kb = r / 32, nb = r % 32; p0_transpose_item<false>(F.w_out, D, D, nullptr, (u16*)(F.ws + WS_WOT), nb * 32, nb * 32, kb * 64, scr, F.lane); continue; } r -= IO;
        { const int kb = r / 64, nb = r % 64; p0_transpose_item<true>(F.w_q, D, 2048, F.g2, (u16*)(F.ws + WS_WQT), nb * 32, nb * 32, kb * 64, scr, F.lane); }
    }
    const int gt = blockIdx.x * NTHR + F.tid, NT = F.G * NTHR;
    f16_t* SKB = (f16_t*)(F.ws + WS_SKB);
    for (int i = gt; i < 16 * 128 * 128 / 4; i += NT) { const f32x4 v = ((const f32x4*)F.subk)[i]; u32x2 o; o.x = pk2h(v.x, v.y); o.y = pk2h(v.z, v.w); ((u32x2*)SKB)[i] = o; }
}
__device__ __forceinline__ unsigned fp4_code(float x, float inv) {
    const float a = fabsf(x) * inv;
    const unsigned idx = (unsigned)(a >= 0.25f) + (unsigned)(a >= 0.75f) + (unsigned)(a >= 1.25f) + (unsigned)(a >= 1.75f) + (unsigned)(a >= 2.5f) + (unsigned)(a >= 3.5f) + (unsigned)(a >= 5.0f);
    return idx | (x < 0.f ? 8u : 0u);
}
__device__ __forceinline__ float clamp6(float x) { return __builtin_fminf(__builtin_fmaxf(x, -6.0f), 6.0f); }
__device__ __forceinline__ unsigned fp4_pack8(f32x4 a, f32x4 b, float inv) {
    unsigned w = 0;
    w = __builtin_amdgcn_cvt_scalef32_pk_fp4_f32(w, clamp6(a.x * inv), clamp6(a.y * inv), 1.0f, 0);
    w = __builtin_amdgcn_cvt_scalef32_pk_fp4_f32(w, clamp6(a.z * inv), clamp6(a.w * inv), 1.0f, 1);
    w = __builtin_amdgcn_cvt_scalef32_pk_fp4_f32(w, clamp6(b.x * inv), clamp6(b.y * inv), 1.0f, 2);
    w = __builtin_amdgcn_cvt_scalef32_pk_fp4_f32(w, clamp6(b.z * inv), clamp6(b.w * inv), 1.0f, 3);
    return w;
}
__device__ __forceinline__ float wave_max(float v) {
#pragma unroll
    for (int o = 1; o < 64; o <<= 1) v = fmaxf(v, __shfl_xor(v, o));
    return v;
}
__device__ __forceinline__ void convert_tables(Ctx& F) {
    unsigned char* U4 = F.ws + WS_T; unsigned char* V4 = F.ws + WS_T + 8 * MiB; float* SU = (float*)(F.ws + WS_T + 16 * MiB); float* SV = SU + NEXP;
    f32x4 g[4];
#pragma unroll
    for (int j = 0; j < 4; ++j) g[j] = *(const f32x4*)(F.g2 + 256 * j + 4 * F.lane);
    for (int t0 = F.gw; t0 < 2 * NEXP; t0 += 4 * F.NGW) {
        f32x4 v[4][4];
#pragma unroll
        for (int u = 0; u < 4; ++u) { const int t = min(t0 + u * F.NGW, 2 * NEXP - 1); const float* src = (t < NEXP ? F.pu : F.pv) + (size_t)(t & (NEXP - 1)) * D + 4 * F.lane;
#pragma unroll
            for (int j = 0; j < 4; ++j) v[u][j] = __builtin_nontemporal_load((const f32x4*)(src + 256 * j)); }
#pragma unroll
        for (int u = 0; u < 4; ++u) {
            const int t = t0 + u * F.NGW; const bool isu = t < NEXP; const int row = t & (NEXP - 1);
            float m = 0.f;
#pragma unroll
            for (int j = 0; j < 4; ++j) { if (isu) v[u][j] = v[u][j] * g[j]; m = fmaxf(m, fmaxf(fmaxf(fabsf(v[u][j].x), fabsf(v[u][j].y)), fmaxf(fabsf(v[u][j].z), fabsf(v[u][j].w)))); }
            m = fmaxf(wave_max(m), 1.0e-30f);
            const float sc = m * 0.125f, inv = 8.0f / m;
            if (t < 2 * NEXP) {
                unsigned char* dst = (isu ? U4 : V4) + (size_t)row * 128 + 2 * F.lane;
#pragma unroll
                for (int j = 0; j < 4; ++j) { unsigned w = 0;
                    w = __builtin_amdgcn_cvt_scalef32_pk_fp4_f32(w, clamp6(v[u][j].x * inv), clamp6(v[u][j].y * inv), 1.0f, 0);
                    w = __builtin_amdgcn_cvt_scalef32_pk_fp4_f32(w, clamp6(v[u][j].z * inv), clamp6(v[u][j].w * inv), 1.0f, 1);
                    *(u16*)(dst + (size_t)j * (NEXP * 128)) = (u16)w; }
                if (F.lane == 0) (isu ? SU : SV)[row] = sc;
            }
        }
    }
}

__device__ __forceinline__ u32x4 pack8bf(f32x4 a, f32x4 b) { u32x4 w; w.x = pk2bf(a.x, a.y); w.y = pk2bf(a.z, a.w); w.z = pk2bf(b.x, b.y); w.w = pk2bf(b.z, b.w); return w; }
__device__ __forceinline__ u32x4 pack8h(f32x4 a, f32x4 b) { u32x4 w; w.x = pk2h(a.x, a.y); w.y = pk2h(a.z, a.w); w.z = pk2h(b.x, b.y); w.w = pk2h(b.z, b.w); return w; }
__device__ __forceinline__ void unpack8bf(u32x4 w, f32x4& a, f32x4& b) { a = (f32x4){bflo(w.x), bfhi(w.x), bflo(w.y), bfhi(w.y)}; b = (f32x4){bflo(w.z), bfhi(w.z), bflo(w.w), bfhi(w.w)}; }
__device__ __forceinline__ unsigned sig4u8(f32x4 v) {
    const unsigned a = (unsigned)(sigmoidf_(v.x) * 255.f + 0.5f), b = (unsigned)(sigmoidf_(v.y) * 255.f + 0.5f), c = (unsigned)(sigmoidf_(v.z) * 255.f + 0.5f), d = (unsigned)(sigmoidf_(v.w) * 255.f + 0.5f);
    return a | (b << 8) | (c << 16) | (d << 24); }
__device__ __forceinline__ f32x4 u8x4f(unsigned w) { return (f32x4){(float)(w & 0xffu), (float)((w >> 8) & 0xffu), (float)((w >> 16) & 0xffu), (float)(w >> 24)} * (1.0f / 255.0f); }
__device__ __forceinline__ f32x4 sig4(f32x4 v) { return (f32x4){sigmoidf_(v.x), sigmoidf_(v.y), sigmoidf_(v.z), sigmoidf_(v.w)}; }

struct Epi1 {
    bf16_t *BA, *CU, *Q, *K, *V;
    __device__ __forceinline__ void operator()(int row, int col, int pn, int wc, f32x4 l0, f32x4 l1, f32x4 h0, f32x4 h1) const {
        if (pn < 2) { bf16_t* p = BA + (size_t)row * CW + col; *(u32x4*)p = pack8bf(l0, l1); *(u32x4*)(p + 128) = pack8bf(h0, h1); }
        else if (pn < 6) { bf16_t* p = CU + (size_t)row * CW + (pn - 2) * 128 + (col & 255); *(u32x4*)p = pack8bf(l0 * h0, l1 * h1); }
        else if (pn < 8) { bf16_t* p = Q + (size_t)row * CW + (col - 1536); *(u32x4*)p = pack8bf(l0 * 0.125f, l1 * 0.125f); *(u32x4*)(p + 128) = pack8bf(h0 * 0.125f, h1 * 0.125f); }
        else if (pn < 10) { const int c = col - 2048, b = row >> 11, t = row & (SEQ - 1);
            *(u32x4*)(K + ((size_t)(b * NH + (c >> 6)) * LP + 32 + t) * HD + (c & 63)) = pack8bf(l0, l1);
            *(u32x4*)(K + ((size_t)(b * NH + ((c + 128) >> 6)) * LP + 32 + t) * HD + (c & 63)) = pack8bf(h0, h1); }
        else { const int c = col - 2560, b = row >> 11, t = row & (SEQ - 1);
            bf16_t* p0 = V + ((size_t)(b * NH + (c >> 6)) * HD + (c & 63)) * LP + 32 + t; bf16_t* p1 = V + ((size_t)(b * NH + ((c + 128) >> 6)) * HD + (c & 63)) * LP + 32 + t;
            p0[0] = (bf16_t)f2bf(l0.x); p0[LP] = (bf16_t)f2bf(l0.y); p0[2 * LP] = (bf16_t)f2bf(l0.z); p0[3 * LP] = (bf16_t)f2bf(l0.w);
            p0[4 * LP] = (bf16_t)f2bf(l1.x); p0[5 * LP] = (bf16_t)f2bf(l1.y); p0[6 * LP] = (bf16_t)f2bf(l1.z); p0[7 * LP] = (bf16_t)f2bf(l1.w);
            p1[0] = (bf16_t)f2bf(h0.x); p1[LP] = (bf16_t)f2bf(h0.y); p1[2 * LP] = (bf16_t)f2bf(h0.z); p1[3 * LP] = (bf16_t)f2bf(h0.w);
            p1[4 * LP] = (bf16_t)f2bf(h1.x); p1[5 * LP] = (bf16_t)f2bf(h1.y); p1[6 * LP] = (bf16_t)f2bf(h1.z); p1[7 * LP] = (bf16_t)f2bf(h1.w); }
    }
};
struct Epi1g {
    unsigned char *SGA, *SGB;
    __device__ __forceinline__ void operator()(int row, int col, int pn, int wc, f32x4 l0, f32x4 l1, f32x4 h0, f32x4 h1) const {
        constexpr float r = 1.0f / (GATE_WSCALE * XN8_SCALE);
        unsigned char* p = (pn < 4 ? SGA : SGB) + (size_t)row * D + (col & 1023); u32x2 a, b; a.x = sig4u8(l0 * r); a.y = sig4u8(l1 * r); b.x = sig4u8(h0 * r); b.y = sig4u8(h1 * r); *(u32x2*)p = a; *(u32x2*)(p + 128) = b;
    }
};
struct EpiNull { float* sink; __device__ __forceinline__ void operator()(int row, int col, int pn, int wc, f32x4 l0, f32x4 l1, f32x4 h0, f32x4 h1) const { const f32x4 t = l0 + l1 + h0 + h1; if (t.x == 1234.5f) sink[0] = t.y; } };
struct Epi3a {
    bf16_t* MIX; const unsigned char* SGA; const unsigned char* SGB;
    __device__ __forceinline__ void operator()(int row, int col, int pn, int wc, f32x4 l0, f32x4 l1, f32x4 h0, f32x4 h1) const {
        const bool add = pn >= 64;
        bf16_t* p = MIX + (size_t)row * D + col; const unsigned char* s = (add ? SGB : SGA) + (size_t)row * D + col;
        const u32x2 ga = *(const u32x2*)s, gb = *(const u32x2*)(s + 128);
        l0 = l0 * u8x4f(ga.x); l1 = l1 * u8x4f(ga.y); h0 = h0 * u8x4f(gb.x); h1 = h1 * u8x4f(gb.y);
        if (add) { f32x4 a, b, c, d; unpack8bf(*(const u32x4*)p, a, b); unpack8bf(*(const u32x4*)(p + 128), c, d); l0 += a; l1 += b; h0 += c; h1 += d; }
        *(u32x4*)p = pack8bf(l0, l1); *(u32x4*)(p + 128) = pack8bf(h0, h1);
    }
};
struct Epi3b {
    const float* x; f16_t* X1H; float* SS2; unsigned char* X18;
    __device__ __forceinline__ void operator()(int row, int col, int pn, int wc, f32x4 l0, f32x4 l1, f32x4 h0, f32x4 h1) const {
        const float* xp = x + (size_t)row * D + col; f16_t* hp = X1H + (size_t)row * D + col;
        l0 += *(const f32x4*)xp; l1 += *(const f32x4*)(xp + 4); h0 += *(const f32x4*)(xp + 128); h1 += *(const f32x4*)(xp + 132);
        *(u32x4*)hp = pack8h(l0, l1); *(u32x4*)(hp + 128) = pack8h(h0, h1);
        { unsigned char* bp = X18 + (size_t)row * D + col; u32x2 a, b; const f32x4 m0 = l0 * 4.f, m1 = l1 * 4.f, m2 = h0 * 4.f, m3 = h1 * 4.f;
          a.x = (unsigned)__builtin_amdgcn_cvt_pk_fp8_f32(m0.z, m0.w, __builtin_amdgcn_cvt_pk_fp8_f32(m0.x, m0.y, 0, false), true); a.y = (unsigned)__builtin_amdgcn_cvt_pk_fp8_f32(m1.z, m1.w, __builtin_amdgcn_cvt_pk_fp8_f32(m1.x, m1.y, 0, false), true);
          b.x = (unsigned)__builtin_amdgcn_cvt_pk_fp8_f32(m2.z, m2.w, __builtin_amdgcn_cvt_pk_fp8_f32(m2.x, m2.y, 0, false), true); b.y = (unsigned)__builtin_amdgcn_cvt_pk_fp8_f32(m3.z, m3.w, __builtin_amdgcn_cvt_pk_fp8_f32(m3.x, m3.y, 0, false), true);
          *(u32x2*)bp = a; *(u32x2*)(bp + 128) = b; }
        float s = (l0.x * l0.x + l0.y * l0.y) + (l0.z * l0.z + l0.w * l0.w) + (l1.x * l1.x + l1.y * l1.y) + (l1.z * l1.z + l1.w * l1.w)
                + (h0.x * h0.x + h0.y * h0.y) + (h0.z * h0.z + h0.w * h0.w) + (h1.x * h1.x + h1.y * h1.y) + (h1.z * h1.z + h1.w * h1.w);
        s += __shfl_xor(s, 16); s += __shfl_xor(s, 32);
        if (lane_id() < 16) SS2[(size_t)row * 16 + pn * 4 + wc] = s;
    }
};
__device__ __forceinline__ float rstd2_of(const float* SS2, int row) {
    const f32x4* p = (const f32x4*)(SS2 + (size_t)row * 16); const f32x4 a = p[0], b = p[1], c = p[2], d = p[3];
    const float s = ((a.x + a.y) + (a.z + a.w)) + ((b.x + b.y) + (b.z + b.w)) + ((c.x + c.y) + (c.z + c.w)) + ((d.x + d.y) + (d.z + d.w));
    return 1.0f / sqrtf(s * (1.0f / D) + EPS);
}
struct Epi4 {
    f16_t* QP;
    __device__ __forceinline__ void operator()(int row, int col, int pn, int wc, f32x4 l0, f32x4 l1, f32x4 h0, f32x4 h1) const {
        f16_t* p = QP + (size_t)row * 2048 + col;
        *(u32x4*)p = pack8h(l0, l1); *(u32x4*)(p + 128) = pack8h(h0, h1);
    }
};

__device__ __forceinline__ void phase2(Ctx& F) {
    const bf16_t* BA = (const bf16_t*)(F.ws + WS_B); const bf16_t* CU = BA + (size_t)M * CW; const bf16_t* Q = CU + (size_t)M * CW;
    bf16_t* O = (bf16_t*)(F.ws + WS_A); bf16_t* YA = O + (size_t)M * CW;
    const bf16_t* MK = (const bf16_t*)(F.ws + WS_META); const bf16_t* MV = MK + 16 * 512; const float* MCA = (const float*)(MV + 16 * 512); const float* MUA = MCA + 16 * 512;
    {
        const int gt = blockIdx.x * NTHR + F.tid, NT = F.G * NTHR;
        for (int it = gt; it < (M / 8) * 64; it += NT) {
            const int strip = it >> 6, c = (it & 63) * 8, r0 = strip * 8, t0 = r0 & (SEQ - 1);
            u32x4 cu[8], ba[8];
#pragma unroll
            for (int q = 0; q < 8; ++q) { cu[q] = *(const u32x4*)(CU + (size_t)(r0 + q) * CW + c); ba[q] = *(const u32x4*)(BA + (size_t)(r0 + q) * CW + c); }
            const f32x4 wa0 = *(const f32x4*)(F.conv_w + c), wa1 = *(const f32x4*)(F.conv_w + c + 4), wb0 = *(const f32x4*)(F.conv_w + CW + c), wb1 = *(const f32x4*)(F.conv_w + CW + c + 4),
                        wc0 = *(const f32x4*)(F.conv_w + 2 * CW + c), wc1 = *(const f32x4*)(F.conv_w + 2 * CW + c + 4);
            f32x4 p2a, p2b, p1a, p1b;
            if (t0 != 0) { unpack8bf(*(const u32x4*)(CU + (size_t)(r0 - 2) * CW + c), p2a, p2b); unpack8bf(*(const u32x4*)(CU + (size_t)(r0 - 1) * CW + c), p1a, p1b); }
            else { p2a = *(const f32x4*)(MCA + 14 * 512 + c) * *(const f32x4*)(MUA + 14 * 512 + c); p2b = *(const f32x4*)(MCA + 14 * 512 + c + 4) * *(const f32x4*)(MUA + 14 * 512 + c + 4);
                   p1a = *(const f32x4*)(MCA + 15 * 512 + c) * *(const f32x4*)(MUA + 15 * 512 + c); p1b = *(const f32x4*)(MCA + 15 * 512 + c + 4) * *(const f32x4*)(MUA + 15 * 512 + c + 4); }
#pragma unroll
            for (int q = 0; q < 8; ++q) {
                f32x4 ca, cb, ga, gb; unpack8bf(cu[q], ca, cb); unpack8bf(ba[q], ga, gb);
                const f32x4 ya = ga * (wa0 * p2a + wb0 * p1a + wc0 * ca), yb = gb * (wa1 * p2b + wb1 * p1b + wc1 * cb);
                *(u32x4*)(YA + (size_t)(r0 + q) * CW + c) = pack8bf(ya, yb);
                p2a = p1a; p2b = p1b; p1a = ca; p1b = cb;
            }
        }
    }
    {
        const bf16_t* KU = (const bf16_t*)(F.ws + WS_KU); const bf16_t* VT = (const bf16_t*)(F.ws + WS_VT);
        const int r = F.lane & 31, hh = F.lane >> 5;
        for (int item = F.gw; item < 64 * 64; item += F.NGW) {
            const int bh = item >> 6, a = item & 63, b = bh >> 3, h = bh & 7;
            const bf16_t* qp = Q + (size_t)(b * SEQ + 32 * a + r) * CW + h * HD + 8 * hh;
            bf16x8 qf[4];
#pragma unroll
            for (int kk = 0; kk < 4; ++kk) qf[kk] = *(const bf16x8*)(qp + 16 * kk);
            const bf16_t* kb = KU + (size_t)bh * LP * HD + (size_t)r * HD + 8 * hh;
            const bf16_t* vb0 = VT + ((size_t)bh * HD + r) * LP + 4 * hh;
            f32x16 o0, o1;
#pragma unroll
            for (int i = 0; i < 16; ++i) { o0[i] = 0.f; o1[i] = 0.f; }
            float carry = 0.f;
            bf16x8 kA[4], kB[4]; u32x2 vA[8], vB[8];
#define AT_LOAD(jj, KF, VF) do { const int _j = (jj); _Pragma("unroll") for (int kk = 0; kk < 4; ++kk) KF[kk] = *(const bf16x8*)(kb + (size_t)(32 * _j) * HD + 16 * kk); \
                _Pragma("unroll") for (int mt = 0; mt < 2; ++mt) _Pragma("unroll") for (int st = 0; st < 2; ++st) { const bf16_t* vp = vb0 + (size_t)mt * 32 * LP + 32 * _j + 16 * st; \
                    VF[(mt * 2 + st) * 2] = *(const u32x2*)vp; VF[(mt * 2 + st) * 2 + 1] = *(const u32x2*)(vp + 8); } } while (0)
#define AT_TILE(jj, KF, VF) do { const int jt = (jj); f32x16 sc; \
                _Pragma("unroll") for (int i = 0; i < 16; ++i) sc[i] = 0.f; \
                _Pragma("unroll") for (int kk = 0; kk < 4; ++kk) sc = __builtin_amdgcn_mfma_f32_32x32x16_bf16(KF[kk], qf[kk], sc, 0, 0, 0); \
                float lm[16], ls[16], ex[16], gs[4], pg[4]; \
                const bool diag = (jt == a + 1), first = (jt == 0); \
                _Pragma("unroll") for (int i = 0; i < 16; ++i) { \
                    const int key = (i & 3) + 8 * (i >> 2) + 4 * hh; \
                    const bool valid = diag ? (key < r) : (first ? (key >= 16) : true); \
                    const float z = sc[i]; \
                    const float sp = fmaxf(z, 0.f) + __logf(1.0f + __expf(-fabsf(z))); \
                    lm[i] = valid ? -sp : 0.f; ls[i] = valid ? (z - sp) : -1.0e30f; } \
                _Pragma("unroll") for (int g = 0; g < 4; ++g) { ex[4 * g + 3] = 0.f; ex[4 * g + 2] = lm[4 * g + 3]; ex[4 * g + 1] = ex[4 * g + 2] + lm[4 * g + 2]; ex[4 * g] = ex[4 * g + 1] + lm[4 * g + 1]; gs[g] = ex[4 * g] + lm[4 * g]; } \
                _Pragma("unroll") for (int g = 0; g < 4; ++g) pg[g] = __shfl_xor(gs[g], 32); \
                float os[4], pi[4], off[4]; \
                os[3] = 0.f; os[2] = gs[3]; os[1] = os[2] + gs[2]; os[0] = os[1] + gs[1]; \
                pi[3] = pg[3]; pi[2] = pi[3] + pg[2]; pi[1] = pi[2] + pg[1]; pi[0] = pi[1] + pg[0]; \
                _Pragma("unroll") for (int g = 0; g < 4; ++g) off[g] = carry + os[g] + (hh == 0 ? pi[g] : (pi[g] - pg[g])); \
                const float total = os[0] + gs[0] + pi[0]; \
                float pv[16]; \
                _Pragma("unroll") for (int i = 0; i < 16; ++i) pv[i] = __expf(ls[i] + off[i >> 2] + ex[i]); \
                carry += total; \
                bf16x8 pf[2]; \
                _Pragma("unroll") for (int st = 0; st < 2; ++st) { u32x4 w; w.x = pk2bf(pv[8 * st], pv[8 * st + 1]); w.y = pk2bf(pv[8 * st + 2], pv[8 * st + 3]); w.z = pk2bf(pv[8 * st + 4], pv[8 * st + 5]); w.w = pk2bf(pv[8 * st + 6], pv[8 * st + 7]); pf[st] = __builtin_bit_cast(bf16x8, w); } \
                _Pragma("unroll") for (int st = 0; st < 2; ++st) { \
                    u32x4 w0; w0.x = VF[st * 2].x; w0.y = VF[st * 2].y; w0.z = VF[st * 2 + 1].x; w0.w = VF[st * 2 + 1].y; \
                    u32x4 w1; w1.x = VF[(2 + st) * 2].x; w1.y = VF[(2 + st) * 2].y; w1.z = VF[(2 + st) * 2 + 1].x; w1.w = VF[(2 + st) * 2 + 1].y; \
                    o0 = __builtin_amdgcn_mfma_f32_32x32x16_bf16(__builtin_bit_cast(bf16x8, w0), pf[st], o0, 0, 0, 0); \
                    o1 = __builtin_amdgcn_mfma_f32_32x32x16_bf16(__builtin_bit_cast(bf16x8, w1), pf[st], o1, 0, 0, 0); } \
            } while (0)
            int j = a + 1;
            AT_LOAD(j, kA, vA);
            for (;;) {
                AT_LOAD(j > 0 ? j - 1 : 0, kB, vB);
                AT_TILE(j, kA, vA);
                if (j == 0 || __all(carry < -SB_THR)) break;
                --j;
                AT_LOAD(j > 0 ? j - 1 : 0, kA, vA);
                AT_TILE(j, kB, vB);
                if (j == 0 || __all(carry < -SB_THR)) break;
                --j;
            }
#undef AT_LOAD
#undef AT_TILE
            bf16_t* op = O + (size_t)(b * SEQ + 32 * a + r) * CW + h * HD + 4 * hh;
#pragma unroll
            for (int g = 0; g < 4; ++g) {
                u32x2 w0, w1; w0.x = pk2bf(o0[4 * g], o0[4 * g + 1]); w0.y = pk2bf(o0[4 * g + 2], o0[4 * g + 3]); w1.x = pk2bf(o1[4 * g], o1[4 * g + 1]); w1.y = pk2bf(o1[4 * g + 2], o1[4 * g + 3]);
                *(u32x2*)(op + 8 * g) = w0; *(u32x2*)(op + 32 + 8 * g) = w1;
            }
        }
    }
}

__device__ __forceinline__ unsigned ord_key(float s) { const unsigned u = __builtin_bit_cast(unsigned, s); return u ^ ((unsigned)((int)u >> 31) | 0x80000000u); }
__device__ __forceinline__ float ord_val(unsigned k) { const unsigned u = (k & 0x80000000u) ? (k ^ 0x80000000u) : ~k; return __builtin_bit_cast(float, u); }
#define CE(a, b) do { const unsigned _x = (a), _y = (b); (a) = _x > _y ? _x : _y; (b) = _x > _y ? _y : _x; } while (0)
#define SORT16(v) do { CE(v[0], v[1]); CE(v[2], v[3]); CE(v[0], v[2]); CE(v[1], v[3]); CE(v[1], v[2]); CE(v[4], v[5]); CE(v[6], v[7]); CE(v[4], v[6]); CE(v[5], v[7]); CE(v[5], v[6]); CE(v[0], v[4]); CE(v[2], v[6]); CE(v[2], v[4]); CE(v[1], v[5]); CE(v[3], v[7]); CE(v[3], v[5]); CE(v[1], v[2]); CE(v[3], v[4]); CE(v[5], v[6]); CE(v[8], v[9]); CE(v[10], v[11]); CE(v[8], v[10]); CE(v[9], v[11]); CE(v[9], v[10]); CE(v[12], v[13]); CE(v[14], v[15]); CE(v[12], v[14]); CE(v[13], v[15]); CE(v[13], v[14]); CE(v[8], v[12]); CE(v[10], v[14]); CE(v[10], v[12]); CE(v[9], v[13]); CE(v[11], v[15]); CE(v[11], v[13]); CE(v[9], v[10]); CE(v[11], v[12]); CE(v[13], v[14]); CE(v[0], v[8]); CE(v[4], v[12]); CE(v[4], v[8]); CE(v[2], v[10]); CE(v[6], v[14]); CE(v[6], v[10]); CE(v[2], v[4]); CE(v[6], v[8]); CE(v[10], v[12]); CE(v[1], v[9]); CE(v[5], v[13]); CE(v[5], v[9]); CE(v[3], v[11]); CE(v[7], v[15]); CE(v[7], v[11]); CE(v[3], v[5]); CE(v[7], v[9]); CE(v[11], v[13]); CE(v[1], v[2]); CE(v[3], v[4]); CE(v[5], v[6]); CE(v[7], v[8]); CE(v[9], v[10]); CE(v[11], v[12]); CE(v[13], v[14]); } while (0)
#define BMERGE16(v) do { CE(v[0], v[8]); CE(v[1], v[9]); CE(v[2], v[10]); CE(v[3], v[11]); CE(v[4], v[12]); CE(v[5], v[13]); CE(v[6], v[14]); CE(v[7], v[15]); CE(v[0], v[4]); CE(v[1], v[5]); CE(v[2], v[6]); CE(v[3], v[7]); CE(v[8], v[12]); CE(v[9], v[13]); CE(v[10], v[14]); CE(v[11], v[15]); CE(v[0], v[2]); CE(v[1], v[3]); CE(v[4], v[6]); CE(v[5], v[7]); CE(v[8], v[10]); CE(v[9], v[11]); CE(v[12], v[14]); CE(v[13], v[15]); CE(v[0], v[1]); CE(v[2], v[3]); CE(v[4], v[5]); CE(v[6], v[7]); CE(v[8], v[9]); CE(v[10], v[11]); CE(v[12], v[13]); CE(v[14], v[15]); } while (0)

#define MERGE_TOP16(a, b) do { _Pragma("unroll") for (int _i = 0; _i < 16; ++_i) { const unsigned _p = (a)[_i], _q = (b)[15 - _i]; (a)[_i] = _p > _q ? _p : _q; } BMERGE16(a); } while (0)
__device__ static constexpr int CAND_I[50] = {0, 0, 0, 0, 0, 0, 0, 0, 0, 0, 0, 0, 0, 0, 0, 0, 1, 1, 1, 1, 1, 1, 1, 1, 2, 2, 2, 2, 2, 3, 3, 3, 3, 4, 4, 4, 5, 5, 6, 6, 7, 7, 8, 9, 10, 11, 12, 13, 14, 15};
__device__ static constexpr int CAND_J[50] = {0, 1, 2, 3, 4, 5, 6, 7, 8, 9, 10, 11, 12, 13, 14, 15, 0, 1, 2, 3, 4, 5, 6, 7, 0, 1, 2, 3, 4, 0, 1, 2, 3, 0, 1, 2, 0, 1, 0, 1, 0, 1, 0, 0, 0, 0, 0, 0, 0, 0};

__device__ __forceinline__ void phase5_stage(Ctx& F) {
    const f16_t* SKB = (const f16_t*)(F.ws + WS_SKB);
    const int h = blockIdx.x & 7;
    const u32x4* src = (const u32x4*)(SKB + (size_t)(h * 2) * 128 * 128);
    u32x4 t[8];
#pragma unroll
    for (int i = 0; i < 8; ++i) t[i] = src[F.tid + NTHR * i];
#pragma unroll
    for (int i = 0; i < 8; ++i) { const int c = F.tid + NTHR * i, row = c >> 4, ch = c & 15; *(LAS u32x4*)(F.lds + row * 272 + ch * 16) = t[i]; }
    __syncthreads();
}
__device__ __forceinline__ void phase5(Ctx& F) {
    const f16_t* QP = (const f16_t*)(F.ws + WS_B);
    u16* EIDX = (u16*)(F.ws + WS_E); float* GATE = (float*)(F.ws + WS_GATE);
    const int r = F.lane & 31, hh = F.lane >> 5;
    LAS unsigned char* tab = F.lds + 73728 + F.wave * 2048 + F.lane * 32;
    const int h = blockIdx.x & 7, nbh = F.G >> 3;
    for (int tg = (blockIdx.x >> 3) + nbh * F.wave; tg < 512; tg += nbh * NWAVES) {
        const int tok = tg * 32 + r;
        unsigned T0[16], T1[16];
#pragma unroll
        for (int p = 0; p < 2; ++p) {
            const int g = h * 2 + p;
            f32x16 acc[4];
#pragma unroll
            for (int mt = 0; mt < 4; ++mt)
#pragma unroll
                for (int i = 0; i < 16; ++i) acc[mt][i] = 0.f;
            const f16_t* qp = QP + (size_t)tok * 2048 + g * 128 + 8 * hh;
            const LAS unsigned char* kp = F.lds + (p * 128 + r) * 272 + 16 * hh;
#pragma unroll
            for (int kk = 0; kk < 8; ++kk) {
                const f16x8 qf = *(const f16x8*)(qp + 16 * kk);
#pragma unroll
                for (int mt = 0; mt < 4; ++mt) { const f16x8 kf = *(const LAS f16x8*)(kp + mt * 32 * 272 + 32 * kk); acc[mt] = __builtin_amdgcn_mfma_f32_32x32x16_f16(kf, qf, acc[mt], 0, 0, 0); }
            }
            unsigned cur[16], nxt[16];
#pragma unroll
            for (int mt = 0; mt < 4; ++mt) {
#pragma unroll
                for (int i = 0; i < 16; ++i) { const int kc = 127 - (32 * mt + (i & 3) + 8 * (i >> 2)); nxt[i] = (ord_key(acc[mt][i]) & ~127u) | (unsigned)(kc - 4 * hh); }
                SORT16(nxt);
                if (mt == 0) {
#pragma unroll
                    for (int i = 0; i < 16; ++i) cur[i] = nxt[i];
                } else MERGE_TOP16(cur, nxt);
            }
#pragma unroll
            for (int i = 0; i < 16; ++i) nxt[i] = (unsigned)__shfl_xor((int)cur[i], 32);
            MERGE_TOP16(cur, nxt);
#pragma unroll
            for (int i = 0; i < 16; ++i) { if (p == 0) T0[i] = cur[i]; else T1[i] = cur[i]; }
        }
        {
            u32x4 w0, w1, w2, w3;
            w0.x = (T0[0] & 127u) | ((T0[1] & 127u) << 8) | ((T0[2] & 127u) << 16) | ((T0[3] & 127u) << 24); w0.y = (T0[4] & 127u) | ((T0[5] & 127u) << 8) | ((T0[6] & 127u) << 16) | ((T0[7] & 127u) << 24);
            w0.z = (T0[8] & 127u) | ((T0[9] & 127u) << 8) | ((T0[10] & 127u) << 16) | ((T0[11] & 127u) << 24); w0.w = (T0[12] & 127u) | ((T0[13] & 127u) << 8) | ((T0[14] & 127u) << 16) | ((T0[15] & 127u) << 24);
            w1.x = (T1[0] & 127u) | ((T1[1] & 127u) << 8) | ((T1[2] & 127u) << 16) | ((T1[3] & 127u) << 24); w1.y = (T1[4] & 127u) | ((T1[5] & 127u) << 8) | ((T1[6] & 127u) << 16) | ((T1[7] & 127u) << 24);
            w1.z = (T1[8] & 127u) | ((T1[9] & 127u) << 8) | ((T1[10] & 127u) << 16) | ((T1[11] & 127u) << 24); w1.w = (T1[12] & 127u) | ((T1[13] & 127u) << 8) | ((T1[14] & 127u) << 16) | ((T1[15] & 127u) << 24);
            *(LAS u32x4*)tab = w0; *(LAS u32x4*)(tab + 16) = w1; (void)w2; (void)w3;
        }
        float s0[16], s1[16];
#pragma unroll
        for (int i = 0; i < 16; ++i) { s0[i] = ord_val(T0[i] & ~127u); s1[i] = ord_val(T1[i] & ~127u); }
        unsigned c0[16], c1[16];
#pragma unroll
        for (int c = 0; c < 16; ++c) c0[c] = (ord_key(s0[CAND_I[c]] + s1[CAND_J[c]]) & ~255u) | (unsigned)(255 - (CAND_I[c] * 16 + CAND_J[c]));
        SORT16(c0);
#pragma unroll
        for (int c = 0; c < 16; ++c) c1[c] = (ord_key(s0[CAND_I[16 + c]] + s1[CAND_J[16 + c]]) & ~255u) | (unsigned)(255 - (CAND_I[16 + c] * 16 + CAND_J[16 + c]));
        SORT16(c1); MERGE_TOP16(c0, c1);
#pragma unroll
        for (int c = 0; c < 16; ++c) c1[c] = (ord_key(s0[CAND_I[32 + c]] + s1[CAND_J[32 + c]]) & ~255u) | (unsigned)(255 - (CAND_I[32 + c] * 16 + CAND_J[32 + c]));
        SORT16(c1); MERGE_TOP16(c0, c1);
#pragma unroll
        for (int c = 0; c < 16; ++c) c1[c] = 0u;
        c1[0] = (ord_key(s0[CAND_I[48]] + s1[CAND_J[48]]) & ~255u) | (unsigned)(255 - (CAND_I[48] * 16 + CAND_J[48]));
        c1[1] = (ord_key(s0[CAND_I[49]] + s1[CAND_J[49]]) & ~255u) | (unsigned)(255 - (CAND_I[49] * 16 + CAND_J[49]));
        CE(c1[0], c1[1]); MERGE_TOP16(c0, c1);
        float sc[16]; unsigned eid[16];
        asm volatile("s_waitcnt lgkmcnt(0)" ::: "memory");
#pragma unroll
        for (int k = 0; k < 16; ++k) {
            const unsigned ci = 255u - (c0[k] & 255u);
            const unsigned b0 = tab[ci >> 4], b1 = tab[16 + (ci & 15u)];
            eid[k] = (127u - b0) * 128u + (127u - b1);
            sc[k] = ord_val(c0[k] & ~255u);
        }
        float sum = 0.f; const float mx = sc[0], r2 = rstd2_of((const float*)(F.ws + WS_SS2), tok);
#pragma unroll
        for (int k = 0; k < 16; ++k) { sc[k] = __expf((sc[k] - mx) * r2); sum += sc[k]; }
        const float inv = 1.0f / sum;
        if (hh == 0) {
            u32x4 w0, w1;
            w0.x = eid[0] | (eid[1] << 16); w0.y = eid[2] | (eid[3] << 16); w0.z = eid[4] | (eid[5] << 16); w0.w = eid[6] | (eid[7] << 16);
            w1.x = eid[8] | (eid[9] << 16); w1.y = eid[10] | (eid[11] << 16); w1.z = eid[12] | (eid[13] << 16); w1.w = eid[14] | (eid[15] << 16);
            u32x4* ep = (u32x4*)(EIDX + (size_t)tok * NSEL + h * 16); ep[0] = w0; ep[1] = w1;
        } else {
            f32x4* gp = (f32x4*)(GATE + (size_t)tok * NSEL + h * 16);
            gp[0] = (f32x4){sc[0] * inv, sc[1] * inv, sc[2] * inv, sc[3] * inv}; gp[1] = (f32x4){sc[4] * inv, sc[5] * inv, sc[6] * inv, sc[7] * inv};
            gp[2] = (f32x4){sc[8] * inv, sc[9] * inv, sc[10] * inv, sc[11] * inv}; gp[3] = (f32x4){sc[12] * inv, sc[13] * inv, sc[14] * inv, sc[15] * inv};
        }
    }
}

__device__ __forceinline__ float gelu_tanh(float x) { const float u = 0.7978845608028654f * (x + 0.044715f * x * x * x); return 0.5f * x * (1.0f + tanhf(u)); }
__device__ __forceinline__ unsigned e16_of(const u32x4& a, const u32x4& b, int i) {
    const unsigned w = (i < 8) ? ((i >> 1) == 0 ? a.x : (i >> 1) == 1 ? a.y : (i >> 1) == 2 ? a.z : a.w) : (((i - 8) >> 1) == 0 ? b.x : ((i - 8) >> 1) == 1 ? b.y : ((i - 8) >> 1) == 2 ? b.z : b.w);
    return (i & 1) ? (w >> 16) : (w & 0xffffu);
}
#ifndef FP4_SWAP
#define FP4_SWAP 0
#endif
__device__ __forceinline__ f16x2 fp4h2(unsigned w, int b) {
    const f16x2 r = b == 0 ? __builtin_amdgcn_cvt_scalef32_pk_f16_fp4(w, 1.0f, 0) : b == 1 ? __builtin_amdgcn_cvt_scalef32_pk_f16_fp4(w, 1.0f, 1) : b == 2 ? __builtin_amdgcn_cvt_scalef32_pk_f16_fp4(w, 1.0f, 2) : __builtin_amdgcn_cvt_scalef32_pk_f16_fp4(w, 1.0f, 3);
    return FP4_SWAP ? (f16x2){r[1], r[0]} : r;
}
#define UM_IDX(k, E) do { E = *(const u32x4*)(EIDX + (size_t)(tok0 + (k) * nws) * NSEL + 8 * cA); } while (0)
#define UM_ISSUE(k, UV, XB, E) do { const u32x4* _xp = (const u32x4*)(X18 + (size_t)(tok0 + (k) * nws) * D + slice * 256 + xoff); \
        _Pragma("unroll") for (int _g = 0; _g < 8; ++_g) { const unsigned _w = (_g >> 1) == 0 ? E.x : (_g >> 1) == 1 ? E.y : (_g >> 1) == 2 ? E.z : E.w; \
            const unsigned char* _r = ub + (size_t)((_g & 1) ? (_w >> 16) : (_w & 0xffffu)) * 128; UV[2 * _g] = *(const u32x4*)_r; UV[2 * _g + 1] = *(const u32x4*)(_r + 64); } \
        XB[0] = _xp[0]; XB[1] = _xp[8]; } while (0)
#define UM_CONSUME(k, UV, XB) do { float dv[8]; \
        i32x8 bx0, bx1; \
        bx0[0] = inLo ? XB[0].x : 0u; bx0[1] = inLo ? XB[0].y : 0u; bx0[2] = inLo ? XB[0].z : 0u; bx0[3] = inLo ? XB[0].w : 0u; bx0[4] = inHi ? XB[0].x : 0u; bx0[5] = inHi ? XB[0].y : 0u; bx0[6] = inHi ? XB[0].z : 0u; bx0[7] = inHi ? XB[0].w : 0u; \
        bx1[0] = inLo ? XB[1].x : 0u; bx1[1] = inLo ? XB[1].y : 0u; bx1[2] = inLo ? XB[1].z : 0u; bx1[3] = inLo ? XB[1].w : 0u; bx1[4] = inHi ? XB[1].x : 0u; bx1[5] = inHi ? XB[1].y : 0u; bx1[6] = inHi ? XB[1].z : 0u; bx1[7] = inHi ? XB[1].w : 0u; \
        _Pragma("unroll") for (int _g = 0; _g < 8; ++_g) { \
            i32x8 ax; ax[0] = UV[2 * _g].x; ax[1] = UV[2 * _g].y; ax[2] = UV[2 * _g].z; ax[3] = UV[2 * _g].w; ax[4] = 0; ax[5] = 0; ax[6] = 0; ax[7] = 0; \
            f32x4 z = {0.f, 0.f, 0.f, 0.f}; \
            z = __builtin_amdgcn_mfma_scale_f32_16x16x128_f8f6f4(ax, bx0, z, 4, 0, 0, 0, 0, 0); \
            ax[0] = UV[2 * _g + 1].x; ax[1] = UV[2 * _g + 1].y; ax[2] = UV[2 * _g + 1].z; ax[3] = UV[2 * _g + 1].w; \
            z = __builtin_amdgcn_mfma_scale_f32_16x16x128_f8f6f4(ax, bx1, z, 4, 0, 0, 0, 0, 0); \
            float v = bq == 0 ? z.x : bq == 1 ? z.y : bq == 2 ? z.z : z.w; \
            v += __builtin_bit_cast(float, __builtin_amdgcn_update_dpp(0, __builtin_bit_cast(int, v), 0xB1, 0xf, 0xf, true)); \
            v += __builtin_bit_cast(float, __builtin_amdgcn_update_dpp(0, __builtin_bit_cast(int, v), 0x4E, 0xf, 0xf, true)); \
            dv[_g] = v; } \
        if (storer) { u32x4 o0; o0.x = pk2h(dv[0], dv[1]); o0.y = pk2h(dv[2], dv[3]); o0.z = pk2h(dv[4], dv[5]); o0.w = pk2h(dv[6], dv[7]); \
            *(u32x4*)(DOTP + ((size_t)(tok0 + (k) * nws) * 4 + slice) * NSEL + 8 * cD) = o0; } } while (0)
__device__ __forceinline__ void phaseU(Ctx& F) {
    const unsigned char* U4 = F.ws + WS_T; const u16* EIDX = (const u16*)(F.ws + WS_E); f16_t* DOTP = (f16_t*)(F.ws + WS_B); const unsigned char* X18 = F.ws + WS_X18;
    const int xl = blockIdx.x & 7, slice = xl & 3, nws = (F.G >> 3) * NWAVES, tok0 = (xl >> 2) * (M / 2) + (blockIdx.x >> 3) * NWAVES + F.wave;
    const int rho = F.lane & 15, kg = F.lane >> 4, bq = rho & 3, aq = rho >> 2;
    const int cA = 4 * aq + kg;
    const int cD = 4 * kg + aq;
    const bool inLo = aq == (kg >> 1), inHi = aq == 2 + (kg >> 1);
    const int xoff = 32 * bq + 16 * (kg & 1);
    const bool storer = bq == 0;
    const unsigned char* ub = U4 + (size_t)slice * (NEXP * 128) + bq * 16;
    const int N = (M / 2 - ((blockIdx.x >> 3) * NWAVES + F.wave) + nws - 1) / nws;
    if (N <= 0) return;
    u32x4 uvA[16], uvB[16]; u32x4 xA[2], xB[2]; u32x4 eA, eB;
    int k0 = 0;
    if (N & 1) { UM_IDX(0, eA); UM_ISSUE(0, uvA, xA, eA); UM_CONSUME(0, uvA, xA); k0 = 1; if (N == 1) return; }
    const int L = N - 1;
    UM_IDX(k0, eA);
    UM_IDX(k0 + 1, eB);
    UM_ISSUE(k0, uvA, xA, eA);
    for (int n = k0; n < N; n += 2) {
        UM_IDX(min(n + 2, L), eA);
        UM_ISSUE(n + 1, uvB, xB, eB);
        UM_CONSUME(n, uvA, xA);
        UM_IDX(min(n + 3, L), eB);
        UM_ISSUE(min(n + 2, L), uvA, xA, eA);
        UM_CONSUME(n + 1, uvB, xB);
    }
}
__device__ __forceinline__ void phaseW(Ctx& F) {
    const f16_t* DOTP = (const f16_t*)(F.ws + WS_B); const float* GATE = (const float*)(F.ws + WS_GATE); const float* SS2 = (const float*)(F.ws + WS_SS2); unsigned char* W8 = F.ws + WS_WGT;
    const u16* EIDX = (const u16*)(F.ws + WS_E); const float* SU = (const float*)(F.ws + WS_T + 16 * MiB); const float* SV = SU + NEXP;
    for (int tok0 = F.gw; tok0 < M; tok0 += 4 * F.NGW) {
        unsigned dp[4][4], ee[4]; f32x2 gt[4]; f32x4 ss[4][4];
#pragma unroll
        for (int u = 0; u < 4; ++u) {
            const int tok = min(tok0 + u * F.NGW, M - 1);
#pragma unroll
            for (int sl = 0; sl < 4; ++sl) dp[u][sl] = *(const unsigned*)(DOTP + ((size_t)tok * 4 + sl) * NSEL + 2 * F.lane);
            gt[u] = *(const f32x2*)(GATE + (size_t)tok * NSEL + 2 * F.lane);
            ee[u] = *(const unsigned*)(EIDX + (size_t)tok * NSEL + 2 * F.lane);
#pragma unroll
            for (int q = 0; q < 4; ++q) ss[u][q] = ((const f32x4*)(SS2 + (size_t)tok * 16))[q];
        }
        float su0[4], su1[4], sv0[4], sv1[4];
#pragma unroll
        for (int u = 0; u < 4; ++u) { const unsigned e0 = ee[u] & 0xffffu, e1 = ee[u] >> 16; su0[u] = SU[e0]; su1[u] = SU[e1]; sv0[u] = SV[e0]; sv1[u] = SV[e1]; }
#pragma unroll
        for (int u = 0; u < 4; ++u) {
            const int tok = tok0 + u * F.NGW;
            const f32x4 a = ss[u][0], b = ss[u][1], c = ss[u][2], d = ss[u][3];
            const float sq = ((a.x + a.y) + (a.z + a.w)) + ((b.x + b.y) + (b.z + b.w)) + ((c.x + c.y) + (c.z + c.w)) + ((d.x + d.y) + (d.z + d.w));
            const float r2 = (1.0f / 4.0f) / sqrtf(sq * (1.0f / D) + EPS);
            float d0 = 0.f, d1 = 0.f;
#pragma unroll
            for (int sl = 0; sl < 4; ++sl) { const f16x2 h = as_h2(dp[u][sl]); d0 += (float)h[0]; d1 += (float)h[1]; }
            if (tok < M) {
                const unsigned pk = (unsigned)__builtin_amdgcn_cvt_pk_fp8_f32(128.f * gt[u].x * gelu_tanh(d0 * r2 * su0[u]) * sv0[u], 128.f * gt[u].y * gelu_tanh(d1 * r2 * su1[u]) * sv1[u], 0, false);
                unsigned char* wp = W8 + (size_t)tok * NSEL + 16 * (F.lane & 7) + (F.lane >> 3);
                wp[0] = (unsigned char)(pk & 0xffu); wp[8] = (unsigned char)((pk >> 8) & 0xffu);
            }
        }
    }
}
typedef int v2i_t __attribute__((ext_vector_type(2)));
__device__ __forceinline__ void phaseV(Ctx& F) {
    const unsigned char* V4 = F.ws + WS_T + 8 * MiB; const u16* EIDX = (const u16*)(F.ws + WS_E); const unsigned char* W8 = F.ws + WS_WGT; const f16_t* X1H = (const f16_t*)(F.ws + WS_A); f16_t* X2 = (f16_t*)(F.ws + WS_B);
    const int xl = blockIdx.x & 7, slice = xl & 3, nws = (F.G >> 3) * NWAVES, tok0 = (xl >> 2) * (M / 2) + (blockIdx.x >> 3) * NWAVES + F.wave;
    const int p = F.lane >> 3, c = F.lane & 7;
    const int j = F.lane & 15, kg = F.lane >> 4;
    const unsigned char* vb = V4 + (size_t)slice * (NEXP * 128) + ((c ^ p) * 16);
    const int N = (M / 2 - ((blockIdx.x >> 3) * NWAVES + F.wave) + nws - 1) / nws;
    if (N <= 0) return;
    LAS unsigned char* fifo = F.lds + F.wave * 16384;
    const int ra = 32 * kg + j, rb = ra + 16;
    const LAS unsigned char* pa = fifo + ra * 128; const LAS unsigned char* pb = fifo + rb * 128;
    const int sa = ra & 7, sb = rb & 7;
    const int L = N - 1;
#define VT_IDX(k, EA, EB) do { const u32x4* _ep = (const u32x4*)(EIDX + (size_t)(tok0 + (k) * nws) * NSEL + p * 16); EA = _ep[0]; EB = _ep[1]; } while (0)
#define VT_DMA(EA, EB) do { _Pragma("unroll") for (int _i = 0; _i < 16; ++_i) \
        __builtin_amdgcn_global_load_lds((const unsigned*)(vb + (size_t)e16_of(EA, EB, _i) * 128), (LAS unsigned*)(fifo + 1024 * _i), 16, 0, 0); } while (0)
#define VT_META(k, WA, WB, X) do { const size_t _t = (size_t)(tok0 + (k) * nws); const u32x4* _wp = (const u32x4*)(W8 + _t * NSEL + 16 * kg); WA = _wp[0]; WB = _wp[4]; \
        const f16_t* _xp = X1H + _t * D + slice * 256 + 64 * kg + j; X[0] = *(const u16*)(_xp); X[1] = *(const u16*)(_xp + 16); X[2] = *(const u16*)(_xp + 32); X[3] = *(const u16*)(_xp + 48); } while (0)
    u32x4 e1a, e1b, wa, wb, wna, wnb; unsigned xc[4], xn[4];
    { u32x4 e0a, e0b; VT_IDX(0, e0a, e0b); VT_DMA(e0a, e0b); }
    VT_IDX(min(1, L), e1a, e1b);
    VT_META(0, wa, wb, xc);
#pragma unroll 1
    for (int n = 0; n < N; ++n) {
        asm volatile("s_waitcnt vmcnt(0)" ::: "memory");
        v2i_t ta[16], tb[16];
#pragma unroll
        for (int q = 0; q < 16; ++q) {
            ta[q] = __builtin_amdgcn_ds_read_tr4_b64_v2i32((LAS v2i_t*)(pa + (((q >> 1) ^ sa) << 4) + ((q & 1) << 3)));
            tb[q] = __builtin_amdgcn_ds_read_tr4_b64_v2i32((LAS v2i_t*)(pb + (((q >> 1) ^ sb) << 4) + ((q & 1) << 3)));
        }
        asm volatile("s_waitcnt lgkmcnt(0)" ::: "memory");
        VT_DMA(e1a, e1b);
        VT_IDX(min(n + 2, L), e1a, e1b);
        VT_META(min(n + 1, L), wna, wnb, xn);
        i32x8 aw; aw[0] = wa.x; aw[1] = wa.y; aw[2] = wa.z; aw[3] = wa.w; aw[4] = wb.x; aw[5] = wb.y; aw[6] = wb.z; aw[7] = wb.w;
        float yv[4] = {0.f, 0.f, 0.f, 0.f};
#pragma unroll
        for (int q = 0; q < 16; ++q) {
            i32x8 bv; bv[0] = ta[q].x; bv[1] = ta[q].y; bv[2] = tb[q].x; bv[3] = tb[q].y; bv[4] = 0; bv[5] = 0; bv[6] = 0; bv[7] = 0;
            f32x4 z = {0.f, 0.f, 0.f, 0.f};
            z = __builtin_amdgcn_mfma_scale_f32_16x16x128_f8f6f4(aw, bv, z, 0, 4, 0, 0, 0, 0);
            yv[q & 3] = ((q >> 2) == kg) ? z.x : yv[q & 3];
        }
        const size_t t = (size_t)(tok0 + n * nws);
        f16_t* op = X2 + t * D + slice * 256 + 64 * kg + j;
#pragma unroll
        for (int m = 0; m < 4; ++m) { const f16_t xh = __builtin_bit_cast(f16_t, (u16)xc[m]); op[16 * m] = (f16_t)((float)xh + yv[m] * (1.0f / 128.0f)); }
        wa = wna; wb = wnb;
#pragma unroll
        for (int m = 0; m < 4; ++m) xc[m] = xn[m];
    }
    asm volatile("s_waitcnt vmcnt(0)" ::: "memory");
#undef VT_IDX
#undef VT_DMA
#undef VT_META
}
__device__ __forceinline__ void phaseN(Ctx& F) {
    const f16_t* X2 = (const f16_t*)(F.ws + WS_B);
    f32x4 g[4];
#pragma unroll
    for (int c = 0; c < 4; ++c) g[c] = *(const f32x4*)(F.gf + 256 * c + 4 * F.lane);
    for (int tok0 = F.gw; tok0 < M; tok0 += 4 * F.NGW) {
        u32x2 xa[4][4];
#pragma unroll
        for (int u = 0; u < 4; ++u) {
            const int tok = min(tok0 + u * F.NGW, M - 1);
#pragma unroll
            for (int c = 0; c < 4; ++c) xa[u][c] = *(const u32x2*)(X2 + (size_t)tok * D + 256 * c + 4 * F.lane);
        }
#pragma unroll
        for (int u = 0; u < 4; ++u) {
            const int tok = tok0 + u * F.NGW;
            f32x4 a[4]; float sq = 0.f;
#pragma unroll
            for (int c = 0; c < 4; ++c) { const f16x2 p0 = as_h2(xa[u][c].x), p1 = as_h2(xa[u][c].y); a[c] = (f32x4){(float)p0[0], (float)p0[1], (float)p1[0], (float)p1[1]};
                sq += (a[c].x * a[c].x + a[c].y * a[c].y) + (a[c].z * a[c].z + a[c].w * a[c].w); }
            const float r3 = 1.0f / sqrtf(wave_sum(sq) * (1.0f / D) + EPS);
            if (tok < M) {
#pragma unroll
                for (int c = 0; c < 4; ++c) *(f32x4*)(F.out + (size_t)tok * D + 256 * c + 4 * F.lane) = a[c] * r3 * g[c];
            }
        }
    }
}

constexpr int NPHASE = 11;
__global__ void __launch_bounds__(NTHR, 2) fwd_kernel(Args args) {
    extern __shared__ __attribute__((aligned(16))) unsigned char lds[];
    Ctx F;
    F.lds = (LAS unsigned char*)lds;
    F.tid = threadIdx.x; F.lane = F.tid & 63; F.wave = __builtin_amdgcn_readfirstlane(F.tid >> 6);
    F.G = gridDim.x; F.gw = blockIdx.x * NWAVES + F.wave; F.NGW = F.G * NWAVES;
    F.x = args.in[0]; F.meta = args.in[1]; F.g1 = args.in[2]; F.w_in = args.in[3]; F.conv_w = args.in[4]; F.w_a = args.in[5]; F.w_b = args.in[6]; F.w_out = args.in[7];
    F.g2 = args.in[8]; F.w_q = args.in[9]; F.subk = args.in[10]; F.pu = args.in[11]; F.pv = args.in[12]; F.gf = args.in[13];
    F.out = args.out; F.ws = args.ws;
    volatile LAS unsigned* MISC = (volatile LAS unsigned*)(F.lds + MISC_OFF);
    if (F.tid < 32) MISC[F.tid] = 0u;
    __syncthreads();
    const int lo = args.ph_lo, hi = args.ph_hi;
    const bool multi = (hi - lo) > 1;
    XcdBarrier bar; bar.bar = (unsigned*)(F.ws + WS_CTL); bar.x = 0; bar.st = nullptr; bar.wave = F.wave;
    if (multi) bar = xcd_barrier_post((unsigned*)(F.ws + WS_CTL), MISC + 8, F.wave);
#define IN(k) (F.lane = lane_id(), F.tid = F.wave * 64 + F.lane, lo <= (k) && (k) < hi)
#define SEAM(k) do { if (IN(k) && IN((k) + 1)) xcd_barrier(bar); } while (0)

    bf16_t* BA = (bf16_t*)(F.ws + WS_B); bf16_t* CU = BA + (size_t)M * CW; bf16_t* Qb = CU + (size_t)M * CW; bf16_t* Kb = (bf16_t*)(F.ws + WS_KU); bf16_t* Vb = (bf16_t*)(F.ws + WS_VT);
    unsigned char* SGA = (unsigned char*)F.out; unsigned char* SGB = SGA + (size_t)M * D;
    bf16_t* MIX = (bf16_t*)(F.ws + WS_B);
    if (IN(0)) { phase0(F); if (DUP_PHASE == 0) { xcd_barrier(bar); phase0(F); } SEAM(0); }
    if (IN(1)) {
        pg8::Gemm g{(const u16*)(F.ws + WS_A), (const u16*)(F.ws + WS_W1T), M, 3072, D, nullptr, nullptr}; pg8::StaticOrder S; S.init(M, 3072, F.G, (int)blockIdx.x);
        pg8::EpiAdapt<Epi1> E{Epi1{BA, CU, Qb, Kb, Vb}};
        pg8::Gemm g8{(const u16*)(F.ws + WS_X18), (const u16*)(F.ws + WS_WG8), M, 2048, D / 2, nullptr, nullptr}; pg8::StaticOrder S8; S8.init(M, 2048, F.G, (int)blockIdx.x);
        pg8::EpiAdapt<Epi1g> E8{Epi1g{SGA, SGB}};
        pg8::gemm_phase<pg8::EpiAdapt<Epi1>, pg8::StaticOrder, 0>(F.lds, g, S, E, F.wave);
        pg8::gemm_phase<pg8::EpiAdapt<Epi1g>, pg8::StaticOrder, 2>(F.lds, g8, S8, E8, F.wave);
        if (DUP_PHASE == 1) { xcd_barrier(bar); pg8::gemm_phase<pg8::EpiAdapt<Epi1>, pg8::StaticOrder, 0>(F.lds, g, S, E, F.wave); }
        if (DUP_PHASE == 102) { xcd_barrier(bar); pg8::gemm_phase<pg8::EpiAdapt<Epi1g>, pg8::StaticOrder, 2>(F.lds, g8, S8, E8, F.wave); }
        SEAM(1);
    }
    if (IN(2)) { if (F.wave & 1) convert_weights_late(F); phase2(F); if (!(F.wave & 1)) convert_weights_late(F); if (DUP_PHASE == 2) { xcd_barrier(bar); phase2(F); } SEAM(2); }
    if (IN(3)) {
        pg8::PairOrder S; S.S.init(M, D, F.G, (int)blockIdx.x);
        pg8::Gemm g{(const u16*)(F.ws + WS_A + (size_t)M * CW * 2), (const u16*)(F.ws + WS_WAT), M, D, CW, (const u16*)(F.ws + WS_A), (const u16*)(F.ws + WS_WBT)};
        pg8::EpiAdapt<Epi3a> E{Epi3a{MIX, SGA, SGB}};
        pg8::gemm_phase<pg8::EpiAdapt<Epi3a>, pg8::PairOrder, 0>(F.lds, g, S, E, F.wave);
        if (DUP_PHASE == 3) { xcd_barrier(bar); pg8::gemm_phase<pg8::EpiAdapt<Epi3a>, pg8::PairOrder, 0>(F.lds, g, S, E, F.wave); }
        SEAM(3);
    }
    if (IN(4)) {
        pg8::Gemm g{(const u16*)MIX, (const u16*)(F.ws + WS_WOT), M, D, D, nullptr, nullptr}; pg8::StaticOrder S; S.init(M, D, F.G, (int)blockIdx.x);
        pg8::EpiAdapt<Epi3b> E{Epi3b{F.x, (f16_t*)(F.ws + WS_A), (float*)(F.ws + WS_SS2), F.ws + WS_X18}};
        pg8::gemm_phase<pg8::EpiAdapt<Epi3b>, pg8::StaticOrder, 0>(F.lds, g, S, E, F.wave);
        if (DUP_PHASE == 4) { xcd_barrier(bar); pg8::gemm_phase<pg8::EpiAdapt<Epi3b>, pg8::StaticOrder, 0>(F.lds, g, S, E, F.wave); }
        SEAM(4);
    }
    if (IN(5)) {
        pg8::Gemm g{(const u16*)(F.ws + WS_A), (const u16*)(F.ws + WS_WQT), M, 2048, D, nullptr, nullptr}; pg8::StaticOrder S; S.init(M, 2048, F.G, (int)blockIdx.x);
        pg8::EpiAdapt<Epi4> E{Epi4{(f16_t*)(F.ws + WS_B)}};
        pg8::gemm_phase<pg8::EpiAdapt<Epi4>, pg8::StaticOrder, 1>(F.lds, g, S, E, F.wave);
        if (DUP_PHASE == 5) { xcd_barrier(bar); pg8::gemm_phase<pg8::EpiAdapt<Epi4>, pg8::StaticOrder, 1>(F.lds, g, S, E, F.wave); }
        SEAM(5);
    }
    if (IN(6)) { phase5_stage(F); if (F.wave & 1) convert_tables(F); phase5(F); if (!(F.wave & 1)) convert_tables(F); if (DUP_PHASE == 66) { xcd_barrier(bar); convert_tables(F); } if (DUP_PHASE == 6) { xcd_barrier(bar); phase5(F); } SEAM(6); }
    if (IN(7)) { phaseU(F); if (DUP_PHASE == 7) { xcd_barrier(bar); phaseU(F); } SEAM(7); }
    if (IN(8)) { phaseW(F); if (DUP_PHASE == 8) { xcd_barrier(bar); phaseW(F); } SEAM(8); }
    if (IN(9)) { phaseV(F); if (DUP_PHASE == 9) { xcd_barrier(bar); phaseV(F); } SEAM(9); }
    if (DUP_PHASE == 200) { for (int q = 0; q < 10; ++q) xcd_barrier(bar); }
    if (IN(10)) { phaseN(F); if (DUP_PHASE == 10) { xcd_barrier(bar); phaseN(F); } }
#undef IN
#undef SEAM
}

extern "C" void kernel_launch(void* const* d_in, const int* in_sizes, int n_in, void* d_out, int out_size, void* d_ws, size_t ws_size, hipStream_t stream) {
    static int grid = 0;
    if (grid == 0) {
        if (n_in != 14 || out_size != M * D || ws_size < WS_END) { fprintf(stderr, "kernel_launch: unexpected shapes (n_in %d out %d ws %zu)\n", n_in, out_size, ws_size); grid = -1; return; }
        int dev = 0, cus = 0, per_cu = 0;
        if (hipGetDevice(&dev) != hipSuccess || hipDeviceGetAttribute(&cus, hipDeviceAttributeMultiprocessorCount, dev) != hipSuccess) { grid = -1; return; }
        if (hipFuncSetAttribute((const void*)fwd_kernel, hipFuncAttributeMaxDynamicSharedMemorySize, LDS_BYTES) != hipSuccess) { fprintf(stderr, "kernel_launch: hipFuncSetAttribute failed\n"); grid = -1; return; }
        if (hipOccupancyMaxActiveBlocksPerMultiprocessor(&per_cu, (const void*)fwd_kernel, NTHR, LDS_BYTES) != hipSuccess || per_cu < 1) { fprintf(stderr, "kernel_launch: occupancy query says %d\n", per_cu); (void)hipGetLastError(); per_cu = 1; }
        grid = cus;
    }
    if (grid < 0) return;
    (void)hipMemsetAsync((char*)d_ws + WS_CTL, 0, CTL_ZERO_BYTES, stream);
    Args a{};
    for (int i = 0; i < 14; ++i) a.in[i] = (const float*)d_in[i];
    a.out = (float*)d_out; a.ws = (unsigned char*)d_ws;
#if MK_N_LAUNCHES == 1
    a.ph_lo = 0; a.ph_hi = NPHASE;
    hipLaunchKernelGGL(fwd_kernel, dim3(grid), dim3(NTHR), LDS_BYTES, stream, a);
#else
    for (int p = 0; p < NPHASE; ++p) { a.ph_lo = p; a.ph_hi = p + 1; hipLaunchKernelGGL(fwd_kernel, dim3(grid), dim3(NTHR), LDS_BYTES, stream, a); }
#endif
}
```

```cpp
#include <hip/hip_runtime.h>
#include <cstdio>
#include <cstdint>

#ifndef MK_N_LAUNCHES
#define MK_N_LAUNCHES 1
#endif
#ifndef DUP_PHASE
#define DUP_PHASE -1
#endif
#ifndef NAIVE_GEMM
#define NAIVE_GEMM 0
#endif

#define LAS __attribute__((address_space(3)))
#define GAS __attribute__((address_space(1)))
typedef unsigned short bf16_t;
typedef unsigned short u16;
typedef _Float16 f16_t;
typedef short bf16x8 __attribute__((ext_vector_type(8)));
typedef _Float16 f16x8 __attribute__((ext_vector_type(8)));
typedef _Float16 f16x2 __attribute__((ext_vector_type(2)));
typedef float f32x4 __attribute__((ext_vector_type(4)));
typedef float f32x2 __attribute__((ext_vector_type(2)));
typedef unsigned u32x4 __attribute__((ext_vector_type(4)));
typedef unsigned u32x2 __attribute__((ext_vector_type(2)));
typedef float f32x16 __attribute__((ext_vector_type(16)));
typedef int i32x8 __attribute__((ext_vector_type(8)));
typedef int i32x4 __attribute__((ext_vector_type(4)));

constexpr int D = 1024, NB = 8, SEQ = 2048, M = NB * SEQ, NMETA = 16, CW = 512, NH = 8, HD = 64, INW = 5120;
constexpr int PH = 8, NKEY = 128, TOPK = 16, NSEL = 128, NEXP = 16384;
constexpr float EPS = 1e-6f;
constexpr float SB_THR = 44.0f;
constexpr int NWAVES = 8, NTHR = 512;

constexpr size_t MiB = 1u << 20;
constexpr size_t WS_CTL = 0, CTL_ZERO_BYTES = 64 * 1024;
constexpr size_t WS_W1T = 1 * MiB;
constexpr size_t WS_WG8 = 7 * MiB;
constexpr float GATE_WSCALE = 64.0f, XN8_SCALE = 8.0f;
constexpr size_t WS_WAT = 11 * MiB;
constexpr size_t WS_WBT = 12 * MiB;
constexpr size_t WS_WOT = 13 * MiB;
constexpr size_t WS_WQT = 15 * MiB;
constexpr size_t WS_SKB = 19 * MiB;
constexpr size_t WS_META = 19 * MiB + 512 * 1024;
constexpr size_t WS_SS2 = 20 * MiB;
constexpr size_t WS_A = 24 * MiB;
constexpr size_t WS_B = 56 * MiB;
constexpr size_t WS_KU = 104 * MiB;
constexpr size_t WS_VT = 121 * MiB;
constexpr int LP = 2080;
constexpr size_t WS_T = 140 * MiB;
constexpr size_t WS_X18 = 160 * MiB;
constexpr size_t WS_E = 200 * MiB;
constexpr size_t WS_GATE = WS_E + 4 * MiB, WS_WGT = WS_E + 12 * MiB;
constexpr size_t WS_SS3 = 21 * MiB;
constexpr size_t WS_END = 220 * MiB;

constexpr int LDS_BYTES = 147456;
constexpr int RING_BYTES = 131072;
constexpr int MISC_OFF = RING_BYTES + 320;

__device__ __forceinline__ unsigned f2bf(float f) { unsigned u = __builtin_bit_cast(unsigned, f); return (u + 0x7fffu + ((u >> 16) & 1u)) >> 16; }
__device__ __forceinline__ float bf2f(unsigned h) { return __builtin_bit_cast(float, (h & 0xffffu) << 16); }
typedef __bf16 bf16x2_t __attribute__((ext_vector_type(2)));
__device__ __forceinline__ unsigned pk2bf(float lo, float hi) { const f32x2 v = {lo, hi}; return __builtin_bit_cast(unsigned, __builtin_convertvector(v, bf16x2_t)); }
__device__ __forceinline__ unsigned pk2h(float lo, float hi) { f16x2 v = {(f16_t)lo, (f16_t)hi}; return __builtin_bit_cast(unsigned, v); }
__device__ __forceinline__ f16x2 as_h2(unsigned w) { return __builtin_bit_cast(f16x2, w); }
__device__ __forceinline__ float bflo(unsigned w) { return __builtin_bit_cast(float, w << 16); }
__device__ __forceinline__ float bfhi(unsigned w) { return __builtin_bit_cast(float, w & 0xffff0000u); }
__device__ __forceinline__ float wave_sum(float v) {
#pragma unroll
    for (int o = 1; o < 64; o <<= 1) v += __shfl_xor(v, o);
    return v;
}
__device__ __forceinline__ unsigned wave_max_u(unsigned v) {
#pragma unroll
    for (int o = 1; o < 64; o <<= 1) { unsigned t = (unsigned)__shfl_xor((int)v, o); v = t > v ? t : v; }
    return v;
}
__device__ __forceinline__ int lane_id() { int l; asm volatile("v_mbcnt_lo_u32_b32 %0, -1, 0\n\tv_mbcnt_hi_u32_b32 %0, -1, %0" : "=v"(l)); return l; }
__device__ __forceinline__ float sigmoidf_(float x) { return 1.0f / (1.0f + __expf(-x)); }

namespace pg8 {
constexpr int BM = 256, BK = 64, HALF = 128, HTB = HALF * BK * 2, STAGE_BYTES = 8 * HTB, NXCD = 8, WGM = 8;
__host__ __device__ __forceinline__ int lds_byte(int r, int c) { const int st = (r >> 4) * 2 + (c >> 5), rr = r & 15, cc = c & 31, ob = rr * 64 + cc * 2; return st * 1024 + (ob ^ (((ob >> 9) & 1) << 5)); }
__host__ __device__ __forceinline__ void stage_rc(int b, int& R, int& C) { const int st = b / 1024, sb = b % 1024, swz = sb ^ (((sb >> 9) & 1) << 5); R = (st >> 1) * 16 + swz / 64; C = (st & 1) * 32 + (swz % 64) / 2; }
__host__ __device__ __forceinline__ int perm32(int rho) { const int n = rho >> 4, i = rho & 15; return 8 * (i >> 2) + 4 * n + (i & 3); }
struct Unit { int pm, pn, which; };
struct Gemm { const u16* A; const u16* Bt; int M, N, K; const u16* A2; const u16* Bt2; };
struct StaticOrder {
    int nM, nN, nwg, G, c;
    __host__ __device__ void init(int M_, int N_, int G_, int c_) { nM = M_ / BM; nN = N_ / BM; nwg = nM * nN; G = G_; c = c_; }
    __host__ __device__ bool next(int i, Unit& u) const {
        const long L = (long)i * G + c; if (L >= nwg) return false;
        int wgid = (int)L; { const int q = nwg / NXCD, r = nwg % NXCD, xcd = wgid % NXCD, off = wgid / NXCD; wgid = (xcd < r ? xcd * (q + 1) : r * (q + 1) + (xcd - r) * q) + off; }
        const int nig = WGM * nN, gid = wgid / nig, fm = gid * WGM, gsz = (nM - fm) < WGM ? (nM - fm) : WGM;
        u.pm = fm + ((wgid % nig) % gsz); u.pn = (wgid % nig) / gsz; u.which = 0; return true;
    }
    __device__ __forceinline__ void a_ready(const Unit&) const {}
    __device__ __forceinline__ void done(const Unit&) const {}
};
struct PairOrder {
    StaticOrder S;
    __host__ __device__ bool next(int i, Unit& u) const { if (!S.next(i >> 1, u)) return false; u.which = i & 1; return true; }
    __device__ __forceinline__ void a_ready(const Unit&) const {}
    __device__ __forceinline__ void done(const Unit&) const {}
};

template <class F> struct EpiAdapt {
    static constexpr bool PERM = true, AFTER_DRAIN = false;
    F f;
    __device__ __forceinline__ void operator()(const f32x4 (&acc)[2][2][4][2], const Unit& u, int wr, int wc, int fr, int fq) const {
        int fr2 = fr; asm volatile("" : "+v"(fr2), "+v"(fq));
        const int col = u.pn * BM + wc * 32 + 8 * fq;
#pragma unroll
        for (int ai = 0; ai < 2; ++ai)
#pragma unroll
            for (int m = 0; m < 4; ++m) {
                const int row = u.pm * BM + ai * HALF + wr * 64 + m * 16 + fr2;
                f(row, col, u.pn + 64 * u.which, wc, acc[ai][0][m][0], acc[ai][0][m][1], acc[ai][1][m][0], acc[ai][1][m][1]);
            }
    }
};

#if NAIVE_GEMM
template <bool F16> __device__ __forceinline__ float dot8(u32x4 a, u32x4 b) {
    float s = 0.f;
#pragma unroll
    for (int i = 0; i < 4; ++i) {
        if (F16) { f16x2 x = as_h2(a[i]), y = as_h2(b[i]); s += (float)x[0] * (float)y[0] + (float)x[1] * (float)y[1]; }
        else s += bflo(a[i]) * bflo(b[i]) + bfhi(a[i]) * bfhi(b[i]);
    }
    return s;
}
template <class Epi, class Sched, int FMT>
__device__ __forceinline__ void gemm_phase(LAS unsigned char* lds, const Gemm g, const Sched& S, const Epi& E, const int wid) {
    constexpr bool F16 = FMT == 1;
    const int lane = lane_id(), tid = wid * 64 + lane, wr = wid >> 2, wc = wid & 3, fr = lane & 15, fq = lane >> 4;
    Unit u;
    for (int ui = 0; S.next(ui, u); ++ui) {
        f32x4 acc[2][2][4][2];
        for (int ai = 0; ai < 2; ++ai) for (int m = 0; m < 4; ++m) {
            const int row = u.pm * BM + ai * HALF + wr * 64 + m * 16 + fr;
            float a16[16];
            for (int j = 0; j < 16; ++j) a16[j] = 0.f;
            const u32x4* ap = (const u32x4*)(g.A + (size_t)row * g.K);
            for (int k8 = 0; k8 < g.K / 8; ++k8) {
                const u32x4 av = ap[k8];
#pragma unroll
                for (int j = 0; j < 16; ++j) {
                    const int col = u.pn * BM + (j >> 3) * HALF + wc * 32 + 8 * fq + (j & 7);
                    const u32x4 bv = ((const u32x4*)(g.Bt + (size_t)col * g.K))[k8];
                    a16[j] += dot8<F16>(av, bv);
                }
            }
            acc[ai][0][m][0] = (f32x4){a16[0], a16[1], a16[2], a16[3]}; acc[ai][0][m][1] = (f32x4){a16[4], a16[5], a16[6], a16[7]};
            acc[ai][1][m][0] = (f32x4){a16[8], a16[9], a16[10], a16[11]}; acc[ai][1][m][1] = (f32x4){a16[12], a16[13], a16[14], a16[15]};
        }
        E(acc, u, wr, wc, fr, fq);
    }
    __syncthreads();
}
#else
template <class Epi, class Sched, int FMT>
__device__ __forceinline__ void gemm_phase(LAS unsigned char* lds, const Gemm g, const Sched& S, const Epi& E, const int wid) {
    constexpr bool ALIGN_EPI = true; constexpr bool F16 = FMT == 1;
    const int lane = lane_id(), tid = wid * 64 + lane, wr = wid >> 2, wc = wid & 3, fr = lane & 15, fq = lane >> 4;
    const int K = g.K; int nt = K / BK;
    if constexpr (FMT == 2) asm volatile("" : "+s"(nt));
    unsigned voffA[2], voffB[2];
#pragma unroll
    for (int i = 0; i < 2; ++i) { int R, C; stage_rc(tid * 16 + i * 8192, R, C); const int Rb = Epi::PERM ? ((R & ~31) + perm32(R & 31)) : R;
        voffA[i] = (unsigned)(R * K + C) * 2u; voffB[i] = (unsigned)(Rb * K + C) * 2u; }
    const unsigned kstep = (unsigned)(BK * 2);
    const unsigned hstep = (unsigned)HALF * (unsigned)K * 2u;
    const unsigned tstep = 2u * hstep;
    const unsigned ldsw = (unsigned)wid * 1024u;
    const int aoff = lds_byte(wr * 64 + fr, fq * 8), boff = lds_byte(wc * 32 + fr, fq * 8);
#define PG8_SA(b, h) (((b) * 2 + (h)) * HTB)
#define PG8_SB(b, h) ((4 + (b) * 2 + (h)) * HTB)
#define PG8_STAGE(bufoff, gbase, goff, voff) do { unsigned _go = (goff); asm volatile("" : "+s"(_go));   \
        _Pragma("unroll") for (int _i = 0; _i < 2; ++_i) \
        __builtin_amdgcn_global_load_lds((const unsigned*)((gbase) + (_go + (voff)[_i])), (LAS unsigned*)(lds + (bufoff) + ldsw + _i * 8192), 16, 0, 0); } while (0)
#define PG8_LDA(dst, b, h) do { _Pragma("unroll") for (int m = 0; m < 4; ++m) _Pragma("unroll") for (int k = 0; k < 2; ++k) dst[m][k] = *(const LAS bf16x8*)(lds + PG8_SA(b, h) + aoff + m * 2048 + k * 1024); } while (0)
#define PG8_LDB(dst, b, h) do { _Pragma("unroll") for (int n = 0; n < 2; ++n) _Pragma("unroll") for (int k = 0; k < 2; ++k) dst[n][k] = *(const LAS bf16x8*)(lds + PG8_SB(b, h) + boff + n * 2048 + k * 1024); } while (0)
#define PG8_MMA(ai, bj, At, Bt) do { __builtin_amdgcn_s_setprio(1); _Pragma("unroll") for (int m = 0; m < 4; ++m) _Pragma("unroll") for (int n = 0; n < 2; ++n) { \
        if constexpr (FMT == 2) { const i32x8 _a = __builtin_shufflevector(__builtin_bit_cast(i32x4, Bt[n][0]), __builtin_bit_cast(i32x4, Bt[n][1]), 0, 1, 2, 3, 4, 5, 6, 7), \
                                      _b = __builtin_shufflevector(__builtin_bit_cast(i32x4, At[m][0]), __builtin_bit_cast(i32x4, At[m][1]), 0, 1, 2, 3, 4, 5, 6, 7); \
            acc[ai][bj][m][n] = __builtin_amdgcn_mfma_scale_f32_16x16x128_f8f6f4(_a, _b, acc[ai][bj][m][n], 0, 0, 0, 0, 0, 0); } \
        else { _Pragma("unroll") for (int k = 0; k < 2; ++k) { \
        if (F16) acc[ai][bj][m][n] = __builtin_amdgcn_mfma_f32_16x16x32_f16(__builtin_bit_cast(f16x8, Bt[n][k]), __builtin_bit_cast(f16x8, At[m][k]), acc[ai][bj][m][n], 0, 0, 0); \
        else acc[ai][bj][m][n] = __builtin_amdgcn_mfma_f32_16x16x32_bf16(Bt[n][k], At[m][k], acc[ai][bj][m][n], 0, 0, 0); } } } __builtin_amdgcn_s_setprio(0); } while (0)
#define PG8_WAIT_V(n) asm volatile("s_waitcnt vmcnt(" #n ")" ::: "memory")
#define PG8_WAIT_L(n) asm volatile("s_waitcnt lgkmcnt(" #n ")" ::: "memory")
#define PG8_BAR __builtin_amdgcn_s_barrier()
#define PG8_SCHED __builtin_amdgcn_sched_barrier(0)
    Unit cur, nxt; int ui = 0;
    if (!S.next(0, cur)) return;
    f32x4 acc[2][2][4][2];
#pragma unroll
    for (int a = 0; a < 2; ++a)
#pragma unroll
        for (int b = 0; b < 2; ++b)
#pragma unroll
            for (int m = 0; m < 4; ++m)
#pragma unroll
                for (int n = 0; n < 2; ++n) acc[a][b][m][n] = (f32x4){0.f, 0.f, 0.f, 0.f};
    bf16x8 At[4][2], B0[2][2], B1[2][2];
    const char* pA = (const char*)(cur.which ? g.A2 : g.A); const char* pB = (const char*)(cur.which ? g.Bt2 : g.Bt);
    unsigned cA = (unsigned)cur.pm * tstep, cB = (unsigned)cur.pn * tstep;
    S.a_ready(cur);
    {
        PG8_STAGE(PG8_SB(0, 0), pB, cB, voffB); PG8_STAGE(PG8_SB(0, 1), pB, cB + hstep, voffB); PG8_STAGE(PG8_SA(0, 0), pA, cA, voffA); PG8_STAGE(PG8_SA(0, 1), pA, cA + hstep, voffA);
        if (wr == 1) PG8_BAR;
        PG8_WAIT_V(2); PG8_BAR;
        PG8_STAGE(PG8_SB(1, 0), pB, cB + kstep, voffB); PG8_STAGE(PG8_SA(1, 0), pA, cA + kstep, voffA); PG8_STAGE(PG8_SB(1, 1), pB, cB + hstep + kstep, voffB);
        PG8_WAIT_V(6); PG8_BAR;
    }
    for (;;) {
        const bool has_next = S.next(ui + 1, nxt);
        const char* qA = has_next ? (const char*)(nxt.which ? g.A2 : g.A) : pA; const char* qB = has_next ? (const char*)(nxt.which ? g.Bt2 : g.Bt) : pB;
        const unsigned nA = has_next ? (unsigned)nxt.pm * tstep : cA, nB = has_next ? (unsigned)nxt.pn * tstep : cB;
        for (int t = 0; t < nt; t += 2) {
            const bool last = (t == nt - 2);
            const unsigned a1 = cA + (unsigned)(t + 1) * kstep;
            const char* rA = last ? qA : pA; const char* rB = last ? qB : pB;
            const unsigned a2 = last ? nA : cA + (unsigned)(t + 2) * kstep, b2 = last ? nB : cB + (unsigned)(t + 2) * kstep;
            const unsigned a3 = a2 + kstep, b3 = b2 + kstep;
            if (last && has_next) S.a_ready(nxt);
            PG8_LDB(B0, 0, 0); PG8_LDB(B1, 0, 1); PG8_SCHED; PG8_LDA(At, 0, 0); PG8_STAGE(PG8_SA(1, 1), pA, a1 + hstep, voffA);
            PG8_WAIT_V(8); PG8_WAIT_L(0); PG8_BAR; PG8_MMA(0, 0, At, B0); PG8_MMA(0, 1, At, B1); PG8_BAR; PG8_SCHED;
            PG8_LDA(At, 0, 1); PG8_STAGE(PG8_SB(0, 0), rB, b2, voffB); PG8_STAGE(PG8_SB(0, 1), rB, b2 + hstep, voffB); PG8_STAGE(PG8_SA(0, 0), rA, a2, voffA);
            PG8_WAIT_V(8); PG8_WAIT_L(0); PG8_BAR; PG8_MMA(1, 0, At, B0); PG8_MMA(1, 1, At, B1); PG8_BAR; PG8_SCHED;
            PG8_LDB(B0, 1, 0); PG8_LDB(B1, 1, 1); PG8_SCHED; PG8_LDA(At, 1, 0); PG8_STAGE(PG8_SA(0, 1), rA, a2 + hstep, voffA);
            PG8_WAIT_V(8); PG8_WAIT_L(0); PG8_BAR; PG8_MMA(0, 0, At, B0); PG8_MMA(0, 1, At, B1); PG8_BAR; PG8_SCHED;
            PG8_LDA(At, 1, 1); PG8_STAGE(PG8_SB(1, 0), rB, b3, voffB); PG8_STAGE(PG8_SB(1, 1), rB, b3 + hstep, voffB); PG8_STAGE(PG8_SA(1, 0), rA, a3, voffA);
            PG8_WAIT_V(8); PG8_WAIT_L(0); PG8_BAR; PG8_MMA(1, 0, At, B0); PG8_MMA(1, 1, At, B1); PG8_BAR; PG8_SCHED;
        }
        if constexpr (ALIGN_EPI) { if (wr == 0) PG8_BAR; }
        E(acc, cur, wr, wc, fr, fq); S.done(cur);
        if (!has_next) break;
#pragma unroll
        for (int a = 0; a < 2; ++a)
#pragma unroll
            for (int b = 0; b < 2; ++b)
#pragma unroll
                for (int m = 0; m < 4; ++m)
#pragma unroll
                    for (int n = 0; n < 2; ++n) acc[a][b][m][n] = (f32x4){0.f, 0.f, 0.f, 0.f};
        cur = nxt; cA = nA; cB = nB; pA = qA; pB = qB; ++ui;
        if constexpr (ALIGN_EPI) { if (wr == 1) PG8_BAR; }
    }
    PG8_WAIT_V(0);
    if constexpr (!ALIGN_EPI) { if (wr == 0) PG8_BAR; }
    PG8_BAR;
#undef PG8_SA
#undef PG8_SB
#undef PG8_STAGE
#undef PG8_LDA
#undef PG8_LDB
#undef PG8_MMA
#undef PG8_WAIT_V
#undef PG8_WAIT_L
#undef PG8_BAR
#undef PG8_SCHED
}
#endif
}

#define XB_TMO      128
#define XB_XCNT(j)  (256  + 64 * (j))
#define XB_XSUB(j)  (1280 + 64 * (j))
#define XB_XGEN(j)  (2304 + 64 * (j))
#define XB_TOP      3328
#define XB_TOPGEN   3392
#define XCD_BAR_WORDS 3456
#define XB_SPIN_CAP (1u << 20)
__device__ __forceinline__ unsigned xb_ld(unsigned* p)              { return __hip_atomic_load(p, __ATOMIC_RELAXED, __HIP_MEMORY_SCOPE_AGENT); }
__device__ __forceinline__ unsigned xb_add(unsigned* p, unsigned v) { return __hip_atomic_fetch_add(p, v, __ATOMIC_RELAXED, __HIP_MEMORY_SCOPE_AGENT); }
__device__ __forceinline__ unsigned xb_xcc_id() { return (unsigned)__builtin_amdgcn_s_getreg((3 << 11) | 20) & 0xFu; }
#define XB_SPIN(cond, bar) do { unsigned _sp = 0; while (cond) { __builtin_amdgcn_s_sleep(1); \
    if ((++_sp & 255u) == 0u) { if (xb_ld(&(bar)[XB_TMO])) break; if (_sp > XB_SPIN_CAP) { atomicAdd(&(bar)[XB_TMO], 1u); break; } } } } while (0)
struct XcdBarrier { unsigned* bar; unsigned x; volatile LAS unsigned* st; int wave; };
__device__ __forceinline__ XcdBarrier xcd_barrier_post(unsigned* bar, volatile LAS unsigned* st, int wave) {
    XcdBarrier b; b.bar = bar; b.x = xb_xcc_id(); b.st = st; b.wave = wave;
    if (wave == 0 && lane_id() == 0) st[4] = xb_add(&bar[XB_XCNT(b.x)], 1u);
    return b;
}
__device__ __forceinline__ void xcd_barrier_complete(unsigned* bar, unsigned x, unsigned& nloc, unsigned& nx, unsigned& regular) {
    const unsigned G = gridDim.x * gridDim.y * gridDim.z;
    unsigned sum, cnt, mine, low8, sp = 0u;
    for (;;) {
        sum = 0u; cnt = 0u; mine = 0u; low8 = 0u;
#pragma unroll
        for (unsigned j = 0; j < 16; ++j) { const unsigned c = xb_ld(&bar[XB_XCNT(j)]); sum += c; cnt += (c > 0u) ? 1u : 0u; mine = (j == x) ? c : mine; low8 += (j < 8u && c == 32u) ? 1u : 0u; }
        if (sum == G) break;
        __builtin_amdgcn_s_sleep(1);
        if ((++sp & 255u) == 0u) { if (xb_ld(&bar[XB_TMO])) break; if (sp > XB_SPIN_CAP) { atomicAdd(&bar[XB_TMO], 1u); break; } }
    }
    nloc = mine > 0u ? mine : 1u; nx = cnt > 0u ? cnt : 1u;
    regular = (G == 256u && sum == G && cnt == 8u && low8 == 8u) ? 1u : 0u;
}
__device__ __forceinline__ void xcd_barrier(const XcdBarrier& b) {
    asm volatile("s_waitcnt vmcnt(0)" ::: "memory");
    __syncthreads();
    if (b.wave == 0 && lane_id() == 0) {
        unsigned* bar = b.bar;
        __builtin_amdgcn_s_waitcnt(0);
        unsigned nloc = b.st[0], nx = b.st[1];
        if (nloc == 0u) { unsigned reg; xcd_barrier_complete(bar, b.x, nloc, nx, reg); b.st[0] = nloc; b.st[1] = nx; b.st[2] = reg; }
        const unsigned old = xb_add(&bar[XB_XSUB(b.x)], 1u);
        const unsigned gen = old / nloc;
        if (old + 1u == (gen + 1u) * nloc) {
            __builtin_amdgcn_fence(__ATOMIC_RELEASE, "agent");
            asm volatile("s_waitcnt vmcnt(0)" ::: "memory");
            const unsigned og = xb_add(&bar[XB_TOP], 1u);
            const unsigned tg = og / nx;
            if (og + 1u == (tg + 1u) * nx) xb_add(&bar[XB_TOPGEN], 1u);
            else XB_SPIN(xb_ld(&bar[XB_TOPGEN]) == tg, bar);
            __builtin_amdgcn_fence(__ATOMIC_ACQUIRE, "agent");
            xb_add(&bar[XB_XGEN(b.x)], 1u);
            asm volatile("s_waitcnt vmcnt(0)" ::: "memory");
        } else {
            XB_SPIN(xb_ld(&bar[XB_XGEN(b.x)]) == gen, bar);
            __builtin_amdgcn_fence(__ATOMIC_ACQUIRE, "agent");
            asm volatile("s_waitcnt vmcnt(0)" ::: "memory");
        }
    }
    __syncthreads();
}

#define XB_LSUB(j)  (3520 + 64 * (j))
__device__ __forceinline__ void xcd_local_barrier(const XcdBarrier& b) {
    asm volatile("s_waitcnt vmcnt(0)" ::: "memory");
    __syncthreads();
    if (b.wave == 0 && lane_id() == 0) {
        unsigned* bar = b.bar;
        __builtin_amdgcn_s_waitcnt(0);
        const unsigned nloc = b.st[0];
        const unsigned old = xb_add(&bar[XB_LSUB(b.x)], 1u);
        const unsigned tgt = (old / nloc + 1u) * nloc;
        XB_SPIN(xb_ld(&bar[XB_LSUB(b.x)]) < tgt, bar);
        __builtin_amdgcn_fence(__ATOMIC_ACQUIRE, "agent");
        asm volatile("s_waitcnt vmcnt(0)" ::: "memory");
    }
    __syncthreads();
}

struct Args { const float* in[14]; float* out; unsigned char* ws; int ph_lo, ph_hi; };
struct Ctx {
    LAS unsigned char* lds;
    int tid, lane, wave, G, gw, NGW;
    int reg, xcc, rank;
    const float *x, *meta, *g1, *w_in, *conv_w, *w_a, *w_b, *w_out, *g2, *w_q, *subk, *pu, *pv, *gf;
    float* out; unsigned char* ws;
};

__device__ __forceinline__ float one_or(const float* s, int i) { return s ? s[i] : 1.0f; }
template <bool F16>
__device__ __forceinline__ void p0_transpose_item(const float* W, int K, int N, const float* scale, u16* WT, int scol0, int drow0, int k0, LAS float* scr, int lane) {
#pragma unroll
    for (int i = 0; i < 32; ++i) { const int kk = 2 * i + (lane >> 5); scr[kk * 33 + (lane & 31)] = W[(size_t)(k0 + kk) * N + scol0 + (lane & 31)] * one_or(scale, k0 + kk); }
    asm volatile("s_waitcnt lgkmcnt(0)" ::: "memory");
    const int c = lane & 7;
#pragma unroll
    for (int j = 0; j < 4; ++j) { const int n = (lane >> 3) + 8 * j; const LAS float* s = scr + (8 * c) * 33 + n;
        u32x4 o;
        if (F16) { o.x = pk2h(s[0 * 33], s[1 * 33]); o.y = pk2h(s[2 * 33], s[3 * 33]); o.z = pk2h(s[4 * 33], s[5 * 33]); o.w = pk2h(s[6 * 33], s[7 * 33]); }
        else { o.x = pk2bf(s[0 * 33], s[1 * 33]); o.y = pk2bf(s[2 * 33], s[3 * 33]); o.z = pk2bf(s[4 * 33], s[5 * 33]); o.w = pk2bf(s[6 * 33], s[7 * 33]); }
        *(u32x4*)(WT + (size_t)(drow0 + n) * K + k0 + 8 * c) = o; }
    asm volatile("s_waitcnt lgkmcnt(0)" ::: "memory");
}
__device__ __forceinline__ void p0_transpose_item8(const float* W, int K, int N, const float* scale, float mul, unsigned char* WT8, int scol0, int drow0, int k0, LAS float* scr, int lane) {
#pragma unroll
    for (int i = 0; i < 32; ++i) { const int kk = 2 * i + (lane >> 5); scr[kk * 33 + (lane & 31)] = W[(size_t)(k0 + kk) * N + scol0 + (lane & 31)] * (mul * one_or(scale, k0 + kk)); }
    asm volatile("s_waitcnt lgkmcnt(0)" ::: "memory");
    const int n = lane & 31, hf = lane >> 5; const LAS float* s = scr + (32 * hf) * 33 + n;
    unsigned w[8];
#pragma unroll
    for (int j = 0; j < 8; ++j) w[j] = (unsigned)__builtin_amdgcn_cvt_pk_fp8_f32(s[(4 * j + 2) * 33], s[(4 * j + 3) * 33], __builtin_amdgcn_cvt_pk_fp8_f32(s[(4 * j) * 33], s[(4 * j + 1) * 33], 0, false), true);
    u32x4* op = (u32x4*)(WT8 + (size_t)(drow0 + n) * K + k0 + 32 * hf);
    op[0] = (u32x4){w[0], w[1], w[2], w[3]}; op[1] = (u32x4){w[4], w[5], w[6], w[7]};
    asm volatile("s_waitcnt lgkmcnt(0)" ::: "memory");
}
template <int KR> __device__ __forceinline__ void tr_load(const float* W, int N, int scol0, int k0, int lane, float (&t)[KR / 2]) {
#pragma unroll
    for (int i = 0; i < KR / 2; ++i) t[i] = W[(size_t)(k0 + 2 * i + (lane >> 5)) * N + scol0 + (lane & 31)];
}
template <int KR, bool FP8> __device__ __forceinline__ void tr_finish(const float (&t)[KR / 2], const float* scale, float mul, void* WT, int ldk, int drow0, int k0, LAS float* scr, int lane) {
#pragma unroll
    for (int i = 0; i < KR / 2; ++i) scr[(2 * i + (lane >> 5)) * 33 + (lane & 31)] = t[i];
    asm volatile("s_waitcnt lgkmcnt(0)" ::: "memory");
    if constexpr (!FP8) {
        constexpr int NJ = KR / 16;
        const int c = lane & (KR / 8 - 1), nl = lane / (KR / 8);
        const f32x4 ga = *(const f32x4*)(scale + k0 + 8 * c), gb = *(const f32x4*)(scale + k0 + 8 * c + 4);
#pragma unroll
        for (int j = 0; j < NJ; ++j) { const int n = nl + (512 / KR) * j; const LAS float* s = scr + (8 * c) * 33 + n;
            u32x4 o; o.x = pk2bf(s[0 * 33] * ga.x, s[1 * 33] * ga.y); o.y = pk2bf(s[2 * 33] * ga.z, s[3 * 33] * ga.w); o.z = pk2bf(s[4 * 33] * gb.x, s[5 * 33] * gb.y); o.w = pk2bf(s[6 * 33] * gb.z, s[7 * 33] * gb.w);
            *(u32x4*)((u16*)WT + (size_t)(drow0 + n) * ldk + k0 + 8 * c) = o; }
    } else {
        constexpr int KL = KR / 2;
        const int n = lane & 31, hf = lane >> 5; const LAS float* s = scr + (KL * hf) * 33 + n;
        unsigned w[KL / 4];
#pragma unroll
        for (int j = 0; j < KL / 4; ++j) { const f32x4 gq = *(const f32x4*)(scale + k0 + KL * hf + 4 * j) * mul;
            w[j] = (unsigned)__builtin_amdgcn_cvt_pk_fp8_f32(s[(4 * j + 2) * 33] * gq.z, s[(4 * j + 3) * 33] * gq.w, __builtin_amdgcn_cvt_pk_fp8_f32(s[(4 * j) * 33] * gq.x, s[(4 * j + 1) * 33] * gq.y, 0, false), true); }
        unsigned char* op = (unsigned char*)WT + (size_t)(drow0 + n) * ldk + k0 + KL * hf;
        if constexpr (KL == 32) { ((u32x4*)op)[0] = (u32x4){w[0], w[1], w[2], w[3]}; ((u32x4*)op)[1] = (u32x4){w[4], w[5], w[6], w[7]}; }
        else { *(u32x2*)op = (u32x2){w[0], w[1]}; }
    }
    asm volatile("s_waitcnt lgkmcnt(0)" ::: "memory");
}
__device__ __forceinline__ int w1_srccol(int n) {
    if (n < 512 || n >= 1536) return n;
    const int t = (n - 512) >> 8, r = (n - 512) & 255;
    return r < 128 ? 512 + 128 * t + r : 1024 + 128 * t + (r - 128);
}

__device__ __forceinline__ void phase0(Ctx& F) {
    f32x4 xv[4][4]; int xr[4];
#pragma unroll
    for (int u = 0; u < 4; ++u) { xr[u] = min(F.gw + u * F.NGW, M - 1); const f32x4* xp = (const f32x4*)(F.x + (size_t)xr[u] * D) + F.lane;
#pragma unroll
        for (int j = 0; j < 4; ++j) xv[u][j] = __builtin_nontemporal_load(xp + 64 * j); }
    const bool trfast = F.NGW == 2048;
    float tA[32], tB[8];
    const int itA = F.gw, kbA = itA / 160, nbA = itA % 160, itB = 2048 + (F.gw >> 2), kbB = itB / 160, nbB = itB % 160, k0B = kbB * 64 + 16 * (F.gw & 3);
    if (trfast) { tr_load<64>(F.w_in, INW, nbA < 96 ? w1_srccol(nbA * 32) : nbA * 32, kbA * 64, F.lane, tA); tr_load<16>(F.w_in, INW, nbB < 96 ? w1_srccol(nbB * 32) : nbB * 32, k0B, F.lane, tB); }
    {
        LAS float* mn = (LAS float*)F.lds;
        LAS float* red = (LAS float*)(F.lds + 65536);
        {
            const int r = F.wave * 2; float va[16], vb[16], gg[16]; float sa = 0.f, sb = 0.f;
#pragma unroll
            for (int j = 0; j < 16; ++j) { va[j] = F.meta[r * D + j * 64 + F.lane]; vb[j] = F.meta[(r + 1) * D + j * 64 + F.lane]; gg[j] = F.g1[j * 64 + F.lane]; }
#pragma unroll
            for (int j = 0; j < 16; ++j) { sa += va[j] * va[j]; sb += vb[j] * vb[j]; }
            const float ra = 1.0f / sqrtf(wave_sum(sa) * (1.0f / D) + EPS), rb = 1.0f / sqrtf(wave_sum(sb) * (1.0f / D) + EPS);
#pragma unroll
            for (int j = 0; j < 16; ++j) { const int k = j * 64 + F.lane; *(LAS f32x2*)(mn + k * 16 + r) = (f32x2){va[j] * ra * gg[j], vb[j] * rb * gg[j]}; }
        }
        __syncthreads();
        bf16_t* MK = (bf16_t*)(F.ws + WS_META); bf16_t* MV = MK + 16 * 512; float* MCA = (float*)(MV + 16 * 512); float* MUA = MCA + 16 * 512;
        for (int cgx = blockIdx.x; cgx < 256; cgx += F.G) {
            const int cg = (cgx & 7) * 32 + (cgx >> 3);
            const int j = F.tid & 7, kq = F.tid >> 3;
            const int gc = cg * 8 + j, which = gc >> 9, cc = gc & 511;
            const int scol = which == 0 ? 2048 + cc : which == 1 ? 2560 + cc : which == 2 ? 512 + cc : 1024 + cc;
            float wv[16];
#pragma unroll
            for (int kk = 0; kk < 16; ++kk) wv[kk] = F.w_in[(size_t)(kq * 16 + kk) * INW + scol];
            float acc[16];
#pragma unroll
            for (int r = 0; r < 16; ++r) acc[r] = 0.f;
#pragma unroll
            for (int kk = 0; kk < 16; ++kk) {
#pragma unroll
                for (int r4 = 0; r4 < 4; ++r4) { const f32x4 mv = *(const LAS f32x4*)(mn + (kq * 16 + kk) * 16 + r4 * 4);
                    acc[r4 * 4 + 0] += mv.x * wv[kk]; acc[r4 * 4 + 1] += mv.y * wv[kk]; acc[r4 * 4 + 2] += mv.z * wv[kk]; acc[r4 * 4 + 3] += mv.w * wv[kk]; }
            }
#pragma unroll
            for (int r = 0; r < 16; ++r) red[(kq * 16 + r) * 8 + j] = acc[r];
            __syncthreads();
            if (F.tid < 128) {
                const int r = F.tid >> 3, jj = F.tid & 7; float sm = 0.f;
                for (int q = 0; q < 64; ++q) sm += red[(q * 16 + r) * 8 + jj];
                const int gc2 = cg * 8 + jj, wh = gc2 >> 9, c2 = gc2 & 511;
                if (wh == 0) { MK[r * 512 + c2] = (bf16_t)f2bf(sm); bf16_t* KU = (bf16_t*)(F.ws + WS_KU);
                    for (int b = 0; b < NB; ++b) KU[((size_t)(b * NH + (c2 >> 6)) * LP + 16 + r) * HD + (c2 & 63)] = (bf16_t)f2bf(sm); }
                else if (wh == 1) { MV[r * 512 + c2] = (bf16_t)f2bf(sm); bf16_t* VT = (bf16_t*)(F.ws + WS_VT);
                    for (int b = 0; b < NB; ++b) VT[((size_t)(b * NH + (c2 >> 6)) * HD + (c2 & 63)) * LP + 16 + r] = (bf16_t)f2bf(sm); }
                else if (wh == 2) MCA[r * 512 + c2] = sm; else MUA[r * 512 + c2] = sm;
            }
            __syncthreads();
        }
    }
    {
        bf16_t* KU = (bf16_t*)(F.ws + WS_KU); bf16_t* VT = (bf16_t*)(F.ws + WS_VT);
        for (int i = blockIdx.x * NTHR + F.tid; i < 64 * 16 * 64; i += F.G * NTHR) {
            const int bh = i >> 10, rr = (i >> 6) & 15, dd = i & 63;
            KU[((size_t)bh * LP + rr) * HD + dd] = 0; VT[((size_t)bh * HD + dd) * LP + rr] = 0;
        }
    }
    {
        LAS float* scr = (LAS float*)(F.lds + F.wave * 16384);
        constexpr int I1 = 16 * 160;
        if (trfast) {
            if (nbA < 96) tr_finish<64, false>(tA, F.g1, 1.0f, F.ws + WS_W1T, D, nbA * 32, kbA * 64, scr, F.lane); else tr_finish<64, true>(tA, F.g1, GATE_WSCALE, F.ws + WS_WG8, D, (nbA - 96) * 32, kbA * 64, scr, F.lane);
            if (nbB < 96) tr_finish<16, false>(tB, F.g1, 1.0f, F.ws + WS_W1T, D, nbB * 32, k0B, scr, F.lane); else tr_finish<16, true>(tB, F.g1, GATE_WSCALE, F.ws + WS_WG8, D, (nbB - 96) * 32, k0B, scr, F.lane);
        } else
        for (int it = F.gw; it < I1; it += F.NGW) { const int kb = it / 160, nb = it % 160;
            if (nb < 96) p0_transpose_item<false>(F.w_in, D, INW, F.g1, (u16*)(F.ws + WS_W1T), w1_srccol(nb * 32), nb * 32, kb * 64, scr, F.lane);
            else p0_transpose_item8(F.w_in, D, INW, F.g1, GATE_WSCALE, F.ws + WS_WG8, nb * 32, (nb - 96) * 32, kb * 64, scr, F.lane); }
    }
    {
        bf16_t* XN = (bf16_t*)(F.ws + WS_A); unsigned char* XN8 = F.ws + WS_X18;
        for (int m0 = F.gw; m0 < M; m0 += 4 * F.NGW) {
            f32x4 v[4][4]; int mr[4];
#pragma unroll
            for (int u = 0; u < 4; ++u) {
#pragma unroll
                for (int j = 0; j < 4; ++j) v[u][j] = xv[u][j];
                mr[u] = xr[u]; }
            const int m1 = m0 + 4 * F.NGW;
            if (m1 < M) {
#pragma unroll
                for (int u = 0; u < 4; ++u) { xr[u] = min(m1 + u * F.NGW, M - 1); const f32x4* xp = (const f32x4*)(F.x + (size_t)xr[u] * D) + F.lane;
#pragma unroll
                    for (int j = 0; j < 4; ++j) xv[u][j] = __builtin_nontemporal_load(xp + 64 * j); }
            }
#pragma unroll
            for (int u = 0; u < 4; ++u) {
                float s = 0.f;
#pragma unroll
                for (int j = 0; j < 4; ++j) s += (v[u][j].x * v[u][j].x + v[u][j].y * v[u][j].y) + (v[u][j].z * v[u][j].z + v[u][j].w * v[u][j].w);
                const float rstd = 1.0f / sqrtf(wave_sum(s) * (1.0f / D) + EPS);
                u32x2* o8 = (u32x2*)(XN + (size_t)mr[u] * D) + F.lane; unsigned* o4 = (unsigned*)(XN8 + (size_t)mr[u] * D) + F.lane; const float r8 = rstd * XN8_SCALE;
#pragma unroll
                for (int j = 0; j < 4; ++j) { u32x2 o; o.x = pk2bf(v[u][j].x * rstd, v[u][j].y * rstd); o.y = pk2bf(v[u][j].z * rstd, v[u][j].w * rstd); o8[64 * j] = o;
                    o4[64 * j] = (unsigned)__builtin_amdgcn_cvt_pk_fp8_f32(v[u][j].z * r8, v[u][j].w * r8, __builtin_amdgcn_cvt_pk_fp8_f32(v[u][j].x * r8, v[u][j].y * r8, 0, false), true); }
            }
        }
    }
}
__device__ __forceinline__ void convert_weights_late(Ctx& F) {
    LAS float* scr = (LAS float*)(F.lds + 32768 + F.wave * 12288);
    constexpr int IA = 8 * 32, IB = 8 * 32, IO = 16 * 32, IQ = 16 * 64, NIT = IA + IB + IO + IQ;
    for (int it = F.gw; it < NIT; it += F.NGW) {
        int r = it;
        if (r < IA) { const int kb = r / 32, nb = r % 32; p0_transpose_item<false>(F.w_a, CW, D, nullptr, (u16*)(F.ws + WS_WAT), nb * 32, nb * 32, kb * 64, scr, F.lane); continue; } r -= IA;
        if (r < IB) { const int kb = r / 32, nb = r % 32; p0_transpose_item<false>(F.w_b, CW, D, nullptr, (u16*)(F.ws + WS_WBT), nb * 32, nb * 32, kb * 64, scr, F.lane); continue; } r -= IB;
        if (r < IO) { const int kb = r / 32, nb = r % 32; p0_transpose_item<false>(F.w_out, D, D, nullptr, (u16*)(F.ws + WS_WOT), nb * 32, nb * 32, kb * 64, scr, F.lane); continue; } r -= IO;
        { const int kb = r / 64, nb = r % 64; p0_transpose_item<true>(F.w_q, D, 2048, F.g2, (u16*)(F.ws + WS_WQT), nb * 32, nb * 32, kb * 64, scr, F.lane); }
    }
    const int gt = blockIdx.x * NTHR + F.tid, NT = F.G * NTHR;
    f16_t* SKB = (f16_t*)(F.ws + WS_SKB);
    for (int i = gt; i < 16 * 128 * 128 / 4; i += NT) { const f32x4 v = ((const f32x4*)F.subk)[i]; u32x2 o; o.x = pk2h(v.x, v.y); o.y = pk2h(v.z, v.w); ((u32x2*)SKB)[i] = o; }
}
__device__ __forceinline__ unsigned fp4_code(float x, float inv) {
    const float a = fabsf(x) * inv;
    const unsigned idx = (unsigned)(a >= 0.25f) + (unsigned)(a >= 0.75f) + (unsigned)(a >= 1.25f) + (unsigned)(a >= 1.75f) + (unsigned)(a >= 2.5f) + (unsigned)(a >= 3.5f) + (unsigned)(a >= 5.0f);
    return idx | (x < 0.f ? 8u : 0u);
}
__device__ __forceinline__ float clamp6(float x) { return __builtin_fminf(__builtin_fmaxf(x, -6.0f), 6.0f); }
__device__ __forceinline__ unsigned fp4_pack8(f32x4 a, f32x4 b, float inv) {
    unsigned w = 0;
    w = __builtin_amdgcn_cvt_scalef32_pk_fp4_f32(w, clamp6(a.x * inv), clamp6(a.y * inv), 1.0f, 0);
    w = __builtin_amdgcn_cvt_scalef32_pk_fp4_f32(w, clamp6(a.z * inv), clamp6(a.w * inv), 1.0f, 1);
    w = __builtin_amdgcn_cvt_scalef32_pk_fp4_f32(w, clamp6(b.x * inv), clamp6(b.y * inv), 1.0f, 2);
    w = __builtin_amdgcn_cvt_scalef32_pk_fp4_f32(w, clamp6(b.z * inv), clamp6(b.w * inv), 1.0f, 3);
    return w;
}
__device__ __forceinline__ float wave_max(float v) {
#pragma unroll
    for (int o = 1; o < 64; o <<= 1) v = fmaxf(v, __shfl_xor(v, o));
    return v;
}
__device__ __forceinline__ void convert_tables(Ctx& F) {
    unsigned char* U4 = F.ws + WS_T; unsigned char* V4 = F.ws + WS_T + 8 * MiB; float* SU = (float*)(F.ws + WS_T + 16 * MiB); float* SV = SU + NEXP;
    f32x4 g[4];
#pragma unroll
    for (int j = 0; j < 4; ++j) g[j] = *(const f32x4*)(F.g2 + 256 * j + 4 * F.lane);
    for (int t0 = F.gw; t0 < 2 * NEXP; t0 += 4 * F.NGW) {
        f32x4 v[4][4];
#pragma unroll
        for (int u = 0; u < 4; ++u) { const int t = min(t0 + u * F.NGW, 2 * NEXP - 1); const float* src = (t < NEXP ? F.pu : F.pv) + (size_t)(t & (NEXP - 1)) * D + 4 * F.lane;
#pragma unroll
            for (int j = 0; j < 4; ++j) v[u][j] = __builtin_nontemporal_load((const f32x4*)(src + 256 * j)); }
#pragma unroll
        for (int u = 0; u < 4; ++u) {
            const int t = t0 + u * F.NGW; const bool isu = t < NEXP; const int row = t & (NEXP - 1);
            float m = 0.f;
#pragma unroll
            for (int j = 0; j < 4; ++j) { if (isu) v[u][j] = v[u][j] * g[j]; m = fmaxf(m, fmaxf(fmaxf(fabsf(v[u][j].x), fabsf(v[u][j].y)), fmaxf(fabsf(v[u][j].z), fabsf(v[u][j].w)))); }
            m = fmaxf(wave_max(m), 1.0e-30f);
            const float sc = m * 0.125f, inv = 8.0f / m;
            if (t < 2 * NEXP) {
                unsigned char* dst = (isu ? U4 : V4) + (size_t)row * 128 + 2 * F.lane;
#pragma unroll
                for (int j = 0; j < 4; ++j) { unsigned w = 0;
                    w = __builtin_amdgcn_cvt_scalef32_pk_fp4_f32(w, clamp6(v[u][j].x * inv), clamp6(v[u][j].y * inv), 1.0f, 0);
                    w = __builtin_amdgcn_cvt_scalef32_pk_fp4_f32(w, clamp6(v[u][j].z * inv), clamp6(v[u][j].w * inv), 1.0f, 1);
                    *(u16*)(dst + (size_t)j * (NEXP * 128)) = (u16)w; }
                if (F.lane == 0) (isu ? SU : SV)[row] = sc;
            }
        }
    }
}

__device__ __forceinline__ u32x4 pack8bf(f32x4 a, f32x4 b) { u32x4 w; w.x = pk2bf(a.x, a.y); w.y = pk2bf(a.z, a.w); w.z = pk2bf(b.x, b.y); w.w = pk2bf(b.z, b.w); return w; }
__device__ __forceinline__ u32x4 pack8h(f32x4 a, f32x4 b) { u32x4 w; w.x = pk2h(a.x, a.y); w.y = pk2h(a.z, a.w); w.z = pk2h(b.x, b.y); w.w = pk2h(b.z, b.w); return w; }
__device__ __forceinline__ void unpack8bf(u32x4 w, f32x4& a, f32x4& b) { a = (f32x4){bflo(w.x), bfhi(w.x), bflo(w.y), bfhi(w.y)}; b = (f32x4){bflo(w.z), bfhi(w.z), bflo(w.w), bfhi(w.w)}; }
__device__ __forceinline__ unsigned sig4u8(f32x4 v) {
    const unsigned a = (unsigned)(sigmoidf_(v.x) * 255.f + 0.5f), b = (unsigned)(sigmoidf_(v.y) * 255.f + 0.5f), c = (unsigned)(sigmoidf_(v.z) * 255.f + 0.5f), d = (unsigned)(sigmoidf_(v.w) * 255.f + 0.5f);
    return a | (b << 8) | (c << 16) | (d << 24); }
__device__ __forceinline__ f32x4 u8x4f(unsigned w) { return (f32x4){(float)(w & 0xffu), (float)((w >> 8) & 0xffu), (float)((w >> 16) & 0xffu), (float)(w >> 24)} * (1.0f / 255.0f); }
__device__ __forceinline__ f32x4 sig4(f32x4 v) { return (f32x4){sigmoidf_(v.x), sigmoidf_(v.y), sigmoidf_(v.z), sigmoidf_(v.w)}; }

struct Epi1 {
    bf16_t *BA, *CU, *Q, *K, *V;
    __device__ __forceinline__ void operator()(int row, int col, int pn, int wc, f32x4 l0, f32x4 l1, f32x4 h0, f32x4 h1) const {
        if (pn < 2) { bf16_t* p = BA + (size_t)row * CW + col; *(u32x4*)p = pack8bf(l0, l1); *(u32x4*)(p + 128) = pack8bf(h0, h1); }
        else if (pn < 6) { bf16_t* p = CU + (size_t)row * CW + (pn - 2) * 128 + (col & 255); *(u32x4*)p = pack8bf(l0 * h0, l1 * h1); }
        else if (pn < 8) { bf16_t* p = Q + (size_t)row * CW + (col - 1536); *(u32x4*)p = pack8bf(l0 * 0.125f, l1 * 0.125f); *(u32x4*)(p + 128) = pack8bf(h0 * 0.125f, h1 * 0.125f); }
        else if (pn < 10) { const int c = col - 2048, b = row >> 11, t = row & (SEQ - 1);
            *(u32x4*)(K + ((size_t)(b * NH + (c >> 6)) * LP + 32 + t) * HD + (c & 63)) = pack8bf(l0, l1);
            *(u32x4*)(K + ((size_t)(b * NH + ((c + 128) >> 6)) * LP + 32 + t) * HD + (c & 63)) = pack8bf(h0, h1); }
        else { const int c = col - 2560, b = row >> 11, t = row & (SEQ - 1);
            bf16_t* p0 = V + ((size_t)(b * NH + (c >> 6)) * HD + (c & 63)) * LP + 32 + t; bf16_t* p1 = V + ((size_t)(b * NH + ((c + 128) >> 6)) * HD + (c & 63)) * LP + 32 + t;
            p0[0] = (bf16_t)f2bf(l0.x); p0[LP] = (bf16_t)f2bf(l0.y); p0[2 * LP] = (bf16_t)f2bf(l0.z); p0[3 * LP] = (bf16_t)f2bf(l0.w);
            p0[4 * LP] = (bf16_t)f2bf(l1.x); p0[5 * LP] = (bf16_t)f2bf(l1.y); p0[6 * LP] = (bf16_t)f2bf(l1.z); p0[7 * LP] = (bf16_t)f2bf(l1.w);
            p1[0] = (bf16_t)f2bf(h0.x); p1[LP] = (bf16_t)f2bf(h0.y); p1[2 * LP] = (bf16_t)f2bf(h0.z); p1[3 * LP] = (bf16_t)f2bf(h0.w);
            p1[4 * LP] = (bf16_t)f2bf(h1.x); p1[5 * LP] = (bf16_t)f2bf(h1.y); p1[6 * LP] = (bf16_t)f2bf(h1.z); p1[7 * LP] = (bf16_t)f2bf(h1.w); }
    }
};
struct Epi1g {
    unsigned char *SGA, *SGB;
    __device__ __forceinline__ void operator()(int row, int col, int pn, int wc, f32x4 l0, f32x4 l1, f32x4 h0, f32x4 h1) const {
        constexpr float r = 1.0f / (GATE_WSCALE * XN8_SCALE);
        unsigned char* p = (pn < 4 ? SGA : SGB) + (size_t)row * D + (col & 1023); u32x2 a, b; a.x = sig4u8(l0 * r); a.y = sig4u8(l1 * r); b.x = sig4u8(h0 * r); b.y = sig4u8(h1 * r); *(u32x2*)p = a; *(u32x2*)(p + 128) = b;
    }
};
struct EpiNull { float* sink; __device__ __forceinline__ void operator()(int row, int col, int pn, int wc, f32x4 l0, f32x4 l1, f32x4 h0, f32x4 h1) const { const f32x4 t = l0 + l1 + h0 + h1; if (t.x == 1234.5f) sink[0] = t.y; } };
struct Epi3a {
    bf16_t* MIX; const unsigned char* SGA; const unsigned char* SGB;
    __device__ __forceinline__ void operator()(int row, int col, int pn, int wc, f32x4 l0, f32x4 l1, f32x4 h0, f32x4 h1) const {
        const bool add = pn >= 64;
        bf16_t* p = MIX + (size_t)row * D + col; const unsigned char* s = (add ? SGB : SGA) + (size_t)row * D + col;
        const u32x2 ga = *(const u32x2*)s, gb = *(const u32x2*)(s + 128);
        l0 = l0 * u8x4f(ga.x); l1 = l1 * u8x4f(ga.y); h0 = h0 * u8x4f(gb.x); h1 = h1 * u8x4f(gb.y);
        if (add) { f32x4 a, b, c, d; unpack8bf(*(const u32x4*)p, a, b); unpack8bf(*(const u32x4*)(p + 128), c, d); l0 += a; l1 += b; h0 += c; h1 += d; }
        *(u32x4*)p = pack8bf(l0, l1); *(u32x4*)(p + 128) = pack8bf(h0, h1);
    }
};
struct Epi3b {
    const float* x; f16_t* X1H; float* SS2; unsigned char* X18;
    __device__ __forceinline__ void operator()(int row, int col, int pn, int wc, f32x4 l0, f32x4 l1, f32x4 h0, f32x4 h1) const {
        const float* xp = x + (size_t)row * D + col; f16_t* hp = X1H + (size_t)row * D + col;
        l0 += *(const f32x4*)xp; l1 += *(const f32x4*)(xp + 4); h0 += *(const f32x4*)(xp + 128); h1 += *(const f32x4*)(xp + 132);
        *(u32x4*)hp = pack8h(l0, l1); *(u32x4*)(hp + 128) = pack8h(h0, h1);
        { unsigned char* bp = X18 + (size_t)row * D + col; u32x2 a, b; const f32x4 m0 = l0 * 4.f, m1 = l1 * 4.f, m2 = h0 * 4.f, m3 = h1 * 4.f;
          a.x = (unsigned)__builtin_amdgcn_cvt_pk_fp8_f32(m0.z, m0.w, __builtin_amdgcn_cvt_pk_fp8_f32(m0.x, m0.y, 0, false), true); a.y = (unsigned)__builtin_amdgcn_cvt_pk_fp8_f32(m1.z, m1.w, __builtin_amdgcn_cvt_pk_fp8_f32(m1.x, m1.y, 0, false), true);
          b.x = (unsigned)__builtin_amdgcn_cvt_pk_fp8_f32(m2.z, m2.w, __builtin_amdgcn_cvt_pk_fp8_f32(m2.x, m2.y, 0, false), true); b.y = (unsigned)__builtin_amdgcn_cvt_pk_fp8_f32(m3.z, m3.w, __builtin_amdgcn_cvt_pk_fp8_f32(m3.x, m3.y, 0, false), true);
          *(u32x2*)bp = a; *(u32x2*)(bp + 128) = b; }
        float s = (l0.x * l0.x + l0.y * l0.y) + (l0.z * l0.z + l0.w * l0.w) + (l1.x * l1.x + l1.y * l1.y) + (l1.z * l1.z + l1.w * l1.w)
                + (h0.x * h0.x + h0.y * h0.y) + (h0.z * h0.z + h0.w * h0.w) + (h1.x * h1.x + h1.y * h1.y) + (h1.z * h1.z + h1.w * h1.w);
        s += __shfl_xor(s, 16); s += __shfl_xor(s, 32);
        if (lane_id() < 16) SS2[(size_t)row * 16 + pn * 4 + wc] = s;
    }
};
__device__ __forceinline__ float rstd2_of(const float* SS2, int row) {
    const f32x4* p = (const f32x4*)(SS2 + (size_t)row * 16); const f32x4 a = p[0], b = p[1], c = p[2], d = p[3];
    const float s = ((a.x + a.y) + (a.z + a.w)) + ((b.x + b.y) + (b.z + b.w)) + ((c.x + c.y) + (c.z + c.w)) + ((d.x + d.y) + (d.z + d.w));
    return 1.0f / sqrtf(s * (1.0f / D) + EPS);
}
struct Epi4 {
    f16_t* QP;
    __device__ __forceinline__ void operator()(int row, int col, int pn, int wc, f32x4 l0, f32x4 l1, f32x4 h0, f32x4 h1) const {
        f16_t* p = QP + (size_t)row * 2048 + col;
        *(u32x4*)p = pack8h(l0, l1); *(u32x4*)(p + 128) = pack8h(h0, h1);
    }
};

__device__ __forceinline__ void phase2(Ctx& F) {
    const bf16_t* BA = (const bf16_t*)(F.ws + WS_B); const bf16_t* CU = BA + (size_t)M * CW; const bf16_t* Q = CU + (size_t)M * CW;
    bf16_t* O = (bf16_t*)(F.ws + WS_A); bf16_t* YA = O + (size_t)M * CW;
    const bf16_t* MK = (const bf16_t*)(F.ws + WS_META); const bf16_t* MV = MK + 16 * 512; const float* MCA = (const float*)(MV + 16 * 512); const float* MUA = MCA + 16 * 512;
    {
        const int gt = (F.reg ? F.xcc * 32 + F.rank : (int)blockIdx.x) * NTHR + F.tid, NT = F.G * NTHR;
        for (int it = gt; it < (M / 8) * 64; it += NT) {
            const int strip = it >> 6, c = (it & 63) * 8, r0 = strip * 8, t0 = r0 & (SEQ - 1);
            u32x4 cu[8], ba[8];
#pragma unroll
            for (int q = 0; q < 8; ++q) { cu[q] = *(const u32x4*)(CU + (size_t)(r0 + q) * CW + c); ba[q] = *(const u32x4*)(BA + (size_t)(r0 + q) * CW + c); }
            const f32x4 wa0 = *(const f32x4*)(F.conv_w + c), wa1 = *(const f32x4*)(F.conv_w + c + 4), wb0 = *(const f32x4*)(F.conv_w + CW + c), wb1 = *(const f32x4*)(F.conv_w + CW + c + 4),
                        wc0 = *(const f32x4*)(F.conv_w + 2 * CW + c), wc1 = *(const f32x4*)(F.conv_w + 2 * CW + c + 4);
            f32x4 p2a, p2b, p1a, p1b;
            if (t0 != 0) { unpack8bf(*(const u32x4*)(CU + (size_t)(r0 - 2) * CW + c), p2a, p2b); unpack8bf(*(const u32x4*)(CU + (size_t)(r0 - 1) * CW + c), p1a, p1b); }
            else { p2a = *(const f32x4*)(MCA + 14 * 512 + c) * *(const f32x4*)(MUA + 14 * 512 + c); p2b = *(const f32x4*)(MCA + 14 * 512 + c + 4) * *(const f32x4*)(MUA + 14 * 512 + c + 4);
                   p1a = *(const f32x4*)(MCA + 15 * 512 + c) * *(const f32x4*)(MUA + 15 * 512 + c); p1b = *(const f32x4*)(MCA + 15 * 512 + c + 4) * *(const f32x4*)(MUA + 15 * 512 + c + 4); }
#pragma unroll
            for (int q = 0; q < 8; ++q) {
                f32x4 ca, cb, ga, gb; unpack8bf(cu[q], ca, cb); unpack8bf(ba[q], ga, gb);
                const f32x4 ya = ga * (wa0 * p2a + wb0 * p1a + wc0 * ca), yb = gb * (wa1 * p2b + wb1 * p1b + wc1 * cb);
                *(u32x4*)(YA + (size_t)(r0 + q) * CW + c) = pack8bf(ya, yb);
                p2a = p1a; p2b = p1b; p1a = ca; p1b = cb;
            }
        }
    }
    {
        const bf16_t* KU = (const bf16_t*)(F.ws + WS_KU); const bf16_t* VT = (const bf16_t*)(F.ws + WS_VT);
        const int r = F.lane & 31, hh = F.lane >> 5;
        const int item0 = F.reg ? F.xcc * 512 + F.rank * 8 + F.wave : F.gw, istep = F.reg ? 256 : F.NGW, iend = F.reg ? F.xcc * 512 + 512 : 64 * 64;
        for (int item = item0; item < iend; item += istep) {
            const int bh = item >> 6, a = item & 63, b = bh >> 3, h = bh & 7;
            const bf16_t* qp = Q + (size_t)(b * SEQ + 32 * a + r) * CW + h * HD + 8 * hh;
            bf16x8 qf[4];
#pragma unroll
            for (int kk = 0; kk < 4; ++kk) qf[kk] = *(const bf16x8*)(qp + 16 * kk);
            const bf16_t* kb = KU + (size_t)bh * LP * HD + (size_t)r * HD + 8 * hh;
            const bf16_t* vb0 = VT + ((size_t)bh * HD + r) * LP + 4 * hh;
            f32x16 o0, o1;
#pragma unroll
            for (int i = 0; i < 16; ++i) { o0[i] = 0.f; o1[i] = 0.f; }
            float carry = 0.f;
            bf16x8 kA[4], kB[4]; u32x2 vA[8], vB[8];
#define AT_LOAD(jj, KF, VF) do { const int _j = (jj); _Pragma("unroll") for (int kk = 0; kk < 4; ++kk) KF[kk] = *(const bf16x8*)(kb + (size_t)(32 * _j) * HD + 16 * kk); \
                _Pragma("unroll") for (int mt = 0; mt < 2; ++mt) _Pragma("unroll") for (int st = 0; st < 2; ++st) { const bf16_t* vp = vb0 + (size_t)mt * 32 * LP + 32 * _j + 16 * st; \
                    VF[(mt * 2 + st) * 2] = *(const u32x2*)vp; VF[(mt * 2 + st) * 2 + 1] = *(const u32x2*)(vp + 8); } } while (0)
#define AT_TILE(jj, KF, VF) do { const int jt = (jj); f32x16 sc; \
                _Pragma("unroll") for (int i = 0; i < 16; ++i) sc[i] = 0.f; \
                _Pragma("unroll") for (int kk = 0; kk < 4; ++kk) sc = __builtin_amdgcn_mfma_f32_32x32x16_bf16(KF[kk], qf[kk], sc, 0, 0, 0); \
                float lm[16], ls[16], ex[16], gs[4], pg[4]; \
                const bool diag = (jt == a + 1), first = (jt == 0); \
                _Pragma("unroll") for (int i = 0; i < 16; ++i) { \
                    const int key = (i & 3) + 8 * (i >> 2) + 4 * hh; \
                    const bool valid = diag ? (key < r) : (first ? (key >= 16) : true); \
                    const float z = sc[i]; \
                    const float sp = fmaxf(z, 0.f) + __logf(1.0f + __expf(-fabsf(z))); \
                    lm[i] = valid ? -sp : 0.f; ls[i] = valid ? (z - sp) : -1.0e30f; } \
                _Pragma("unroll") for (int g = 0; g < 4; ++g) { ex[4 * g + 3] = 0.f; ex[4 * g + 2] = lm[4 * g + 3]; ex[4 * g + 1] = ex[4 * g + 2] + lm[4 * g + 2]; ex[4 * g] = ex[4 * g + 1] + lm[4 * g + 1]; gs[g] = ex[4 * g] + lm[4 * g]; } \
                _Pragma("unroll") for (int g = 0; g < 4; ++g) pg[g] = __shfl_xor(gs[g], 32); \
                float os[4], pi[4], off[4]; \
                os[3] = 0.f; os[2] = gs[3]; os[1] = os[2] + gs[2]; os[0] = os[1] + gs[1]; \
                pi[3] = pg[3]; pi[2] = pi[3] + pg[2]; pi[1] = pi[2] + pg[1]; pi[0] = pi[1] + pg[0]; \
                _Pragma("unroll") for (int g = 0; g < 4; ++g) off[g] = carry + os[g] + (hh == 0 ? pi[g] : (pi[g] - pg[g])); \
                const float total = os[0] + gs[0] + pi[0]; \
                float pv[16]; \
                _Pragma("unroll") for (int i = 0; i < 16; ++i) pv[i] = __expf(ls[i] + off[i >> 2] + ex[i]); \
                carry += total; \
                bf16x8 pf[2]; \
                _Pragma("unroll") for (int st = 0; st < 2; ++st) { u32x4 w; w.x = pk2bf(pv[8 * st], pv[8 * st + 1]); w.y = pk2bf(pv[8 * st + 2], pv[8 * st + 3]); w.z = pk2bf(pv[8 * st + 4], pv[8 * st + 5]); w.w = pk2bf(pv[8 * st + 6], pv[8 * st + 7]); pf[st] = __builtin_bit_cast(bf16x8, w); } \
                _Pragma("unroll") for (int st = 0; st < 2; ++st) { \
                    u32x4 w0; w0.x = VF[st * 2].x; w0.y = VF[st * 2].y; w0.z = VF[st * 2 + 1].x; w0.w = VF[st * 2 + 1].y; \
                    u32x4 w1; w1.x = VF[(2 + st) * 2].x; w1.y = VF[(2 + st) * 2].y; w1.z = VF[(2 + st) * 2 + 1].x; w1.w = VF[(2 + st) * 2 + 1].y; \
                    o0 = __builtin_amdgcn_mfma_f32_32x32x16_bf16(__builtin_bit_cast(bf16x8, w0), pf[st], o0, 0, 0, 0); \
                    o1 = __builtin_amdgcn_mfma_f32_32x32x16_bf16(__builtin_bit_cast(bf16x8, w1), pf[st], o1, 0, 0, 0); } \
            } while (0)
            int j = a + 1;
            AT_LOAD(j, kA, vA);
            for (;;) {
                AT_LOAD(j > 0 ? j - 1 : 0, kB, vB);
                AT_TILE(j, kA, vA);
                if (j == 0 || __all(carry < -SB_THR)) break;
                --j;
                AT_LOAD(j > 0 ? j - 1 : 0, kA, vA);
                AT_TILE(j, kB, vB);
                if (j == 0 || __all(carry < -SB_THR)) break;
                --j;
            }
#undef AT_LOAD
#undef AT_TILE
            bf16_t* op = O + (size_t)(b * SEQ + 32 * a + r) * CW + h * HD + 4 * hh;
#pragma unroll
            for (int g = 0; g < 4; ++g) {
                u32x2 w0, w1; w0.x = pk2bf(o0[4 * g], o0[4 * g + 1]); w0.y = pk2bf(o0[4 * g + 2], o0[4 * g + 3]); w1.x = pk2bf(o1[4 * g], o1[4 * g + 1]); w1.y = pk2bf(o1[4 * g + 2], o1[4 * g + 3]);
                *(u32x2*)(op + 8 * g) = w0; *(u32x2*)(op + 32 + 8 * g) = w1;
            }
        }
    }
}

__device__ __forceinline__ unsigned ord_key(float s) { const unsigned u = __builtin_bit_cast(unsigned, s); return u ^ ((unsigned)((int)u >> 31) | 0x80000000u); }
__device__ __forceinline__ float ord_val(unsigned k) { const unsigned u = (k & 0x80000000u) ? (k ^ 0x80000000u) : ~k; return __builtin_bit_cast(float, u); }
#define CE(a, b) do { const unsigned _x = (a), _y = (b); (a) = _x > _y ? _x : _y; (b) = _x > _y ? _y : _x; } while (0)
#define SORT16(v) do { CE(v[0], v[1]); CE(v[2], v[3]); CE(v[0], v[2]); CE(v[1], v[3]); CE(v[1], v[2]); CE(v[4], v[5]); CE(v[6], v[7]); CE(v[4], v[6]); CE(v[5], v[7]); CE(v[5], v[6]); CE(v[0], v[4]); CE(v[2], v[6]); CE(v[2], v[4]); CE(v[1], v[5]); CE(v[3], v[7]); CE(v[3], v[5]); CE(v[1], v[2]); CE(v[3], v[4]); CE(v[5], v[6]); CE(v[8], v[9]); CE(v[10], v[11]); CE(v[8], v[10]); CE(v[9], v[11]); CE(v[9], v[10]); CE(v[12], v[13]); CE(v[14], v[15]); CE(v[12], v[14]); CE(v[13], v[15]); CE(v[13], v[14]); CE(v[8], v[12]); CE(v[10], v[14]); CE(v[10], v[12]); CE(v[9], v[13]); CE(v[11], v[15]); CE(v[11], v[13]); CE(v[9], v[10]); CE(v[11], v[12]); CE(v[13], v[14]); CE(v[0], v[8]); CE(v[4], v[12]); CE(v[4], v[8]); CE(v[2], v[10]); CE(v[6], v[14]); CE(v[6], v[10]); CE(v[2], v[4]); CE(v[6], v[8]); CE(v[10], v[12]); CE(v[1], v[9]); CE(v[5], v[13]); CE(v[5], v[9]); CE(v[3], v[11]); CE(v[7], v[15]); CE(v[7], v[11]); CE(v[3], v[5]); CE(v[7], v[9]); CE(v[11], v[13]); CE(v[1], v[2]); CE(v[3], v[4]); CE(v[5], v[6]); CE(v[7], v[8]); CE(v[9], v[10]); CE(v[11], v[12]); CE(v[13], v[14]); } while (0)
#define BMERGE16(v) do { CE(v[0], v[8]); CE(v[1], v[9]); CE(v[2], v[10]); CE(v[3], v[11]); CE(v[4], v[12]); CE(v[5], v[13]); CE(v[6], v[14]); CE(v[7], v[15]); CE(v[0], v[4]); CE(v[1], v[5]); CE(v[2], v[6]); CE(v[3], v[7]); CE(v[8], v[12]); CE(v[9], v[13]); CE(v[10], v[14]); CE(v[11], v[15]); CE(v[0], v[2]); CE(v[1], v[3]); CE(v[4], v[6]); CE(v[5], v[7]); CE(v[8], v[10]); CE(v[9], v[11]); CE(v[12], v[14]); CE(v[13], v[15]); CE(v[0], v[1]); CE(v[2], v[3]); CE(v[4], v[5]); CE(v[6], v[7]); CE(v[8], v[9]); CE(v[10], v[11]); CE(v[12], v[13]); CE(v[14], v[15]); } while (0)

#define MERGE_TOP16(a, b) do { _Pragma("unroll") for (int _i = 0; _i < 16; ++_i) { const unsigned _p = (a)[_i], _q = (b)[15 - _i]; (a)[_i] = _p > _q ? _p : _q; } BMERGE16(a); } while (0)
__device__ static constexpr int CAND_I[50] = {0, 0, 0, 0, 0, 0, 0, 0, 0, 0, 0, 0, 0, 0, 0, 0, 1, 1, 1, 1, 1, 1, 1, 1, 2, 2, 2, 2, 2, 3, 3, 3, 3, 4, 4, 4, 5, 5, 6, 6, 7, 7, 8, 9, 10, 11, 12, 13, 14, 15};
__device__ static constexpr int CAND_J[50] = {0, 1, 2, 3, 4, 5, 6, 7, 8, 9, 10, 11, 12, 13, 14, 15, 0, 1, 2, 3, 4, 5, 6, 7, 0, 1, 2, 3, 4, 0, 1, 2, 3, 0, 1, 2, 0, 1, 0, 1, 0, 1, 0, 0, 0, 0, 0, 0, 0, 0};

__device__ __forceinline__ void phase5_stage(Ctx& F) {
    const f16_t* SKB = (const f16_t*)(F.ws + WS_SKB);
    const int h = F.reg ? (F.rank & 7) : (int)(blockIdx.x & 7);
    const u32x4* src = (const u32x4*)(SKB + (size_t)(h * 2) * 128 * 128);
    u32x4 t[8];
#pragma unroll
    for (int i = 0; i < 8; ++i) t[i] = src[F.tid + NTHR * i];
#pragma unroll
    for (int i = 0; i < 8; ++i) { const int c = F.tid + NTHR * i, row = c >> 4, ch = c & 15; *(LAS u32x4*)(F.lds + row * 272 + ch * 16) = t[i]; }
    __syncthreads();
}
__device__ __forceinline__ void phase5(Ctx& F) {
    const f16_t* QP = (const f16_t*)(F.ws + WS_B);
    u16* EIDX = (u16*)(F.ws + WS_E); float* GATE = (float*)(F.ws + WS_GATE);
    const int r = F.lane & 31, hh = F.lane >> 5;
    LAS unsigned char* tab = F.lds + 73728 + F.wave * 2048 + F.lane * 32;
    const int h = F.reg ? (F.rank & 7) : (int)(blockIdx.x & 7), nbh = F.G >> 3;
    const int tg0 = F.reg ? F.xcc * 64 + (F.rank >> 3) * 8 + F.wave : (int)(blockIdx.x >> 3) + nbh * F.wave, tgstep = F.reg ? 32 : nbh * NWAVES, tgend = F.reg ? F.xcc * 64 + 64 : 512;
    for (int tg = tg0; tg < tgend; tg += tgstep) {
        const int tok = tg * 32 + r;
        unsigned T0[16], T1[16];
#pragma unroll
        for (int p = 0; p < 2; ++p) {
            const int g = h * 2 + p;
            f32x16 acc[4];
#pragma unroll
            for (int mt = 0; mt < 4; ++mt)
#pragma unroll
                for (int i = 0; i < 16; ++i) acc[mt][i] = 0.f;
            const f16_t* qp = QP + (size_t)tok * 2048 + g * 128 + 8 * hh;
            const LAS unsigned char* kp = F.lds + (p * 128 + r) * 272 + 16 * hh;
#pragma unroll
            for (int kk = 0; kk < 8; ++kk) {
                const f16x8 qf = *(const f16x8*)(qp + 16 * kk);
#pragma unroll
                for (int mt = 0; mt < 4; ++mt) { const f16x8 kf = *(const LAS f16x8*)(kp + mt * 32 * 272 + 32 * kk); acc[mt] = __builtin_amdgcn_mfma_f32_32x32x16_f16(kf, qf, acc[mt], 0, 0, 0); }
            }
            unsigned cur[16], nxt[16];
#pragma unroll
            for (int mt = 0; mt < 4; ++mt) {
#pragma unroll
                for (int i = 0; i < 16; ++i) { const int kc = 127 - (32 * mt + (i & 3) + 8 * (i >> 2)); nxt[i] = (ord_key(acc[mt][i]) & ~127u) | (unsigned)(kc - 4 * hh); }
                SORT16(nxt);
                if (mt == 0) {
#pragma unroll
                    for (int i = 0; i < 16; ++i) cur[i] = nxt[i];
                } else MERGE_TOP16(cur, nxt);
            }
#pragma unroll
            for (int i = 0; i < 16; ++i) nxt[i] = (unsigned)__shfl_xor((int)cur[i], 32);
            MERGE_TOP16(cur, nxt);
#pragma unroll
            for (int i = 0; i < 16; ++i) { if (p == 0) T0[i] = cur[i]; else T1[i] = cur[i]; }
        }
        {
            u32x4 w0, w1, w2, w3;
            w0.x = (T0[0] & 127u) | ((T0[1] & 127u) << 8) | ((T0[2] & 127u) << 16) | ((T0[3] & 127u) << 24); w0.y = (T0[4] & 127u) | ((T0[5] & 127u) << 8) | ((T0[6] & 127u) << 16) | ((T0[7] & 127u) << 24);
            w0.z = (T0[8] & 127u) | ((T0[9] & 127u) << 8) | ((T0[10] & 127u) << 16) | ((T0[11] & 127u) << 24); w0.w = (T0[12] & 127u) | ((T0[13] & 127u) << 8) | ((T0[14] & 127u) << 16) | ((T0[15] & 127u) << 24);
            w1.x = (T1[0] & 127u) | ((T1[1] & 127u) << 8) | ((T1[2] & 127u) << 16) | ((T1[3] & 127u) << 24); w1.y = (T1[4] & 127u) | ((T1[5] & 127u) << 8) | ((T1[6] & 127u) << 16) | ((T1[7] & 127u) << 24);
            w1.z = (T1[8] & 127u) | ((T1[9] & 127u) << 8) | ((T1[10] & 127u) << 16) | ((T1[11] & 127u) << 24); w1.w = (T1[12] & 127u) | ((T1[13] & 127u) << 8) | ((T1[14] & 127u) << 16) | ((T1[15] & 127u) << 24);
            *(LAS u32x4*)tab = w0; *(LAS u32x4*)(tab + 16) = w1; (void)w2; (void)w3;
        }
        float s0[16], s1[16];
#pragma unroll
        for (int i = 0; i < 16; ++i) { s0[i] = ord_val(T0[i] & ~127u); s1[i] = ord_val(T1[i] & ~127u); }
        unsigned c0[16], c1[16];
#pragma unroll
        for (int c = 0; c < 16; ++c) c0[c] = (ord_key(s0[CAND_I[c]] + s1[CAND_J[c]]) & ~255u) | (unsigned)(255 - (CAND_I[c] * 16 + CAND_J[c]));
        SORT16(c0);
#pragma unroll
        for (int c = 0; c < 16; ++c) c1[c] = (ord_key(s0[CAND_I[16 + c]] + s1[CAND_J[16 + c]]) & ~255u) | (unsigned)(255 - (CAND_I[16 + c] * 16 + CAND_J[16 + c]));
        SORT16(c1); MERGE_TOP16(c0, c1);
#pragma unroll
        for (int c = 0; c < 16; ++c) c1[c] = (ord_key(s0[CAND_I[32 + c]] + s1[CAND_J[32 + c]]) & ~255u) | (unsigned)(255 - (CAND_I[32 + c] * 16 + CAND_J[32 + c]));
        SORT16(c1); MERGE_TOP16(c0, c1);
#pragma unroll
        for (int c = 0; c < 16; ++c) c1[c] = 0u;
        c1[0] = (ord_key(s0[CAND_I[48]] + s1[CAND_J[48]]) & ~255u) | (unsigned)(255 - (CAND_I[48] * 16 + CAND_J[48]));
        c1[1] = (ord_key(s0[CAND_I[49]] + s1[CAND_J[49]]) & ~255u) | (unsigned)(255 - (CAND_I[49] * 16 + CAND_J[49]));
        CE(c1[0], c1[1]); MERGE_TOP16(c0, c1);
        float sc[16]; unsigned eid[16];
        asm volatile("s_waitcnt lgkmcnt(0)" ::: "memory");
#pragma unroll
        for (int k = 0; k < 16; ++k) {
            const unsigned ci = 255u - (c0[k] & 255u);
            const unsigned b0 = tab[ci >> 4], b1 = tab[16 + (ci & 15u)];
            eid[k] = (127u - b0) * 128u + (127u - b1);
            sc[k] = ord_val(c0[k] & ~255u);
        }
        float sum = 0.f; const float mx = sc[0], r2 = rstd2_of((const float*)(F.ws + WS_SS2), tok);
#pragma unroll
        for (int k = 0; k < 16; ++k) { sc[k] = __expf((sc[k] - mx) * r2); sum += sc[k]; }
        const float inv = 1.0f / sum;
        if (hh == 0) {
            u32x4 w0, w1;
            w0.x = eid[0] | (eid[1] << 16); w0.y = eid[2] | (eid[3] << 16); w0.z = eid[4] | (eid[5] << 16); w0.w = eid[6] | (eid[7] << 16);
            w1.x = eid[8] | (eid[9] << 16); w1.y = eid[10] | (eid[11] << 16); w1.z = eid[12] | (eid[13] << 16); w1.w = eid[14] | (eid[15] << 16);
            u32x4* ep = (u32x4*)(EIDX + (size_t)tok * NSEL + h * 16); ep[0] = w0; ep[1] = w1;
        } else {
            f32x4* gp = (f32x4*)(GATE + (size_t)tok * NSEL + h * 16);
            gp[0] = (f32x4){sc[0] * inv, sc[1] * inv, sc[2] * inv, sc[3] * inv}; gp[1] = (f32x4){sc[4] * inv, sc[5] * inv, sc[6] * inv, sc[7] * inv};
            gp[2] = (f32x4){sc[8] * inv, sc[9] * inv, sc[10] * inv, sc[11] * inv}; gp[3] = (f32x4){sc[12] * inv, sc[13] * inv, sc[14] * inv, sc[15] * inv};
        }
    }
}

__device__ __forceinline__ float gelu_tanh(float x) { const float u = 0.7978845608028654f * (x + 0.044715f * x * x * x); return 0.5f * x * (1.0f + tanhf(u)); }
__device__ __forceinline__ unsigned e16_of(const u32x4& a, const u32x4& b, int i) {
    const unsigned w = (i < 8) ? ((i >> 1) == 0 ? a.x : (i >> 1) == 1 ? a.y : (i >> 1) == 2 ? a.z : a.w) : (((i - 8) >> 1) == 0 ? b.x : ((i - 8) >> 1) == 1 ? b.y : ((i - 8) >> 1) == 2 ? b.z : b.w);
    return (i & 1) ? (w >> 16) : (w & 0xffffu);
}
#ifndef FP4_SWAP
#define FP4_SWAP 0
#endif
__device__ __forceinline__ f16x2 fp4h2(unsigned w, int b) {
    const f16x2 r = b == 0 ? __builtin_amdgcn_cvt_scalef32_pk_f16_fp4(w, 1.0f, 0) : b == 1 ? __builtin_amdgcn_cvt_scalef32_pk_f16_fp4(w, 1.0f, 1) : b == 2 ? __builtin_amdgcn_cvt_scalef32_pk_f16_fp4(w, 1.0f, 2) : __builtin_amdgcn_cvt_scalef32_pk_f16_fp4(w, 1.0f, 3);
    return FP4_SWAP ? (f16x2){r[1], r[0]} : r;
}
#define UM_IDX(k, E) do { E = *(const u32x4*)(EIDX + (size_t)(tok0 + (k) * nws) * NSEL + 8 * cA); } while (0)
#define UM_ISSUE(k, UV, XB, E) do { const u32x4* _xp = (const u32x4*)(X18 + (size_t)(tok0 + (k) * nws) * D + slice * 256 + xoff); \
        _Pragma("unroll") for (int _g = 0; _g < 8; ++_g) { const unsigned _w = (_g >> 1) == 0 ? E.x : (_g >> 1) == 1 ? E.y : (_g >> 1) == 2 ? E.z : E.w; \
            const unsigned char* _r = ub + (size_t)((_g & 1) ? (_w >> 16) : (_w & 0xffffu)) * 128; UV[2 * _g] = *(const u32x4*)_r; UV[2 * _g + 1] = *(const u32x4*)(_r + 64); } \
        XB[0] = _xp[0]; XB[1] = _xp[8]; } while (0)
#define UM_CONSUME(k, UV, XB) do { float dv[8]; \
        i32x8 bx0, bx1; \
        bx0[0] = inLo ? XB[0].x : 0u; bx0[1] = inLo ? XB[0].y : 0u; bx0[2] = inLo ? XB[0].z : 0u; bx0[3] = inLo ? XB[0].w : 0u; bx0[4] = inHi ? XB[0].x : 0u; bx0[5] = inHi ? XB[0].y : 0u; bx0[6] = inHi ? XB[0].z : 0u; bx0[7] = inHi ? XB[0].w : 0u; \
        bx1[0] = inLo ? XB[1].x : 0u; bx1[1] = inLo ? XB[1].y : 0u; bx1[2] = inLo ? XB[1].z : 0u; bx1[3] = inLo ? XB[1].w : 0u; bx1[4] = inHi ? XB[1].x : 0u; bx1[5] = inHi ? XB[1].y : 0u; bx1[6] = inHi ? XB[1].z : 0u; bx1[7] = inHi ? XB[1].w : 0u; \
        _Pragma("unroll") for (int _g = 0; _g < 8; ++_g) { \
            i32x8 ax; ax[0] = UV[2 * _g].x; ax[1] = UV[2 * _g].y; ax[2] = UV[2 * _g].z; ax[3] = UV[2 * _g].w; ax[4] = 0; ax[5] = 0; ax[6] = 0; ax[7] = 0; \
            f32x4 z = {0.f, 0.f, 0.f, 0.f}; \
            z = __builtin_amdgcn_mfma_scale_f32_16x16x128_f8f6f4(ax, bx0, z, 4, 0, 0, 0, 0, 0); \
            ax[0] = UV[2 * _g + 1].x; ax[1] = UV[2 * _g + 1].y; ax[2] = UV[2 * _g + 1].z; ax[3] = UV[2 * _g + 1].w; \
            z = __builtin_amdgcn_mfma_scale_f32_16x16x128_f8f6f4(ax, bx1, z, 4, 0, 0, 0, 0, 0); \
            float v = bq == 0 ? z.x : bq == 1 ? z.y : bq == 2 ? z.z : z.w; \
            v += __builtin_bit_cast(float, __builtin_amdgcn_update_dpp(0, __builtin_bit_cast(int, v), 0xB1, 0xf, 0xf, true)); \
            v += __builtin_bit_cast(float, __builtin_amdgcn_update_dpp(0, __builtin_bit_cast(int, v), 0x4E, 0xf, 0xf, true)); \
            dv[_g] = v; } \
        if (storer) { u32x4 o0; o0.x = pk2h(dv[0], dv[1]); o0.y = pk2h(dv[2], dv[3]); o0.z = pk2h(dv[4], dv[5]); o0.w = pk2h(dv[6], dv[7]); \
            *(u32x4*)(DOTP + ((size_t)(tok0 + (k) * nws) * 4 + slice) * NSEL + 8 * cD) = o0; } } while (0)
__device__ __forceinline__ void phaseU(Ctx& F) {
    const unsigned char* U4 = F.ws + WS_T; const u16* EIDX = (const u16*)(F.ws + WS_E); f16_t* DOTP = (f16_t*)(F.ws + WS_B); const unsigned char* X18 = F.ws + WS_X18;
    const int xl = blockIdx.x & 7, slice = xl & 3, nws = (F.G >> 3) * NWAVES, tok0 = (xl >> 2) * (M / 2) + (blockIdx.x >> 3) * NWAVES + F.wave;
    const int rho = F.lane & 15, kg = F.lane >> 4, bq = rho & 3, aq = rho >> 2;
    const int cA = 4 * aq + kg;
    const int cD = 4 * kg + aq;
    const bool inLo = aq == (kg >> 1), inHi = aq == 2 + (kg >> 1);
    const int xoff = 32 * bq + 16 * (kg & 1);
    const bool storer = bq == 0;
    const unsigned char* ub = U4 + (size_t)slice * (NEXP * 128) + bq * 16;
    const int N = (M / 2 - ((blockIdx.x >> 3) * NWAVES + F.wave) + nws - 1) / nws;
    if (N <= 0) return;
    u32x4 uvA[16], uvB[16]; u32x4 xA[2], xB[2]; u32x4 eA, eB;
    int k0 = 0;
    if (N & 1) { UM_IDX(0, eA); UM_ISSUE(0, uvA, xA, eA); UM_CONSUME(0, uvA, xA); k0 = 1; if (N == 1) return; }
    const int L = N - 1;
    UM_IDX(k0, eA);
    UM_IDX(k0 + 1, eB);
    UM_ISSUE(k0, uvA, xA, eA);
    for (int n = k0; n < N; n += 2) {
        UM_IDX(min(n + 2, L), eA);
        UM_ISSUE(n + 1, uvB, xB, eB);
        UM_CONSUME(n, uvA, xA);
        UM_IDX(min(n + 3, L), eB);
        UM_ISSUE(min(n + 2, L), uvA, xA, eA);
        UM_CONSUME(n + 1, uvB, xB);
    }
}
__device__ __forceinline__ void phaseW(Ctx& F) {
    const f16_t* DOTP = (const f16_t*)(F.ws + WS_B); const float* GATE = (const float*)(F.ws + WS_GATE); const float* SS2 = (const float*)(F.ws + WS_SS2); unsigned char* W8 = F.ws + WS_WGT;
    const u16* EIDX = (const u16*)(F.ws + WS_E); const float* SU = (const float*)(F.ws + WS_T + 16 * MiB); const float* SV = SU + NEXP;
    for (int tok0 = F.gw; tok0 < M; tok0 += 4 * F.NGW) {
        unsigned dp[4][4], ee[4]; f32x2 gt[4]; f32x4 ss[4][4];
#pragma unroll
        for (int u = 0; u < 4; ++u) {
            const int tok = min(tok0 + u * F.NGW, M - 1);
#pragma unroll
            for (int sl = 0; sl < 4; ++sl) dp[u][sl] = *(const unsigned*)(DOTP + ((size_t)tok * 4 + sl) * NSEL + 2 * F.lane);
            gt[u] = *(const f32x2*)(GATE + (size_t)tok * NSEL + 2 * F.lane);
            ee[u] = *(const unsigned*)(EIDX + (size_t)tok * NSEL + 2 * F.lane);
#pragma unroll
            for (int q = 0; q < 4; ++q) ss[u][q] = ((const f32x4*)(SS2 + (size_t)tok * 16))[q];
        }
        float su0[4], su1[4], sv0[4], sv1[4];
#pragma unroll
        for (int u = 0; u < 4; ++u) { const unsigned e0 = ee[u] & 0xffffu, e1 = ee[u] >> 16; su0[u] = SU[e0]; su1[u] = SU[e1]; sv0[u] = SV[e0]; sv1[u] = SV[e1]; }
#pragma unroll
        for (int u = 0; u < 4; ++u) {
            const int tok = tok0 + u * F.NGW;
            const f32x4 a = ss[u][0], b = ss[u][1], c = ss[u][2], d = ss[u][3];
            const float sq = ((a.x + a.y) + (a.z + a.w)) + ((b.x + b.y) + (b.z + b.w)) + ((c.x + c.y) + (c.z + c.w)) + ((d.x + d.y) + (d.z + d.w));
            const float r2 = (1.0f / 4.0f) / sqrtf(sq * (1.0f / D) + EPS);
            float d0 = 0.f, d1 = 0.f;
#pragma unroll
            for (int sl = 0; sl < 4; ++sl) { const f16x2 h = as_h2(dp[u][sl]); d0 += (float)h[0]; d1 += (float)h[1]; }
            if (tok < M) {
                const unsigned pk = (unsigned)__builtin_amdgcn_cvt_pk_fp8_f32(128.f * gt[u].x * gelu_tanh(d0 * r2 * su0[u]) * sv0[u], 128.f * gt[u].y * gelu_tanh(d1 * r2 * su1[u]) * sv1[u], 0, false);
                unsigned char* wp = W8 + (size_t)tok * NSEL + 16 * (F.lane & 7) + (F.lane >> 3);
                wp[0] = (unsigned char)(pk & 0xffu); wp[8] = (unsigned char)((pk >> 8) & 0xffu);
            }
        }
    }
}
typedef int v2i_t __attribute__((ext_vector_type(2)));
__device__ __forceinline__ void phaseV(Ctx& F) {
    const unsigned char* V4 = F.ws + WS_T + 8 * MiB; const u16* EIDX = (const u16*)(F.ws + WS_E); const unsigned char* W8 = F.ws + WS_WGT; const f16_t* X1H = (const f16_t*)(F.ws + WS_A); f16_t* X2 = (f16_t*)(F.ws + WS_B);
    const int xl = blockIdx.x & 7, slice = xl & 3, nws = (F.G >> 3) * NWAVES, tok0 = (xl >> 2) * (M / 2) + (blockIdx.x >> 3) * NWAVES + F.wave;
    const int p = F.lane >> 3, c = F.lane & 7;
    const int j = F.lane & 15, kg = F.lane >> 4;
    const unsigned char* vb = V4 + (size_t)slice * (NEXP * 128) + ((c ^ p) * 16);
    const int N = (M / 2 - ((blockIdx.x >> 3) * NWAVES + F.wave) + nws - 1) / nws;
    if (N <= 0) return;
    LAS unsigned char* fifo = F.lds + F.wave * 16384;
    const int ra = 32 * kg + j, rb = ra + 16;
    const LAS unsigned char* pa = fifo + ra * 128; const LAS unsigned char* pb = fifo + rb * 128;
    const int sa = ra & 7, sb = rb & 7;
    const int L = N - 1;
#define VT_IDX(k, EA, EB) do { const u32x4* _ep = (const u32x4*)(EIDX + (size_t)(tok0 + (k) * nws) * NSEL + p * 16); EA = _ep[0]; EB = _ep[1]; } while (0)
#define VT_DMA(EA, EB) do { _Pragma("unroll") for (int _i = 0; _i < 16; ++_i) \
        __builtin_amdgcn_global_load_lds((const unsigned*)(vb + (size_t)e16_of(EA, EB, _i) * 128), (LAS unsigned*)(fifo + 1024 * _i), 16, 0, 0); } while (0)
#define VT_META(k, WA, WB, X) do { const size_t _t = (size_t)(tok0 + (k) * nws); const u32x4* _wp = (const u32x4*)(W8 + _t * NSEL + 16 * kg); WA = _wp[0]; WB = _wp[4]; \
        const f16_t* _xp = X1H + _t * D + slice * 256 + 64 * kg + j; X[0] = *(const u16*)(_xp); X[1] = *(const u16*)(_xp + 16); X[2] = *(const u16*)(_xp + 32); X[3] = *(const u16*)(_xp + 48); } while (0)
    u32x4 e1a, e1b, wa, wb, wna, wnb; unsigned xc[4], xn[4];
    { u32x4 e0a, e0b; VT_IDX(0, e0a, e0b); VT_DMA(e0a, e0b); }
    VT_IDX(min(1, L), e1a, e1b);
    VT_META(0, wa, wb, xc);
#pragma unroll 1
    for (int n = 0; n < N; ++n) {
        asm volatile("s_waitcnt vmcnt(0)" ::: "memory");
        v2i_t ta[16], tb[16];
#pragma unroll
        for (int q = 0; q < 16; ++q) {
            ta[q] = __builtin_amdgcn_ds_read_tr4_b64_v2i32((LAS v2i_t*)(pa + (((q >> 1) ^ sa) << 4) + ((q & 1) << 3)));
            tb[q] = __builtin_amdgcn_ds_read_tr4_b64_v2i32((LAS v2i_t*)(pb + (((q >> 1) ^ sb) << 4) + ((q & 1) << 3)));
        }
        asm volatile("s_waitcnt lgkmcnt(0)" ::: "memory");
        VT_DMA(e1a, e1b);
        VT_IDX(min(n + 2, L), e1a, e1b);
        VT_META(min(n + 1, L), wna, wnb, xn);
        i32x8 aw; aw[0] = wa.x; aw[1] = wa.y; aw[2] = wa.z; aw[3] = wa.w; aw[4] = wb.x; aw[5] = wb.y; aw[6] = wb.z; aw[7] = wb.w;
        float yv[4] = {0.f, 0.f, 0.f, 0.f};
#pragma unroll
        for (int q = 0; q < 16; ++q) {
            i32x8 bv; bv[0] = ta[q].x; bv[1] = ta[q].y; bv[2] = tb[q].x; bv[3] = tb[q].y; bv[4] = 0; bv[5] = 0; bv[6] = 0; bv[7] = 0;
            f32x4 z = {0.f, 0.f, 0.f, 0.f};
            z = __builtin_amdgcn_mfma_scale_f32_16x16x128_f8f6f4(aw, bv, z, 0, 4, 0, 0, 0, 0);
            yv[q & 3] = ((q >> 2) == kg) ? z.x : yv[q & 3];
        }
        const size_t t = (size_t)(tok0 + n * nws);
        f16_t* op = X2 + t * D + slice * 256 + 64 * kg + j;
#pragma unroll
        for (int m = 0; m < 4; ++m) { const f16_t xh = __builtin_bit_cast(f16_t, (u16)xc[m]); op[16 * m] = (f16_t)((float)xh + yv[m] * (1.0f / 128.0f)); }
        wa = wna; wb = wnb;
#pragma unroll
        for (int m = 0; m < 4; ++m) xc[m] = xn[m];
    }
    asm volatile("s_waitcnt vmcnt(0)" ::: "memory");
#undef VT_IDX
#undef VT_DMA
#undef VT_META
}
__device__ __forceinline__ void phaseN(Ctx& F) {
    const f16_t* X2 = (const f16_t*)(F.ws + WS_B);
    f32x4 g[4];
#pragma unroll
    for (int c = 0; c < 4; ++c) g[c] = *(const f32x4*)(F.gf + 256 * c + 4 * F.lane);
    for (int tok0 = F.gw; tok0 < M; tok0 += 4 * F.NGW) {
        u32x2 xa[4][4];
#pragma unroll
        for (int u = 0; u < 4; ++u) {
            const int tok = min(tok0 + u * F.NGW, M - 1);
#pragma unroll
            for (int c = 0; c < 4; ++c) xa[u][c] = *(const u32x2*)(X2 + (size_t)tok * D + 256 * c + 4 * F.lane);
        }
#pragma unroll
        for (int u = 0; u < 4; ++u) {
            const int tok = tok0 + u * F.NGW;
            f32x4 a[4]; float sq = 0.f;
#pragma unroll
            for (int c = 0; c < 4; ++c) { const f16x2 p0 = as_h2(xa[u][c].x), p1 = as_h2(xa[u][c].y); a[c] = (f32x4){(float)p0[0], (float)p0[1], (float)p1[0], (float)p1[1]};
                sq += (a[c].x * a[c].x + a[c].y * a[c].y) + (a[c].z * a[c].z + a[c].w * a[c].w); }
            const float r3 = 1.0f / sqrtf(wave_sum(sq) * (1.0f / D) + EPS);
            if (tok < M) {
#pragma unroll
                for (int c = 0; c < 4; ++c) *(f32x4*)(F.out + (size_t)tok * D + 256 * c + 4 * F.lane) = a[c] * r3 * g[c];
            }
        }
    }
}

constexpr int NPHASE = 11;
__global__ void __launch_bounds__(NTHR, 2) fwd_kernel(Args args) {
    extern __shared__ __attribute__((aligned(16))) unsigned char lds[];
    Ctx F;
    F.lds = (LAS unsigned char*)lds;
    F.tid = threadIdx.x; F.lane = F.tid & 63; F.wave = __builtin_amdgcn_readfirstlane(F.tid >> 6);
    F.G = gridDim.x; F.gw = blockIdx.x * NWAVES + F.wave; F.NGW = F.G * NWAVES;
    F.x = args.in[0]; F.meta = args.in[1]; F.g1 = args.in[2]; F.w_in = args.in[3]; F.conv_w = args.in[4]; F.w_a = args.in[5]; F.w_b = args.in[6]; F.w_out = args.in[7];
    F.g2 = args.in[8]; F.w_q = args.in[9]; F.subk = args.in[10]; F.pu = args.in[11]; F.pv = args.in[12]; F.gf = args.in[13];
    F.out = args.out; F.ws = args.ws;
    volatile LAS unsigned* MISC = (volatile LAS unsigned*)(F.lds + MISC_OFF);
    if (F.tid < 32) MISC[F.tid] = 0u;
    __syncthreads();
    const int lo = args.ph_lo, hi = args.ph_hi;
    const bool multi = (hi - lo) > 1;
    XcdBarrier bar; bar.bar = (unsigned*)(F.ws + WS_CTL); bar.x = 0; bar.st = nullptr; bar.wave = F.wave;
    if (multi) bar = xcd_barrier_post((unsigned*)(F.ws + WS_CTL), MISC + 8, F.wave);
#define IN(k) (F.lane = lane_id(), F.tid = F.wave * 64 + F.lane, lo <= (k) && (k) < hi)
#define SEAM(k) do { if (IN(k) && IN((k) + 1)) xcd_barrier(bar); } while (0)

    bf16_t* BA = (bf16_t*)(F.ws + WS_B); bf16_t* CU = BA + (size_t)M * CW; bf16_t* Qb = CU + (size_t)M * CW; bf16_t* Kb = (bf16_t*)(F.ws + WS_KU); bf16_t* Vb = (bf16_t*)(F.ws + WS_VT);
    unsigned char* SGA = (unsigned char*)F.out; unsigned char* SGB = SGA + (size_t)M * D;
    bf16_t* MIX = (bf16_t*)(F.ws + WS_B);
    F.reg = 0; F.xcc = 0; F.rank = 0;
    if (IN(0)) { phase0(F); if (DUP_PHASE == 0) { xcd_barrier(bar); phase0(F); } SEAM(0); }
    if (multi && IN(0) && IN(1)) { F.reg = (int)MISC[10]; F.xcc = (int)bar.x; F.rank = (int)MISC[12]; if (F.rank >= 32 || F.xcc >= 8) F.reg = 0; }
    const int vb = F.reg ? F.rank * 8 + F.xcc : (int)blockIdx.x;
#define LSEAM(k) do { if (IN(k) && IN((k) + 1)) { if (F.reg) xcd_local_barrier(bar); else xcd_barrier(bar); } } while (0)
    if (IN(1)) {
        pg8::Gemm g{(const u16*)(F.ws + WS_A), (const u16*)(F.ws + WS_W1T), M, 3072, D, nullptr, nullptr}; pg8::StaticOrder S; S.init(M, 3072, F.G, vb);
        pg8::EpiAdapt<Epi1> E{Epi1{BA, CU, Qb, Kb, Vb}};
        pg8::Gemm g8{(const u16*)(F.ws + WS_X18), (const u16*)(F.ws + WS_WG8), M, 2048, D / 2, nullptr, nullptr}; pg8::StaticOrder S8; S8.init(M, 2048, F.G, vb);
        pg8::EpiAdapt<Epi1g> E8{Epi1g{SGA, SGB}};
        pg8::gemm_phase<pg8::EpiAdapt<Epi1>, pg8::StaticOrder, 0>(F.lds, g, S, E, F.wave);
        pg8::gemm_phase<pg8::EpiAdapt<Epi1g>, pg8::StaticOrder, 2>(F.lds, g8, S8, E8, F.wave);
        if (DUP_PHASE == 1) { xcd_barrier(bar); pg8::gemm_phase<pg8::EpiAdapt<Epi1>, pg8::StaticOrder, 0>(F.lds, g, S, E, F.wave); }
        if (DUP_PHASE == 102) { xcd_barrier(bar); pg8::gemm_phase<pg8::EpiAdapt<Epi1g>, pg8::StaticOrder, 2>(F.lds, g8, S8, E8, F.wave); }
        LSEAM(1);
    }
    if (IN(2)) { if (F.wave & 1) convert_weights_late(F); phase2(F); if (!(F.wave & 1)) convert_weights_late(F); if (DUP_PHASE == 2) { xcd_barrier(bar); phase2(F); } SEAM(2); }
    if (IN(3)) {
        pg8::PairOrder S; S.S.init(M, D, F.G, vb);
        pg8::Gemm g{(const u16*)(F.ws + WS_A + (size_t)M * CW * 2), (const u16*)(F.ws + WS_WAT), M, D, CW, (const u16*)(F.ws + WS_A), (const u16*)(F.ws + WS_WBT)};
        pg8::EpiAdapt<Epi3a> E{Epi3a{MIX, SGA, SGB}};
        pg8::gemm_phase<pg8::EpiAdapt<Epi3a>, pg8::PairOrder, 0>(F.lds, g, S, E, F.wave);
        if (DUP_PHASE == 3) { xcd_barrier(bar); pg8::gemm_phase<pg8::EpiAdapt<Epi3a>, pg8::PairOrder, 0>(F.lds, g, S, E, F.wave); }
        LSEAM(3);
    }
    if (IN(4)) {
        pg8::Gemm g{(const u16*)MIX, (const u16*)(F.ws + WS_WOT), M, D, D, nullptr, nullptr}; pg8::StaticOrder S; S.init(M, D, F.G, vb);
        pg8::EpiAdapt<Epi3b> E{Epi3b{F.x, (f16_t*)(F.ws + WS_A), (float*)(F.ws + WS_SS2), F.ws + WS_X18}};
        pg8::gemm_phase<pg8::EpiAdapt<Epi3b>, pg8::StaticOrder, 0>(F.lds, g, S, E, F.wave);
        if (DUP_PHASE == 4) { xcd_barrier(bar); pg8::gemm_phase<pg8::EpiAdapt<Epi3b>, pg8::StaticOrder, 0>(F.lds, g, S, E, F.wave); }
        LSEAM(4);
    }
    if (IN(5)) {
        pg8::Gemm g{(const u16*)(F.ws + WS_A), (const u16*)(F.ws + WS_WQT), M, 2048, D, nullptr, nullptr}; pg8::StaticOrder S; S.init(M, 2048, F.G, vb);
        pg8::EpiAdapt<Epi4> E{Epi4{(f16_t*)(F.ws + WS_B)}};
        pg8::gemm_phase<pg8::EpiAdapt<Epi4>, pg8::StaticOrder, 1>(F.lds, g, S, E, F.wave);
        if (DUP_PHASE == 5) { xcd_barrier(bar); pg8::gemm_phase<pg8::EpiAdapt<Epi4>, pg8::StaticOrder, 1>(F.lds, g, S, E, F.wave); }
        LSEAM(5);
    }
    if (IN(6)) { phase5_stage(F); if (F.wave & 1) convert_tables(F); phase5(F); if (!(F.wave & 1)) convert_tables(F); if (DUP_PHASE == 66) { xcd_barrier(bar); convert_tables(F); } if (DUP_PHASE == 6) { xcd_barrier(bar); phase5(F); } SEAM(6); }
    if (IN(7)) { phaseU(F); if (DUP_PHASE == 7) { xcd_barrier(bar); phaseU(F); } SEAM(7); }
    if (IN(8)) { phaseW(F); if (DUP_PHASE == 8) { xcd_barrier(bar); phaseW(F); } SEAM(8); }
    if (IN(9)) { phaseV(F); if (DUP_PHASE == 9) { xcd_barrier(bar); phaseV(F); } SEAM(9); }
    if (DUP_PHASE == 200) { for (int q = 0; q < 10; ++q) xcd_barrier(bar); }
    if (IN(10)) { phaseN(F); if (DUP_PHASE == 10) { xcd_barrier(bar); phaseN(F); } }
#undef IN
#undef SEAM
#undef LSEAM
}

extern "C" void kernel_launch(void* const* d_in, const int* in_sizes, int n_in, void* d_out, int out_size, void* d_ws, size_t ws_size, hipStream_t stream) {
    static int grid = 0;
    if (grid == 0) {
        if (n_in != 14 || out_size != M * D || ws_size < WS_END) { fprintf(stderr, "kernel_launch: unexpected shapes (n_in %d out %d ws %zu)\n", n_in, out_size, ws_size); grid = -1; return; }
        int dev = 0, cus = 0, per_cu = 0;
        if (hipGetDevice(&dev) != hipSuccess || hipDeviceGetAttribute(&cus, hipDeviceAttributeMultiprocessorCount, dev) != hipSuccess) { grid = -1; return; }
        if (hipFuncSetAttribute((const void*)fwd_kernel, hipFuncAttributeMaxDynamicSharedMemorySize, LDS_BYTES) != hipSuccess) { fprintf(stderr, "kernel_launch: hipFuncSetAttribute failed\n"); grid = -1; return; }
        if (hipOccupancyMaxActiveBlocksPerMultiprocessor(&per_cu, (const void*)fwd_kernel, NTHR, LDS_BYTES) != hipSuccess || per_cu < 1) { fprintf(stderr, "kernel_launch: occupancy query says %d\n", per_cu); (void)hipGetLastError(); per_cu = 1; }
        grid = cus;
    }
    if (grid < 0) return;
    (void)hipMemsetAsync((char*)d_ws + WS_CTL, 0, CTL_ZERO_BYTES, stream);
    Args a{};
    for (int i = 0; i < 14; ++i) a.in[i] = (const float*)d_in[i];
    a.out = (float*)d_out; a.ws = (unsigned char*)d_ws;
#if MK_N_LAUNCHES == 1
    a.ph_lo = 0; a.ph_hi = NPHASE;
    hipLaunchKernelGGL(fwd_kernel, dim3(grid), dim3(NTHR), LDS_BYTES, stream, a);
#else
    for (int p = 0; p < NPHASE; ++p) { a.ph_lo = p; a.ph_hi = p + 1; hipLaunchKernelGGL(fwd_kernel, dim3(grid), dim3(NTHR), LDS_BYTES, stream, a); }
#endif
}
```

```cpp
#include <hip/hip_runtime.h>
#include <cstdio>
#include <cstdint>

#ifndef MK_N_LAUNCHES
#define MK_N_LAUNCHES 1
#endif
#ifndef DUP_PHASE
#define DUP_PHASE -1
#endif
#ifndef NAIVE_GEMM
#define NAIVE_GEMM 0
#endif

#define LAS __attribute__((address_space(3)))
#define GAS __attribute__((address_space(1)))
typedef unsigned short bf16_t;
typedef unsigned short u16;
typedef _Float16 f16_t;
typedef short bf16x8 __attribute__((ext_vector_type(8)));
typedef _Float16 f16x8 __attribute__((ext_vector_type(8)));
typedef _Float16 f16x2 __attribute__((ext_vector_type(2)));
typedef float f32x4 __attribute__((ext_vector_type(4)));
typedef float f32x2 __attribute__((ext_vector_type(2)));
typedef unsigned u32x4 __attribute__((ext_vector_type(4)));
typedef unsigned u32x2 __attribute__((ext_vector_type(2)));
typedef float f32x16 __attribute__((ext_vector_type(16)));
typedef int i32x8 __attribute__((ext_vector_type(8)));
typedef int i32x4 __attribute__((ext_vector_type(4)));

constexpr int D = 1024, NB = 8, SEQ = 2048, M = NB * SEQ, NMETA = 16, CW = 512, NH = 8, HD = 64, INW = 5120;
constexpr int PH = 8, NKEY = 128, TOPK = 16, NSEL = 128, NEXP = 16384;
constexpr float EPS = 1e-6f;
constexpr float SB_THR = 44.0f;
constexpr int NWAVES = 8, NTHR = 512;

constexpr size_t MiB = 1u << 20;
constexpr size_t WS_CTL = 0, CTL_ZERO_BYTES = 64 * 1024;
constexpr size_t WS_W1T = 1 * MiB;
constexpr size_t WS_WG8 = 7 * MiB;
constexpr float GATE_WSCALE = 64.0f, XN8_SCALE = 8.0f;
constexpr size_t WS_WAT = 11 * MiB;
constexpr size_t WS_WBT = 12 * MiB;
constexpr size_t WS_WOT = 13 * MiB;
constexpr size_t WS_WQT = 15 * MiB;
constexpr size_t WS_SKB = 19 * MiB;
constexpr size_t WS_META = 19 * MiB + 512 * 1024;
constexpr size_t WS_SS2 = 20 * MiB;
constexpr size_t WS_A = 24 * MiB;
constexpr size_t WS_B = 56 * MiB;
constexpr size_t WS_KU = 104 * MiB;
constexpr size_t WS_VT = 121 * MiB;
constexpr int LP = 2080;
constexpr size_t WS_T = 140 * MiB;
constexpr size_t WS_X18 = 160 * MiB;
constexpr size_t WS_E = 200 * MiB;
constexpr size_t WS_GATE = WS_E + 4 * MiB, WS_WGT = WS_E + 12 * MiB;
constexpr size_t WS_SS3 = 21 * MiB;
constexpr size_t WS_END = 220 * MiB;

constexpr int LDS_BYTES = 147456;
constexpr int RING_BYTES = 131072;
constexpr int MISC_OFF = RING_BYTES + 320;

__device__ __forceinline__ unsigned f2bf(float f) { unsigned u = __builtin_bit_cast(unsigned, f); return (u + 0x7fffu + ((u >> 16) & 1u)) >> 16; }
__device__ __forceinline__ float bf2f(unsigned h) { return __builtin_bit_cast(float, (h & 0xffffu) << 16); }
typedef __bf16 bf16x2_t __attribute__((ext_vector_type(2)));
__device__ __forceinline__ unsigned pk2bf(float lo, float hi) { const f32x2 v = {lo, hi}; return __builtin_bit_cast(unsigned, __builtin_convertvector(v, bf16x2_t)); }
__device__ __forceinline__ unsigned pk2h(float lo, float hi) { f16x2 v = {(f16_t)lo, (f16_t)hi}; return __builtin_bit_cast(unsigned, v); }
__device__ __forceinline__ f16x2 as_h2(unsigned w) { return __builtin_bit_cast(f16x2, w); }
__device__ __forceinline__ float bflo(unsigned w) { return __builtin_bit_cast(float, w << 16); }
__device__ __forceinline__ float bfhi(unsigned w) { return __builtin_bit_cast(float, w & 0xffff0000u); }
__device__ __forceinline__ float wave_sum(float v) {
#pragma unroll
    for (int o = 1; o < 64; o <<= 1) v += __shfl_xor(v, o);
    return v;
}
__device__ __forceinline__ unsigned wave_max_u(unsigned v) {
#pragma unroll
    for (int o = 1; o < 64; o <<= 1) { unsigned t = (unsigned)__shfl_xor((int)v, o); v = t > v ? t : v; }
    return v;
}
__device__ __forceinline__ int lane_id() { int l; asm volatile("v_mbcnt_lo_u32_b32 %0, -1, 0\n\tv_mbcnt_hi_u32_b32 %0, -1, %0" : "=v"(l)); return l; }
__device__ __forceinline__ float sigmoidf_(float x) { return 1.0f / (1.0f + __expf(-x)); }

namespace pg8 {
constexpr int BM = 256, BK = 64, HALF = 128, HTB = HALF * BK * 2, STAGE_BYTES = 8 * HTB, NXCD = 8, WGM = 8;
__host__ __device__ __forceinline__ int lds_byte(int r, int c) { const int st = (r >> 4) * 2 + (c >> 5), rr = r & 15, cc = c & 31, ob = rr * 64 + cc * 2; return st * 1024 + (ob ^ (((ob >> 9) & 1) << 5)); }
__host__ __device__ __forceinline__ void stage_rc(int b, int& R, int& C) { const int st = b / 1024, sb = b % 1024, swz = sb ^ (((sb >> 9) & 1) << 5); R = (st >> 1) * 16 + swz / 64; C = (st & 1) * 32 + (swz % 64) / 2; }
__host__ __device__ __forceinline__ int perm32(int rho) { const int n = rho >> 4, i = rho & 15; return 8 * (i >> 2) + 4 * n + (i & 3); }
struct Unit { int pm, pn, which; };
struct Gemm { const u16* A; const u16* Bt; int M, N, K; const u16* A2; const u16* Bt2; };
struct StaticOrder {
    int nM, nN, nwg, G, c;
    __host__ __device__ void init(int M_, int N_, int G_, int c_) { nM = M_ / BM; nN = N_ / BM; nwg = nM * nN; G = G_; c = c_; }
    __host__ __device__ bool next(int i, Unit& u) const {
        const long L = (long)i * G + c; if (L >= nwg) return false;
        int wgid = (int)L; { const int q = nwg / NXCD, r = nwg % NXCD, xcd = wgid % NXCD, off = wgid / NXCD; wgid = (xcd < r ? xcd * (q + 1) : r * (q + 1) + (xcd - r) * q) + off; }
        const int nig = WGM * nN, gid = wgid / nig, fm = gid * WGM, gsz = (nM - fm) < WGM ? (nM - fm) : WGM;
        u.pm = fm + ((wgid % nig) % gsz); u.pn = (wgid % nig) / gsz; u.which = 0; return true;
    }
    __device__ __forceinline__ void a_ready(const Unit&) const {}
    __device__ __forceinline__ void done(const Unit&) const {}
};
struct PairOrder {
    StaticOrder S;
    __host__ __device__ bool next(int i, Unit& u) const { if (!S.next(i >> 1, u)) return false; u.which = i & 1; return true; }
    __device__ __forceinline__ void a_ready(const Unit&) const {}
    __device__ __forceinline__ void done(const Unit&) const {}
};

template <class F> struct EpiAdapt {
    static constexpr bool PERM = true, AFTER_DRAIN = false;
    F f;
    __device__ __forceinline__ void operator()(const f32x4 (&acc)[2][2][4][2], const Unit& u, int wr, int wc, int fr, int fq) const {
        int fr2 = fr; asm volatile("" : "+v"(fr2), "+v"(fq));
        const int col = u.pn * BM + wc * 32 + 8 * fq;
#pragma unroll
        for (int ai = 0; ai < 2; ++ai)
#pragma unroll
            for (int m = 0; m < 4; ++m) {
                const int row = u.pm * BM + ai * HALF + wr * 64 + m * 16 + fr2;
                f(row, col, u.pn + 64 * u.which, wc, acc[ai][0][m][0], acc[ai][0][m][1], acc[ai][1][m][0], acc[ai][1][m][1]);
            }
    }
};

#if NAIVE_GEMM
template <bool F16> __device__ __forceinline__ float dot8(u32x4 a, u32x4 b) {
    float s = 0.f;
#pragma unroll
    for (int i = 0; i < 4; ++i) {
        if (F16) { f16x2 x = as_h2(a[i]), y = as_h2(b[i]); s += (float)x[0] * (float)y[0] + (float)x[1] * (float)y[1]; }
        else s += bflo(a[i]) * bflo(b[i]) + bfhi(a[i]) * bfhi(b[i]);
    }
    return s;
}
template <class Epi, class Sched, int FMT>
__device__ __forceinline__ void gemm_phase(LAS unsigned char* lds, const Gemm g, const Sched& S, const Epi& E, const int wid) {
    constexpr bool F16 = FMT == 1;
    const int lane = lane_id(), tid = wid * 64 + lane, wr = wid >> 2, wc = wid & 3, fr = lane & 15, fq = lane >> 4;
    Unit u;
    for (int ui = 0; S.next(ui, u); ++ui) {
        f32x4 acc[2][2][4][2];
        for (int ai = 0; ai < 2; ++ai) for (int m = 0; m < 4; ++m) {
            const int row = u.pm * BM + ai * HALF + wr * 64 + m * 16 + fr;
            float a16[16];
            for (int j = 0; j < 16; ++j) a16[j] = 0.f;
            const u32x4* ap = (const u32x4*)(g.A + (size_t)row * g.K);
            for (int k8 = 0; k8 < g.K / 8; ++k8) {
                const u32x4 av = ap[k8];
#pragma unroll
                for (int j = 0; j < 16; ++j) {
                    const int col = u.pn * BM + (j >> 3) * HALF + wc * 32 + 8 * fq + (j & 7);
                    const u32x4 bv = ((const u32x4*)(g.Bt + (size_t)col * g.K))[k8];
                    a16[j] += dot8<F16>(av, bv);
                }
            }
            acc[ai][0][m][0] = (f32x4){a16[0], a16[1], a16[2], a16[3]}; acc[ai][0][m][1] = (f32x4){a16[4], a16[5], a16[6], a16[7]};
            acc[ai][1][m][0] = (f32x4){a16[8], a16[9], a16[10], a16[11]}; acc[ai][1][m][1] = (f32x4){a16[12], a16[13], a16[14], a16[15]};
        }
        E(acc, u, wr, wc, fr, fq);
    }
    __syncthreads();
}
#else
template <class Epi, class Sched, int FMT>
__device__ __forceinline__ void gemm_phase(LAS unsigned char* lds, const Gemm g, const Sched& S, const Epi& E, const int wid) {
    constexpr bool ALIGN_EPI = true; constexpr bool F16 = FMT == 1;
    const int lane = lane_id(), tid = wid * 64 + lane, wr = wid >> 2, wc = wid & 3, fr = lane & 15, fq = lane >> 4;
    const int K = g.K; int nt = K / BK;
    if constexpr (FMT == 2) asm volatile("" : "+s"(nt));
    unsigned voffA[2], voffB[2];
#pragma unroll
    for (int i = 0; i < 2; ++i) { int R, C; stage_rc(tid * 16 + i * 8192, R, C); const int Rb = Epi::PERM ? ((R & ~31) + perm32(R & 31)) : R;
        voffA[i] = (unsigned)(R * K + C) * 2u; voffB[i] = (unsigned)(Rb * K + C) * 2u; }
    const unsigned kstep = (unsigned)(BK * 2);
    const unsigned hstep = (unsigned)HALF * (unsigned)K * 2u;
    const unsigned tstep = 2u * hstep;
    const unsigned ldsw = (unsigned)wid * 1024u;
    const int aoff = lds_byte(wr * 64 + fr, fq * 8), boff = lds_byte(wc * 32 + fr, fq * 8);
#define PG8_SA(b, h) (((b) * 2 + (h)) * HTB)
#define PG8_SB(b, h) ((4 + (b) * 2 + (h)) * HTB)
#define PG8_STAGE(bufoff, gbase, goff, voff) do { unsigned _go = (goff); asm volatile("" : "+s"(_go));   \
        _Pragma("unroll") for (int _i = 0; _i < 2; ++_i) \
        __builtin_amdgcn_global_load_lds((const unsigned*)((gbase) + (_go + (voff)[_i])), (LAS unsigned*)(lds + (bufoff) + ldsw + _i * 8192), 16, 0, 0); } while (0)
#define PG8_LDA(dst, b, h) do { _Pragma("unroll") for (int m = 0; m < 4; ++m) _Pragma("unroll") for (int k = 0; k < 2; ++k) dst[m][k] = *(const LAS bf16x8*)(lds + PG8_SA(b, h) + aoff + m * 2048 + k * 1024); } while (0)
#define PG8_LDB(dst, b, h) do { _Pragma("unroll") for (int n = 0; n < 2; ++n) _Pragma("unroll") for (int k = 0; k < 2; ++k) dst[n][k] = *(const LAS bf16x8*)(lds + PG8_SB(b, h) + boff + n * 2048 + k * 1024); } while (0)
#define PG8_MMA(ai, bj, At, Bt) do { __builtin_amdgcn_s_setprio(1); _Pragma("unroll") for (int m = 0; m < 4; ++m) _Pragma("unroll") for (int n = 0; n < 2; ++n) { \
        if constexpr (FMT == 2) { const i32x8 _a = __builtin_shufflevector(__builtin_bit_cast(i32x4, Bt[n][0]), __builtin_bit_cast(i32x4, Bt[n][1]), 0, 1, 2, 3, 4, 5, 6, 7), \
                                      _b = __builtin_shufflevector(__builtin_bit_cast(i32x4, At[m][0]), __builtin_bit_cast(i32x4, At[m][1]), 0, 1, 2, 3, 4, 5, 6, 7); \
            acc[ai][bj][m][n] = __builtin_amdgcn_mfma_scale_f32_16x16x128_f8f6f4(_a, _b, acc[ai][bj][m][n], 0, 0, 0, 0, 0, 0); } \
        else { _Pragma("unroll") for (int k = 0; k < 2; ++k) { \
        if (F16) acc[ai][bj][m][n] = __builtin_amdgcn_mfma_f32_16x16x32_f16(__builtin_bit_cast(f16x8, Bt[n][k]), __builtin_bit_cast(f16x8, At[m][k]), acc[ai][bj][m][n], 0, 0, 0); \
        else acc[ai][bj][m][n] = __builtin_amdgcn_mfma_f32_16x16x32_bf16(Bt[n][k], At[m][k], acc[ai][bj][m][n], 0, 0, 0); } } } __builtin_amdgcn_s_setprio(0); } while (0)
#define PG8_WAIT_V(n) asm volatile("s_waitcnt vmcnt(" #n ")" ::: "memory")
#define PG8_WAIT_L(n) asm volatile("s_waitcnt lgkmcnt(" #n ")" ::: "memory")
#define PG8_BAR __builtin_amdgcn_s_barrier()
#define PG8_SCHED __builtin_amdgcn_sched_barrier(0)
    Unit cur, nxt; int ui = 0;
    if (!S.next(0, cur)) return;
    f32x4 acc[2][2][4][2];
#pragma unroll
    for (int a = 0; a < 2; ++a)
#pragma unroll
        for (int b = 0; b < 2; ++b)
#pragma unroll
            for (int m = 0; m < 4; ++m)
#pragma unroll
                for (int n = 0; n < 2; ++n) acc[a][b][m][n] = (f32x4){0.f, 0.f, 0.f, 0.f};
    bf16x8 At[4][2], B0[2][2], B1[2][2];
    const char* pA = (const char*)(cur.which ? g.A2 : g.A); const char* pB = (const char*)(cur.which ? g.Bt2 : g.Bt);
    unsigned cA = (unsigned)cur.pm * tstep, cB = (unsigned)cur.pn * tstep;
    S.a_ready(cur);
    {
        PG8_STAGE(PG8_SB(0, 0), pB, cB, voffB); PG8_STAGE(PG8_SB(0, 1), pB, cB + hstep, voffB); PG8_STAGE(PG8_SA(0, 0), pA, cA, voffA); PG8_STAGE(PG8_SA(0, 1), pA, cA + hstep, voffA);
        if (wr == 1) PG8_BAR;
        PG8_WAIT_V(2); PG8_BAR;
        PG8_STAGE(PG8_SB(1, 0), pB, cB + kstep, voffB); PG8_STAGE(PG8_SA(1, 0), pA, cA + kstep, voffA); PG8_STAGE(PG8_SB(1, 1), pB, cB + hstep + kstep, voffB);
        PG8_WAIT_V(6); PG8_BAR;
    }
    for (;;) {
        const bool has_next = S.next(ui + 1, nxt);
        const char* qA = has_next ? (const char*)(nxt.which ? g.A2 : g.A) : pA; const char* qB = has_next ? (const char*)(nxt.which ? g.Bt2 : g.Bt) : pB;
        const unsigned nA = has_next ? (unsigned)nxt.pm * tstep : cA, nB = has_next ? (unsigned)nxt.pn * tstep : cB;
        for (int t = 0; t < nt; t += 2) {
            const bool last = (t == nt - 2);
            const unsigned a1 = cA + (unsigned)(t + 1) * kstep;
            const char* rA = last ? qA : pA; const char* rB = last ? qB : pB;
            const unsigned a2 = last ? nA : cA + (unsigned)(t + 2) * kstep, b2 = last ? nB : cB + (unsigned)(t + 2) * kstep;
            const unsigned a3 = a2 + kstep, b3 = b2 + kstep;
            if (last && has_next) S.a_ready(nxt);
            PG8_LDB(B0, 0, 0); PG8_LDB(B1, 0, 1); PG8_SCHED; PG8_LDA(At, 0, 0); PG8_STAGE(PG8_SA(1, 1), pA, a1 + hstep, voffA);
            PG8_WAIT_V(8); PG8_WAIT_L(0); PG8_BAR; PG8_MMA(0, 0, At, B0); PG8_MMA(0, 1, At, B1); PG8_BAR; PG8_SCHED;
            PG8_LDA(At, 0, 1); PG8_STAGE(PG8_SB(0, 0), rB, b2, voffB); PG8_STAGE(PG8_SB(0, 1), rB, b2 + hstep, voffB); PG8_STAGE(PG8_SA(0, 0), rA, a2, voffA);
            PG8_WAIT_V(8); PG8_WAIT_L(0); PG8_BAR; PG8_MMA(1, 0, At, B0); PG8_MMA(1, 1, At, B1); PG8_BAR; PG8_SCHED;
            PG8_LDB(B0, 1, 0); PG8_LDB(B1, 1, 1); PG8_SCHED; PG8_LDA(At, 1, 0); PG8_STAGE(PG8_SA(0, 1), rA, a2 + hstep, voffA);
            PG8_WAIT_V(8); PG8_WAIT_L(0); PG8_BAR; PG8_MMA(0, 0, At, B0); PG8_MMA(0, 1, At, B1); PG8_BAR; PG8_SCHED;
            PG8_LDA(At, 1, 1); PG8_STAGE(PG8_SB(1, 0), rB, b3, voffB); PG8_STAGE(PG8_SB(1, 1), rB, b3 + hstep, voffB); PG8_STAGE(PG8_SA(1, 0), rA, a3, voffA);
            PG8_WAIT_V(8); PG8_WAIT_L(0); PG8_BAR; PG8_MMA(1, 0, At, B0); PG8_MMA(1, 1, At, B1); PG8_BAR; PG8_SCHED;
        }
        if constexpr (ALIGN_EPI) { if (wr == 0) PG8_BAR; }
        E(acc, cur, wr, wc, fr, fq); S.done(cur);
        if (!has_next) break;
#pragma unroll
        for (int a = 0; a < 2; ++a)
#pragma unroll
            for (int b = 0; b < 2; ++b)
#pragma unroll
                for (int m = 0; m < 4; ++m)
#pragma unroll
                    for (int n = 0; n < 2; ++n) acc[a][b][m][n] = (f32x4){0.f, 0.f, 0.f, 0.f};
        cur = nxt; cA = nA; cB = nB; pA = qA; pB = qB; ++ui;
        if constexpr (ALIGN_EPI) { if (wr == 1) PG8_BAR; }
    }
    PG8_WAIT_V(0);
    if constexpr (!ALIGN_EPI) { if (wr == 0) PG8_BAR; }
    PG8_BAR;
#undef PG8_SA
#undef PG8_SB
#undef PG8_STAGE
#undef PG8_LDA
#undef PG8_LDB
#undef PG8_MMA
#undef PG8_WAIT_V
#undef PG8_WAIT_L
#undef PG8_BAR
#undef PG8_SCHED
}
#endif
}

#define XB_TMO      128
#define XB_XCNT(j)  (256  + 64 * (j))
#define XB_XSUB(j)  (1280 + 64 * (j))
#define XB_XGEN(j)  (2304 + 64 * (j))
#define XB_TOP      3328
#define XB_TOPGEN   3392
#define XCD_BAR_WORDS 3456
#define XB_SPIN_CAP (1u << 20)
__device__ __forceinline__ unsigned xb_ld(unsigned* p)              { return __hip_atomic_load(p, __ATOMIC_RELAXED, __HIP_MEMORY_SCOPE_AGENT); }
__device__ __forceinline__ unsigned xb_add(unsigned* p, unsigned v) { return __hip_atomic_fetch_add(p, v, __ATOMIC_RELAXED, __HIP_MEMORY_SCOPE_AGENT); }
__device__ __forceinline__ unsigned xb_xcc_id() { return (unsigned)__builtin_amdgcn_s_getreg((3 << 11) | 20) & 0xFu; }
#define XB_SPIN(cond, bar) do { unsigned _sp = 0; while (cond) { __builtin_amdgcn_s_sleep(1); \
    if ((++_sp & 255u) == 0u) { if (xb_ld(&(bar)[XB_TMO])) break; if (_sp > XB_SPIN_CAP) { atomicAdd(&(bar)[XB_TMO], 1u); break; } } } } while (0)
struct XcdBarrier { unsigned* bar; unsigned x; volatile LAS unsigned* st; int wave; };
__device__ __forceinline__ XcdBarrier xcd_barrier_post(unsigned* bar, volatile LAS unsigned* st, int wave) {
    XcdBarrier b; b.bar = bar; b.x = xb_xcc_id(); b.st = st; b.wave = wave;
    if (wave == 0 && lane_id() == 0) st[4] = xb_add(&bar[XB_XCNT(b.x)], 1u);
    return b;
}
__device__ __forceinline__ void xcd_barrier_complete(unsigned* bar, unsigned x, unsigned& nloc, unsigned& nx, unsigned& regular) {
    const unsigned G = gridDim.x * gridDim.y * gridDim.z;
    unsigned sum, cnt, mine, low8, sp = 0u;
    for (;;) {
        sum = 0u; cnt = 0u; mine = 0u; low8 = 0u;
#pragma unroll
        for (unsigned j = 0; j < 16; ++j) { const unsigned c = xb_ld(&bar[XB_XCNT(j)]); sum += c; cnt += (c > 0u) ? 1u : 0u; mine = (j == x) ? c : mine; low8 += (j < 8u && c == 32u) ? 1u : 0u; }
        if (sum == G) break;
        __builtin_amdgcn_s_sleep(1);
        if ((++sp & 255u) == 0u) { if (xb_ld(&bar[XB_TMO])) break; if (sp > XB_SPIN_CAP) { atomicAdd(&bar[XB_TMO], 1u); break; } }
    }
    nloc = mine > 0u ? mine : 1u; nx = cnt > 0u ? cnt : 1u;
    regular = (G == 256u && sum == G && cnt == 8u && low8 == 8u) ? 1u : 0u;
}
__device__ __forceinline__ void xcd_barrier(const XcdBarrier& b) {
    asm volatile("s_waitcnt vmcnt(0)" ::: "memory");
    __syncthreads();
    if (b.wave == 0 && lane_id() == 0) {
        unsigned* bar = b.bar;
        __builtin_amdgcn_s_waitcnt(0);
        unsigned nloc = b.st[0], nx = b.st[1];
        if (nloc == 0u) { unsigned reg; xcd_barrier_complete(bar, b.x, nloc, nx, reg); b.st[0] = nloc; b.st[1] = nx; b.st[2] = reg; }
        const unsigned old = xb_add(&bar[XB_XSUB(b.x)], 1u);
        const unsigned gen = old / nloc;
        if (old + 1u == (gen + 1u) * nloc) {
            __builtin_amdgcn_fence(__ATOMIC_RELEASE, "agent");
            asm volatile("s_waitcnt vmcnt(0)" ::: "memory");
            const unsigned og = xb_add(&bar[XB_TOP], 1u);
            const unsigned tg = og / nx;
            if (og + 1u == (tg + 1u) * nx) xb_add(&bar[XB_TOPGEN], 1u);
            else XB_SPIN(xb_ld(&bar[XB_TOPGEN]) == tg, bar);
            __builtin_amdgcn_fence(__ATOMIC_ACQUIRE, "agent");
            xb_add(&bar[XB_XGEN(b.x)], 1u);
            asm volatile("s_waitcnt vmcnt(0)" ::: "memory");
        } else {
            XB_SPIN(xb_ld(&bar[XB_XGEN(b.x)]) == gen, bar);
            __builtin_amdgcn_fence(__ATOMIC_ACQUIRE, "agent");
            asm volatile("s_waitcnt vmcnt(0)" ::: "memory");
        }
    }
    __syncthreads();
}

#define XB_LSUB(j)  (3520 + 64 * (j))
__device__ __forceinline__ void xcd_local_barrier(const XcdBarrier& b) {
    asm volatile("s_waitcnt vmcnt(0)" ::: "memory");
    __syncthreads();
    if (b.wave == 0 && lane_id() == 0) {
        unsigned* bar = b.bar;
        __builtin_amdgcn_s_waitcnt(0);
        const unsigned nloc = b.st[0];
        const unsigned old = xb_add(&bar[XB_LSUB(b.x)], 1u);
        const unsigned tgt = (old / nloc + 1u) * nloc;
        XB_SPIN(xb_ld(&bar[XB_LSUB(b.x)]) < tgt, bar);
        __builtin_amdgcn_fence(__ATOMIC_ACQUIRE, "agent");
        asm volatile("s_waitcnt vmcnt(0)" ::: "memory");
    }
    __syncthreads();
}

struct Args { const float* in[14]; float* out; unsigned char* ws; int ph_lo, ph_hi; };
struct Ctx {
    LAS unsigned char* lds;
    int tid, lane, wave, G, gw, NGW;
    int reg, xcc, rank;
    const float *x, *meta, *g1, *w_in, *conv_w, *w_a, *w_b, *w_out, *g2, *w_q, *subk, *pu, *pv, *gf;
    float* out; unsigned char* ws;
};

__device__ __forceinline__ float one_or(const float* s, int i) { return s ? s[i] : 1.0f; }
template <bool F16>
__device__ __forceinline__ void p0_transpose_item(const float* W, int K, int N, const float* scale, u16* WT, int scol0, int drow0, int k0, LAS float* scr, int lane) {
#pragma unroll
    for (int i = 0; i < 32; ++i) { const int kk = 2 * i + (lane >> 5); scr[kk * 33 + (lane & 31)] = W[(size_t)(k0 + kk) * N + scol0 + (lane & 31)] * one_or(scale, k0 + kk); }
    asm volatile("s_waitcnt lgkmcnt(0)" ::: "memory");
    const int c = lane & 7;
#pragma unroll
    for (int j = 0; j < 4; ++j) { const int n = (lane >> 3) + 8 * j; const LAS float* s = scr + (8 * c) * 33 + n;
        u32x4 o;
        if (F16) { o.x = pk2h(s[0 * 33], s[1 * 33]); o.y = pk2h(s[2 * 33], s[3 * 33]); o.z = pk2h(s[4 * 33], s[5 * 33]); o.w = pk2h(s[6 * 33], s[7 * 33]); }
        else { o.x = pk2bf(s[0 * 33], s[1 * 33]); o.y = pk2bf(s[2 * 33], s[3 * 33]); o.z = pk2bf(s[4 * 33], s[5 * 33]); o.w = pk2bf(s[6 * 33], s[7 * 33]); }
        *(u32x4*)(WT + (size_t)(drow0 + n) * K + k0 + 8 * c) = o; }
    asm volatile("s_waitcnt lgkmcnt(0)" ::: "memory");
}
__device__ __forceinline__ void p0_transpose_item8(const float* W, int K, int N, const float* scale, float mul, unsigned char* WT8, int scol0, int drow0, int k0, LAS float* scr, int lane) {
#pragma unroll
    for (int i = 0; i < 32; ++i) { const int kk = 2 * i + (lane >> 5); scr[kk * 33 + (lane & 31)] = W[(size_t)(k0 + kk) * N + scol0 + (lane & 31)] * (mul * one_or(scale, k0 + kk)); }
    asm volatile("s_waitcnt lgkmcnt(0)" ::: "memory");
    const int n = lane & 31, hf = lane >> 5; const LAS float* s = scr + (32 * hf) * 33 + n;
    unsigned w[8];
#pragma unroll
    for (int j = 0; j < 8; ++j) w[j] = (unsigned)__builtin_amdgcn_cvt_pk_fp8_f32(s[(4 * j + 2) * 33], s[(4 * j + 3) * 33], __builtin_amdgcn_cvt_pk_fp8_f32(s[(4 * j) * 33], s[(4 * j + 1) * 33], 0, false), true);
    u32x4* op = (u32x4*)(WT8 + (size_t)(drow0 + n) * K + k0 + 32 * hf);
    op[0] = (u32x4){w[0], w[1], w[2], w[3]}; op[1] = (u32x4){w[4], w[5], w[6], w[7]};
    asm volatile("s_waitcnt lgkmcnt(0)" ::: "memory");
}
template <int KR> __device__ __forceinline__ void tr_load(const float* W, int N, int scol0, int k0, int lane, float (&t)[KR / 2]) {
#pragma unroll
    for (int i = 0; i < KR / 2; ++i) t[i] = W[(size_t)(k0 + 2 * i + (lane >> 5)) * N + scol0 + (lane & 31)];
}
template <int KR, int FMT> __device__ __forceinline__ void tr_finish(const float (&t)[KR / 2], const float* scale, float mul, void* WT, int ldk, int drow0, int k0, LAS float* scr, int lane) {
#pragma unroll
    for (int i = 0; i < KR / 2; ++i) scr[(2 * i + (lane >> 5)) * 33 + (lane & 31)] = t[i];
    asm volatile("s_waitcnt lgkmcnt(0)" ::: "memory");
    if constexpr (FMT != 2) {
        constexpr int NJ = KR / 16;
        const int c = lane & (KR / 8 - 1), nl = lane / (KR / 8);
        f32x4 ga = {1.f, 1.f, 1.f, 1.f}, gb = ga; if (scale) { ga = *(const f32x4*)(scale + k0 + 8 * c); gb = *(const f32x4*)(scale + k0 + 8 * c + 4); }
#pragma unroll
        for (int j = 0; j < NJ; ++j) { const int n = nl + (512 / KR) * j; const LAS float* s = scr + (8 * c) * 33 + n;
            u32x4 o;
            if constexpr (FMT == 1) { o.x = pk2h(s[0 * 33] * ga.x, s[1 * 33] * ga.y); o.y = pk2h(s[2 * 33] * ga.z, s[3 * 33] * ga.w); o.z = pk2h(s[4 * 33] * gb.x, s[5 * 33] * gb.y); o.w = pk2h(s[6 * 33] * gb.z, s[7 * 33] * gb.w); }
            else { o.x = pk2bf(s[0 * 33] * ga.x, s[1 * 33] * ga.y); o.y = pk2bf(s[2 * 33] * ga.z, s[3 * 33] * ga.w); o.z = pk2bf(s[4 * 33] * gb.x, s[5 * 33] * gb.y); o.w = pk2bf(s[6 * 33] * gb.z, s[7 * 33] * gb.w); }
            *(u32x4*)((u16*)WT + (size_t)(drow0 + n) * ldk + k0 + 8 * c) = o; }
    } else {
        constexpr int KL = KR / 2;
        const int n = lane & 31, hf = lane >> 5; const LAS float* s = scr + (KL * hf) * 33 + n;
        unsigned w[KL / 4];
#pragma unroll
        for (int j = 0; j < KL / 4; ++j) { const f32x4 gq = *(const f32x4*)(scale + k0 + KL * hf + 4 * j) * mul;
            w[j] = (unsigned)__builtin_amdgcn_cvt_pk_fp8_f32(s[(4 * j + 2) * 33] * gq.z, s[(4 * j + 3) * 33] * gq.w, __builtin_amdgcn_cvt_pk_fp8_f32(s[(4 * j) * 33] * gq.x, s[(4 * j + 1) * 33] * gq.y, 0, false), true); }
        unsigned char* op = (unsigned char*)WT + (size_t)(drow0 + n) * ldk + k0 + KL * hf;
        if constexpr (KL == 32) { ((u32x4*)op)[0] = (u32x4){w[0], w[1], w[2], w[3]}; ((u32x4*)op)[1] = (u32x4){w[4], w[5], w[6], w[7]}; }
        else { *(u32x2*)op = (u32x2){w[0], w[1]}; }
    }
    asm volatile("s_waitcnt lgkmcnt(0)" ::: "memory");
}
__device__ __forceinline__ int w1_srccol(int n) {
    if (n < 512 || n >= 1536) return n;
    const int t = (n - 512) >> 8, r = (n - 512) & 255;
    return r < 128 ? 512 + 128 * t + r : 1024 + 128 * t + (r - 128);
}

__device__ __forceinline__ void phase0(Ctx& F) {
    f32x4 xv[4][4]; int xr[4];
#pragma unroll
    for (int u = 0; u < 4; ++u) { xr[u] = min(F.gw + u * F.NGW, M - 1); const f32x4* xp = (const f32x4*)(F.x + (size_t)xr[u] * D) + F.lane;
#pragma unroll
        for (int j = 0; j < 4; ++j) xv[u][j] = __builtin_nontemporal_load(xp + 64 * j); }
    const bool trfast = F.NGW == 2048;
    float tA[32], tB[8];
    const int itA = F.gw, kbA = itA / 160, nbA = itA % 160, itB = 2048 + (F.gw >> 2), kbB = itB / 160, nbB = itB % 160, k0B = kbB * 64 + 16 * (F.gw & 3);
    if (trfast) { tr_load<64>(F.w_in, INW, nbA < 96 ? w1_srccol(nbA * 32) : nbA * 32, kbA * 64, F.lane, tA); tr_load<16>(F.w_in, INW, nbB < 96 ? w1_srccol(nbB * 32) : nbB * 32, k0B, F.lane, tB); }
    {
        LAS float* mn = (LAS float*)F.lds;
        LAS float* red = (LAS float*)(F.lds + 65536);
        {
            const int r = F.wave * 2; float va[16], vb[16], gg[16]; float sa = 0.f, sb = 0.f;
#pragma unroll
            for (int j = 0; j < 16; ++j) { va[j] = F.meta[r * D + j * 64 + F.lane]; vb[j] = F.meta[(r + 1) * D + j * 64 + F.lane]; gg[j] = F.g1[j * 64 + F.lane]; }
#pragma unroll
            for (int j = 0; j < 16; ++j) { sa += va[j] * va[j]; sb += vb[j] * vb[j]; }
            const float ra = 1.0f / sqrtf(wave_sum(sa) * (1.0f / D) + EPS), rb = 1.0f / sqrtf(wave_sum(sb) * (1.0f / D) + EPS);
#pragma unroll
            for (int j = 0; j < 16; ++j) { const int k = j * 64 + F.lane; *(LAS f32x2*)(mn + k * 16 + r) = (f32x2){va[j] * ra * gg[j], vb[j] * rb * gg[j]}; }
        }
        __syncthreads();
        bf16_t* MK = (bf16_t*)(F.ws + WS_META); bf16_t* MV = MK + 16 * 512; float* MCA = (float*)(MV + 16 * 512); float* MUA = MCA + 16 * 512;
        for (int cgx = blockIdx.x; cgx < 256; cgx += F.G) {
            const int cg = (cgx & 7) * 32 + (cgx >> 3);
            const int j = F.tid & 7, kq = F.tid >> 3;
            const int gc = cg * 8 + j, which = gc >> 9, cc = gc & 511;
            const int scol = which == 0 ? 2048 + cc : which == 1 ? 2560 + cc : which == 2 ? 512 + cc : 1024 + cc;
            float wv[16];
#pragma unroll
            for (int kk = 0; kk < 16; ++kk) wv[kk] = F.w_in[(size_t)(kq * 16 + kk) * INW + scol];
            float acc[16];
#pragma unroll
            for (int r = 0; r < 16; ++r) acc[r] = 0.f;
#pragma unroll
            for (int kk = 0; kk < 16; ++kk) {
#pragma unroll
                for (int r4 = 0; r4 < 4; ++r4) { const f32x4 mv = *(const LAS f32x4*)(mn + (kq * 16 + kk) * 16 + r4 * 4);
                    acc[r4 * 4 + 0] += mv.x * wv[kk]; acc[r4 * 4 + 1] += mv.y * wv[kk]; acc[r4 * 4 + 2] += mv.z * wv[kk]; acc[r4 * 4 + 3] += mv.w * wv[kk]; }
            }
#pragma unroll
            for (int r = 0; r < 16; ++r) red[(kq * 16 + r) * 8 + j] = acc[r];
            __syncthreads();
            if (F.tid < 128) {
                const int r = F.tid >> 3, jj = F.tid & 7; float sm = 0.f;
                for (int q = 0; q < 64; ++q) sm += red[(q * 16 + r) * 8 + jj];
                const int gc2 = cg * 8 + jj, wh = gc2 >> 9, c2 = gc2 & 511;
                if (wh == 0) { MK[r * 512 + c2] = (bf16_t)f2bf(sm); bf16_t* KU = (bf16_t*)(F.ws + WS_KU);
                    for (int b = 0; b < NB; ++b) KU[((size_t)(b * NH + (c2 >> 6)) * LP + 16 + r) * HD + (c2 & 63)] = (bf16_t)f2bf(sm); }
                else if (wh == 1) { MV[r * 512 + c2] = (bf16_t)f2bf(sm); bf16_t* VT = (bf16_t*)(F.ws + WS_VT);
                    for (int b = 0; b < NB; ++b) VT[((size_t)(b * NH + (c2 >> 6)) * HD + (c2 & 63)) * LP + 16 + r] = (bf16_t)f2bf(sm); }
                else if (wh == 2) MCA[r * 512 + c2] = sm; else MUA[r * 512 + c2] = sm;
            }
            __syncthreads();
        }
    }
    {
        bf16_t* KU = (bf16_t*)(F.ws + WS_KU); bf16_t* VT = (bf16_t*)(F.ws + WS_VT);
        for (int i = blockIdx.x * NTHR + F.tid; i < 64 * 16 * 64; i += F.G * NTHR) {
            const int bh = i >> 10, rr = (i >> 6) & 15, dd = i & 63;
            KU[((size_t)bh * LP + rr) * HD + dd] = 0; VT[((size_t)bh * HD + dd) * LP + rr] = 0;
        }
    }
    {
        LAS float* scr = (LAS float*)(F.lds + F.wave * 16384);
        constexpr int I1 = 16 * 160;
        if (trfast) {
            if (nbA < 96) tr_finish<64, 0>(tA, F.g1, 1.0f, F.ws + WS_W1T, D, nbA * 32, kbA * 64, scr, F.lane); else tr_finish<64, 2>(tA, F.g1, GATE_WSCALE, F.ws + WS_WG8, D, (nbA - 96) * 32, kbA * 64, scr, F.lane);
            if (nbB < 96) tr_finish<16, 0>(tB, F.g1, 1.0f, F.ws + WS_W1T, D, nbB * 32, k0B, scr, F.lane); else tr_finish<16, 2>(tB, F.g1, GATE_WSCALE, F.ws + WS_WG8, D, (nbB - 96) * 32, k0B, scr, F.lane);
        } else
        for (int it = F.gw; it < I1; it += F.NGW) { const int kb = it / 160, nb = it % 160;
            if (nb < 96) p0_transpose_item<false>(F.w_in, D, INW, F.g1, (u16*)(F.ws + WS_W1T), w1_srccol(nb * 32), nb * 32, kb * 64, scr, F.lane);
            else p0_transpose_item8(F.w_in, D, INW, F.g1, GATE_WSCALE, F.ws + WS_WG8, nb * 32, (nb - 96) * 32, kb * 64, scr, F.lane); }
    }
    {
        bf16_t* XN = (bf16_t*)(F.ws + WS_A); unsigned char* XN8 = F.ws + WS_X18;
        for (int m0 = F.gw; m0 < M; m0 += 4 * F.NGW) {
            f32x4 v[4][4]; int mr[4];
#pragma unroll
            for (int u = 0; u < 4; ++u) {
#pragma unroll
                for (int j = 0; j < 4; ++j) v[u][j] = xv[u][j];
                mr[u] = xr[u]; }
            const int m1 = m0 + 4 * F.NGW;
            if (m1 < M) {
#pragma unroll
                for (int u = 0; u < 4; ++u) { xr[u] = min(m1 + u * F.NGW, M - 1); const f32x4* xp = (const f32x4*)(F.x + (size_t)xr[u] * D) + F.lane;
#pragma unroll
                    for (int j = 0; j < 4; ++j) xv[u][j] = __builtin_nontemporal_load(xp + 64 * j); }
            }
#pragma unroll
            for (int u = 0; u < 4; ++u) {
                float s = 0.f;
#pragma unroll
                for (int j = 0; j < 4; ++j) s += (v[u][j].x * v[u][j].x + v[u][j].y * v[u][j].y) + (v[u][j].z * v[u][j].z + v[u][j].w * v[u][j].w);
                const float rstd = 1.0f / sqrtf(wave_sum(s) * (1.0f / D) + EPS);
                u32x2* o8 = (u32x2*)(XN + (size_t)mr[u] * D) + F.lane; unsigned* o4 = (unsigned*)(XN8 + (size_t)mr[u] * D) + F.lane; const float r8 = rstd * XN8_SCALE;
#pragma unroll
                for (int j = 0; j < 4; ++j) { u32x2 o; o.x = pk2bf(v[u][j].x * rstd, v[u][j].y * rstd); o.y = pk2bf(v[u][j].z * rstd, v[u][j].w * rstd); o8[64 * j] = o;
                    o4[64 * j] = (unsigned)__builtin_amdgcn_cvt_pk_fp8_f32(v[u][j].z * r8, v[u][j].w * r8, __builtin_amdgcn_cvt_pk_fp8_f32(v[u][j].x * r8, v[u][j].y * r8, 0, false), true); }
            }
        }
    }
}
struct LateItem { const float* W; const float* scale; u16* WT; int K, N, kb, nb, f16; };
__device__ __forceinline__ LateItem late_item(Ctx& F, int it) {
    constexpr int IA = 8 * 32, IB = 8 * 32, IO = 16 * 32;
    LateItem L; int r = it;
    if (r < IA) { L = LateItem{F.w_a, nullptr, (u16*)(F.ws + WS_WAT), CW, D, r / 32, r % 32, 0}; return L; } r -= IA;
    if (r < IB) { L = LateItem{F.w_b, nullptr, (u16*)(F.ws + WS_WBT), CW, D, r / 32, r % 32, 0}; return L; } r -= IB;
    if (r < IO) { L = LateItem{F.w_out, nullptr, (u16*)(F.ws + WS_WOT), D, D, r / 32, r % 32, 0}; return L; } r -= IO;
    L = LateItem{F.w_q, F.g2, (u16*)(F.ws + WS_WQT), D, 2048, r / 64, r % 64, 1}; return L;
}
__device__ __forceinline__ void late_load(Ctx& F, float (&t)[32], f32x4& sk) {
    const LateItem L = late_item(F, F.gw);
    tr_load<64>(L.W, L.N, L.nb * 32, L.kb * 64, F.lane, t);
    const int gt = blockIdx.x * NTHR + F.tid; sk = ((const f32x4*)F.subk)[min(gt, 16 * 128 * 128 / 4 - 1)];
}
__device__ __forceinline__ void late_finish(Ctx& F, const float (&t)[32], const f32x4& sk) {
    LAS float* scr = (LAS float*)(F.lds + 32768 + F.wave * 12288);
    const LateItem L = late_item(F, F.gw);
    if (L.f16) tr_finish<64, 1>(t, L.scale, 1.0f, L.WT, L.K, L.nb * 32, L.kb * 64, scr, F.lane); else tr_finish<64, 0>(t, L.scale, 1.0f, L.WT, L.K, L.nb * 32, L.kb * 64, scr, F.lane);
    const int gt = blockIdx.x * NTHR + F.tid;
    if (gt < 16 * 128 * 128 / 4) { u32x2 o; o.x = pk2h(sk.x, sk.y); o.y = pk2h(sk.z, sk.w); ((u32x2*)(F.ws + WS_SKB))[gt] = o; }
}
__device__ __forceinline__ void convert_weights_late(Ctx& F) {
    LAS float* scr = (LAS float*)(F.lds + 32768 + F.wave * 12288);
    constexpr int IA = 8 * 32, IB = 8 * 32, IO = 16 * 32, IQ = 16 * 64, NIT = IA + IB + IO + IQ;
    for (int it = F.gw; it < NIT; it += F.NGW) {
        int r = it;
        if (r < IA) { const int kb = r / 32, nb = r % 32; p0_transpose_item<false>(F.w_a, CW, D, nullptr, (u16*)(F.ws + WS_WAT), nb * 32, nb * 32, kb * 64, scr, F.lane); continue; } r -= IA;
        if (r < IB) { const int kb = r / 32, nb = r % 32; p0_transpose_item<false>(F.w_b, CW, D, nullptr, (u16*)(F.ws + WS_WBT), nb * 32, nb * 32, kb * 64, scr, F.lane); continue; } r -= IB;
        if (r < IO) { const int kb = r / 32, nb = r % 32; p0_transpose_item<false>(F.w_out, D, D, nullptr, (u16*)(F.ws + WS_WOT), nb * 32, nb * 32, kb * 64, scr, F.lane); continue; } r -= IO;
        { const int kb = r / 64, nb = r % 64; p0_transpose_item<true>(F.w_q, D, 2048, F.g2, (u16*)(F.ws + WS_WQT), nb * 32, nb * 32, kb * 64, scr, F.lane); }
    }
    const int gt = blockIdx.x * NTHR + F.tid, NT = F.G * NTHR;
    f16_t* SKB = (f16_t*)(F.ws + WS_SKB);
    for (int i = gt; i < 16 * 128 * 128 / 4; i += NT) { const f32x4 v = ((const f32x4*)F.subk)[i]; u32x2 o; o.x = pk2h(v.x, v.y); o.y = pk2h(v.z, v.w); ((u32x2*)SKB)[i] = o; }
}
__device__ __forceinline__ unsigned fp4_code(float x, float inv) {
    const float a = fabsf(x) * inv;
    const unsigned idx = (unsigned)(a >= 0.25f) + (unsigned)(a >= 0.75f) + (unsigned)(a >= 1.25f) + (unsigned)(a >= 1.75f) + (unsigned)(a >= 2.5f) + (unsigned)(a >= 3.5f) + (unsigned)(a >= 5.0f);
    return idx | (x < 0.f ? 8u : 0u);
}
__device__ __forceinline__ float clamp6(float x) { return __builtin_fminf(__builtin_fmaxf(x, -6.0f), 6.0f); }
__device__ __forceinline__ unsigned fp4_pack8(f32x4 a, f32x4 b, float inv) {
    unsigned w = 0;
    w = __builtin_amdgcn_cvt_scalef32_pk_fp4_f32(w, clamp6(a.x * inv), clamp6(a.y * inv), 1.0f, 0);
    w = __builtin_amdgcn_cvt_scalef32_pk_fp4_f32(w, clamp6(a.z * inv), clamp6(a.w * inv), 1.0f, 1);
    w = __builtin_amdgcn_cvt_scalef32_pk_fp4_f32(w, clamp6(b.x * inv), clamp6(b.y * inv), 1.0f, 2);
    w = __builtin_amdgcn_cvt_scalef32_pk_fp4_f32(w, clamp6(b.z * inv), clamp6(b.w * inv), 1.0f, 3);
    return w;
}
__device__ __forceinline__ float wave_max(float v) {
#pragma unroll
    for (int o = 1; o < 64; o <<= 1) v = fmaxf(v, __shfl_xor(v, o));
    return v;
}
__device__ __forceinline__ void convert_tables(Ctx& F) {
    unsigned char* U4 = F.ws + WS_T; unsigned char* V4 = F.ws + WS_T + 8 * MiB; float* SU = (float*)(F.ws + WS_T + 16 * MiB); float* SV = SU + NEXP;
    f32x4 g[4];
#pragma unroll
    for (int j = 0; j < 4; ++j) g[j] = *(const f32x4*)(F.g2 + 256 * j + 4 * F.lane);
    for (int t0 = F.gw; t0 < 2 * NEXP; t0 += 4 * F.NGW) {
        f32x4 v[4][4];
#pragma unroll
        for (int u = 0; u < 4; ++u) { const int t = min(t0 + u * F.NGW, 2 * NEXP - 1); const float* src = (t < NEXP ? F.pu : F.pv) + (size_t)(t & (NEXP - 1)) * D + 4 * F.lane;
#pragma unroll
            for (int j = 0; j < 4; ++j) v[u][j] = __builtin_nontemporal_load((const f32x4*)(src + 256 * j)); }
#pragma unroll
        for (int u = 0; u < 4; ++u) {
            const int t = t0 + u * F.NGW; const bool isu = t < NEXP; const int row = t & (NEXP - 1);
            float m = 0.f;
#pragma unroll
            for (int j = 0; j < 4; ++j) { if (isu) v[u][j] = v[u][j] * g[j]; m = fmaxf(m, fmaxf(fmaxf(fabsf(v[u][j].x), fabsf(v[u][j].y)), fmaxf(fabsf(v[u][j].z), fabsf(v[u][j].w)))); }
            m = fmaxf(wave_max(m), 1.0e-30f);
            const float sc = m * 0.125f, inv = 8.0f / m;
            if (t < 2 * NEXP) {
                unsigned char* dst = (isu ? U4 : V4) + (size_t)row * 128 + 2 * F.lane;
#pragma unroll
                for (int j = 0; j < 4; ++j) { unsigned w = 0;
                    w = __builtin_amdgcn_cvt_scalef32_pk_fp4_f32(w, clamp6(v[u][j].x * inv), clamp6(v[u][j].y * inv), 1.0f, 0);
                    w = __builtin_amdgcn_cvt_scalef32_pk_fp4_f32(w, clamp6(v[u][j].z * inv), clamp6(v[u][j].w * inv), 1.0f, 1);
                    *(u16*)(dst + (size_t)j * (NEXP * 128)) = (u16)w; }
                if (F.lane == 0) (isu ? SU : SV)[row] = sc;
            }
        }
    }
}

__device__ __forceinline__ u32x4 pack8bf(f32x4 a, f32x4 b) { u32x4 w; w.x = pk2bf(a.x, a.y); w.y = pk2bf(a.z, a.w); w.z = pk2bf(b.x, b.y); w.w = pk2bf(b.z, b.w); return w; }
__device__ __forceinline__ u32x4 pack8h(f32x4 a, f32x4 b) { u32x4 w; w.x = pk2h(a.x, a.y); w.y = pk2h(a.z, a.w); w.z = pk2h(b.x, b.y); w.w = pk2h(b.z, b.w); return w; }
__device__ __forceinline__ void unpack8bf(u32x4 w, f32x4& a, f32x4& b) { a = (f32x4){bflo(w.x), bfhi(w.x), bflo(w.y), bfhi(w.y)}; b = (f32x4){bflo(w.z), bfhi(w.z), bflo(w.w), bfhi(w.w)}; }
__device__ __forceinline__ unsigned sig4u8(f32x4 v) {
    const unsigned a = (unsigned)(sigmoidf_(v.x) * 255.f + 0.5f), b = (unsigned)(sigmoidf_(v.y) * 255.f + 0.5f), c = (unsigned)(sigmoidf_(v.z) * 255.f + 0.5f), d = (unsigned)(sigmoidf_(v.w) * 255.f + 0.5f);
    return a | (b << 8) | (c << 16) | (d << 24); }
__device__ __forceinline__ f32x4 u8x4f(unsigned w) { return (f32x4){(float)(w & 0xffu), (float)((w >> 8) & 0xffu), (float)((w >> 16) & 0xffu), (float)(w >> 24)} * (1.0f / 255.0f); }
__device__ __forceinline__ f32x4 sig4(f32x4 v) { return (f32x4){sigmoidf_(v.x), sigmoidf_(v.y), sigmoidf_(v.z), sigmoidf_(v.w)}; }

struct Epi1 {
    bf16_t *BA, *CU, *Q, *K, *V;
    __device__ __forceinline__ void operator()(int row, int col, int pn, int wc, f32x4 l0, f32x4 l1, f32x4 h0, f32x4 h1) const {
        if (pn < 2) { bf16_t* p = BA + (size_t)row * CW + col; *(u32x4*)p = pack8bf(l0, l1); *(u32x4*)(p + 128) = pack8bf(h0, h1); }
        else if (pn < 6) { bf16_t* p = CU + (size_t)row * CW + (pn - 2) * 128 + (col & 255); *(u32x4*)p = pack8bf(l0 * h0, l1 * h1); }
        else if (pn < 8) { bf16_t* p = Q + (size_t)row * CW + (col - 1536); *(u32x4*)p = pack8bf(l0 * 0.125f, l1 * 0.125f); *(u32x4*)(p + 128) = pack8bf(h0 * 0.125f, h1 * 0.125f); }
        else if (pn < 10) { const int c = col - 2048, b = row >> 11, t = row & (SEQ - 1);
            *(u32x4*)(K + ((size_t)(b * NH + (c >> 6)) * LP + 32 + t) * HD + (c & 63)) = pack8bf(l0, l1);
            *(u32x4*)(K + ((size_t)(b * NH + ((c + 128) >> 6)) * LP + 32 + t) * HD + (c & 63)) = pack8bf(h0, h1); }
        else { const int c = col - 2560, b = row >> 11, t = row & (SEQ - 1);
            bf16_t* p0 = V + ((size_t)(b * NH + (c >> 6)) * HD + (c & 63)) * LP + 32 + t; bf16_t* p1 = V + ((size_t)(b * NH + ((c + 128) >> 6)) * HD + (c & 63)) * LP + 32 + t;
            p0[0] = (bf16_t)f2bf(l0.x); p0[LP] = (bf16_t)f2bf(l0.y); p0[2 * LP] = (bf16_t)f2bf(l0.z); p0[3 * LP] = (bf16_t)f2bf(l0.w);
            p0[4 * LP] = (bf16_t)f2bf(l1.x); p0[5 * LP] = (bf16_t)f2bf(l1.y); p0[6 * LP] = (bf16_t)f2bf(l1.z); p0[7 * LP] = (bf16_t)f2bf(l1.w);
            p1[0] = (bf16_t)f2bf(h0.x); p1[LP] = (bf16_t)f2bf(h0.y); p1[2 * LP] = (bf16_t)f2bf(h0.z); p1[3 * LP] = (bf16_t)f2bf(h0.w);
            p1[4 * LP] = (bf16_t)f2bf(h1.x); p1[5 * LP] = (bf16_t)f2bf(h1.y); p1[6 * LP] = (bf16_t)f2bf(h1.z); p1[7 * LP] = (bf16_t)f2bf(h1.w); }
    }
};
struct Epi1g {
    unsigned char *SGA, *SGB;
    __device__ __forceinline__ void operator()(int row, int col, int pn, int wc, f32x4 l0, f32x4 l1, f32x4 h0, f32x4 h1) const {
        constexpr float r = 1.0f / (GATE_WSCALE * XN8_SCALE);
        unsigned char* p = (pn < 4 ? SGA : SGB) + (size_t)row * D + (col & 1023); u32x2 a, b; a.x = sig4u8(l0 * r); a.y = sig4u8(l1 * r); b.x = sig4u8(h0 * r); b.y = sig4u8(h1 * r); *(u32x2*)p = a; *(u32x2*)(p + 128) = b;
    }
};
struct EpiNull { float* sink; __device__ __forceinline__ void operator()(int row, int col, int pn, int wc, f32x4 l0, f32x4 l1, f32x4 h0, f32x4 h1) const { const f32x4 t = l0 + l1 + h0 + h1; if (t.x == 1234.5f) sink[0] = t.y; } };
struct Epi3a {
    bf16_t* MIX; const unsigned char* SGA; const unsigned char* SGB;
    __device__ __forceinline__ void operator()(int row, int col, int pn, int wc, f32x4 l0, f32x4 l1, f32x4 h0, f32x4 h1) const {
        const bool add = pn >= 64;
        bf16_t* p = MIX + (size_t)row * D + col; const unsigned char* s = (add ? SGB : SGA) + (size_t)row * D + col;
        const u32x2 ga = *(const u32x2*)s, gb = *(const u32x2*)(s + 128);
        l0 = l0 * u8x4f(ga.x); l1 = l1 * u8x4f(ga.y); h0 = h0 * u8x4f(gb.x); h1 = h1 * u8x4f(gb.y);
        if (add) { f32x4 a, b, c, d; unpack8bf(*(const u32x4*)p, a, b); unpack8bf(*(const u32x4*)(p + 128), c, d); l0 += a; l1 += b; h0 += c; h1 += d; }
        *(u32x4*)p = pack8bf(l0, l1); *(u32x4*)(p + 128) = pack8bf(h0, h1);
    }
};
struct Epi3b {
    const float* x; f16_t* X1H; float* SS2; unsigned char* X18;
    __device__ __forceinline__ void operator()(int row, int col, int pn, int wc, f32x4 l0, f32x4 l1, f32x4 h0, f32x4 h1) const {
        const float* xp = x + (size_t)row * D + col; f16_t* hp = X1H + (size_t)row * D + col;
        l0 += *(const f32x4*)xp; l1 += *(const f32x4*)(xp + 4); h0 += *(const f32x4*)(xp + 128); h1 += *(const f32x4*)(xp + 132);
        *(u32x4*)hp = pack8h(l0, l1); *(u32x4*)(hp + 128) = pack8h(h0, h1);
        { unsigned char* bp = X18 + (size_t)row * D + col; u32x2 a, b; const f32x4 m0 = l0 * 4.f, m1 = l1 * 4.f, m2 = h0 * 4.f, m3 = h1 * 4.f;
          a.x = (unsigned)__builtin_amdgcn_cvt_pk_fp8_f32(m0.z, m0.w, __builtin_amdgcn_cvt_pk_fp8_f32(m0.x, m0.y, 0, false), true); a.y = (unsigned)__builtin_amdgcn_cvt_pk_fp8_f32(m1.z, m1.w, __builtin_amdgcn_cvt_pk_fp8_f32(m1.x, m1.y, 0, false), true);
          b.x = (unsigned)__builtin_amdgcn_cvt_pk_fp8_f32(m2.z, m2.w, __builtin_amdgcn_cvt_pk_fp8_f32(m2.x, m2.y, 0, false), true); b.y = (unsigned)__builtin_amdgcn_cvt_pk_fp8_f32(m3.z, m3.w, __builtin_amdgcn_cvt_pk_fp8_f32(m3.x, m3.y, 0, false), true);
          *(u32x2*)bp = a; *(u32x2*)(bp + 128) = b; }
        float s = (l0.x * l0.x + l0.y * l0.y) + (l0.z * l0.z + l0.w * l0.w) + (l1.x * l1.x + l1.y * l1.y) + (l1.z * l1.z + l1.w * l1.w)
                + (h0.x * h0.x + h0.y * h0.y) + (h0.z * h0.z + h0.w * h0.w) + (h1.x * h1.x + h1.y * h1.y) + (h1.z * h1.z + h1.w * h1.w);
        s += __shfl_xor(s, 16); s += __shfl_xor(s, 32);
        if (lane_id() < 16) SS2[(size_t)row * 16 + pn * 4 + wc] = s;
    }
};
__device__ __forceinline__ float rstd2_of(const float* SS2, int row) {
    const f32x4* p = (const f32x4*)(SS2 + (size_t)row * 16); const f32x4 a = p[0], b = p[1], c = p[2], d = p[3];
    const float s = ((a.x + a.y) + (a.z + a.w)) + ((b.x + b.y) + (b.z + b.w)) + ((c.x + c.y) + (c.z + c.w)) + ((d.x + d.y) + (d.z + d.w));
    return 1.0f / sqrtf(s * (1.0f / D) + EPS);
}
struct Epi4 {
    f16_t* QP;
    __device__ __forceinline__ void operator()(int row, int col, int pn, int wc, f32x4 l0, f32x4 l1, f32x4 h0, f32x4 h1) const {
        f16_t* p = QP + (size_t)row * 2048 + col;
        *(u32x4*)p = pack8h(l0, l1); *(u32x4*)(p + 128) = pack8h(h0, h1);
    }
};

__device__ __forceinline__ void phase2(Ctx& F) {
    const bf16_t* BA = (const bf16_t*)(F.ws + WS_B); const bf16_t* CU = BA + (size_t)M * CW; const bf16_t* Q = CU + (size_t)M * CW;
    bf16_t* O = (bf16_t*)(F.ws + WS_A); bf16_t* YA = O + (size_t)M * CW;
    const bf16_t* MK = (const bf16_t*)(F.ws + WS_META); const bf16_t* MV = MK + 16 * 512; const float* MCA = (const float*)(MV + 16 * 512); const float* MUA = MCA + 16 * 512;
    {
        const int gt = (F.reg ? F.xcc * 32 + F.rank : (int)blockIdx.x) * NTHR + F.tid, NT = F.G * NTHR;
        for (int it = gt; it < (M / 8) * 64; it += NT) {
            const int strip = it >> 6, c = (it & 63) * 8, r0 = strip * 8, t0 = r0 & (SEQ - 1);
            u32x4 cu[8], ba[8];
#pragma unroll
            for (int q = 0; q < 8; ++q) { cu[q] = *(const u32x4*)(CU + (size_t)(r0 + q) * CW + c); ba[q] = *(const u32x4*)(BA + (size_t)(r0 + q) * CW + c); }
            const f32x4 wa0 = *(const f32x4*)(F.conv_w + c), wa1 = *(const f32x4*)(F.conv_w + c + 4), wb0 = *(const f32x4*)(F.conv_w + CW + c), wb1 = *(const f32x4*)(F.conv_w + CW + c + 4),
                        wc0 = *(const f32x4*)(F.conv_w + 2 * CW + c), wc1 = *(const f32x4*)(F.conv_w + 2 * CW + c + 4);
            f32x4 p2a, p2b, p1a, p1b;
            if (t0 != 0) { unpack8bf(*(const u32x4*)(CU + (size_t)(r0 - 2) * CW + c), p2a, p2b); unpack8bf(*(const u32x4*)(CU + (size_t)(r0 - 1) * CW + c), p1a, p1b); }
            else { p2a = *(const f32x4*)(MCA + 14 * 512 + c) * *(const f32x4*)(MUA + 14 * 512 + c); p2b = *(const f32x4*)(MCA + 14 * 512 + c + 4) * *(const f32x4*)(MUA + 14 * 512 + c + 4);
                   p1a = *(const f32x4*)(MCA + 15 * 512 + c) * *(const f32x4*)(MUA + 15 * 512 + c); p1b = *(const f32x4*)(MCA + 15 * 512 + c + 4) * *(const f32x4*)(MUA + 15 * 512 + c + 4); }
#pragma unroll
            for (int q = 0; q < 8; ++q) {
                f32x4 ca, cb, ga, gb; unpack8bf(cu[q], ca, cb); unpack8bf(ba[q], ga, gb);
                const f32x4 ya = ga * (wa0 * p2a + wb0 * p1a + wc0 * ca), yb = gb * (wa1 * p2b + wb1 * p1b + wc1 * cb);
                *(u32x4*)(YA + (size_t)(r0 + q) * CW + c) = pack8bf(ya, yb);
                p2a = p1a; p2b = p1b; p1a = ca; p1b = cb;
            }
        }
    }
    {
        const bf16_t* KU = (const bf16_t*)(F.ws + WS_KU); const bf16_t* VT = (const bf16_t*)(F.ws + WS_VT);
        const int r = F.lane & 31, hh = F.lane >> 5;
        const int item0 = F.reg ? F.xcc * 512 + F.rank * 8 + F.wave : F.gw, istep = F.reg ? 256 : F.NGW, iend = F.reg ? F.xcc * 512 + 512 : 64 * 64;
        for (int item = item0; item < iend; item += istep) {
            const int bh = item >> 6, a = item & 63, b = bh >> 3, h = bh & 7;
            const bf16_t* qp = Q + (size_t)(b * SEQ + 32 * a + r) * CW + h * HD + 8 * hh;
            bf16x8 qf[4];
#pragma unroll
            for (int kk = 0; kk < 4; ++kk) qf[kk] = *(const bf16x8*)(qp + 16 * kk);
            const bf16_t* kb = KU + (size_t)bh * LP * HD + (size_t)r * HD + 8 * hh;
            const bf16_t* vb0 = VT + ((size_t)bh * HD + r) * LP + 4 * hh;
            f32x16 o0, o1;
#pragma unroll
            for (int i = 0; i < 16; ++i) { o0[i] = 0.f; o1[i] = 0.f; }
            float carry = 0.f;
            bf16x8 kA[4], kB[4]; u32x2 vA[8], vB[8];
#define AT_LOAD(jj, KF, VF) do { const int _j = (jj); _Pragma("unroll") for (int kk = 0; kk < 4; ++kk) KF[kk] = *(const bf16x8*)(kb + (size_t)(32 * _j) * HD + 16 * kk); \
                _Pragma("unroll") for (int mt = 0; mt < 2; ++mt) _Pragma("unroll") for (int st = 0; st < 2; ++st) { const bf16_t* vp = vb0 + (size_t)mt * 32 * LP + 32 * _j + 16 * st; \
                    VF[(mt * 2 + st) * 2] = *(const u32x2*)vp; VF[(mt * 2 + st) * 2 + 1] = *(const u32x2*)(vp + 8); } } while (0)
#define AT_TILE(jj, KF, VF) do { const int jt = (jj); f32x16 sc; \
                _Pragma("unroll") for (int i = 0; i < 16; ++i) sc[i] = 0.f; \
                _Pragma("unroll") for (int kk = 0; kk < 4; ++kk) sc = __builtin_amdgcn_mfma_f32_32x32x16_bf16(KF[kk], qf[kk], sc, 0, 0, 0); \
                float lm[16], ls[16], ex[16], gs[4], pg[4]; \
                const bool diag = (jt == a + 1), first = (jt == 0); \
                _Pragma("unroll") for (int i = 0; i < 16; ++i) { \
                    const int key = (i & 3) + 8 * (i >> 2) + 4 * hh; \
                    const bool valid = diag ? (key < r) : (first ? (key >= 16) : true); \
                    const float z = sc[i]; \
                    const float sp = fmaxf(z, 0.f) + __logf(1.0f + __expf(-fabsf(z))); \
                    lm[i] = valid ? -sp : 0.f; ls[i] = valid ? (z - sp) : -1.0e30f; } \
                _Pragma("unroll") for (int g = 0; g < 4; ++g) { ex[4 * g + 3] = 0.f; ex[4 * g + 2] = lm[4 * g + 3]; ex[4 * g + 1] = ex[4 * g + 2] + lm[4 * g + 2]; ex[4 * g] = ex[4 * g + 1] + lm[4 * g + 1]; gs[g] = ex[4 * g] + lm[4 * g]; } \
                _Pragma("unroll") for (int g = 0; g < 4; ++g) pg[g] = __shfl_xor(gs[g], 32); \
                float os[4], pi[4], off[4]; \
                os[3] = 0.f; os[2] = gs[3]; os[1] = os[2] + gs[2]; os[0] = os[1] + gs[1]; \
                pi[3] = pg[3]; pi[2] = pi[3] + pg[2]; pi[1] = pi[2] + pg[1]; pi[0] = pi[1] + pg[0]; \
                _Pragma("unroll") for (int g = 0; g < 4; ++g) off[g] = carry + os[g] + (hh == 0 ? pi[g] : (pi[g] - pg[g])); \
                const float total = os[0] + gs[0] + pi[0]; \
                float pv[16]; \
                _Pragma("unroll") for (int i = 0; i < 16; ++i) pv[i] = __expf(ls[i] + off[i >> 2] + ex[i]); \
                carry += total; \
                bf16x8 pf[2]; \
                _Pragma("unroll") for (int st = 0; st < 2; ++st) { u32x4 w; w.x = pk2bf(pv[8 * st], pv[8 * st + 1]); w.y = pk2bf(pv[8 * st + 2], pv[8 * st + 3]); w.z = pk2bf(pv[8 * st + 4], pv[8 * st + 5]); w.w = pk2bf(pv[8 * st + 6], pv[8 * st + 7]); pf[st] = __builtin_bit_cast(bf16x8, w); } \
                _Pragma("unroll") for (int st = 0; st < 2; ++st) { \
                    u32x4 w0; w0.x = VF[st * 2].x; w0.y = VF[st * 2].y; w0.z = VF[st * 2 + 1].x; w0.w = VF[st * 2 + 1].y; \
                    u32x4 w1; w1.x = VF[(2 + st) * 2].x; w1.y = VF[(2 + st) * 2].y; w1.z = VF[(2 + st) * 2 + 1].x; w1.w = VF[(2 + st) * 2 + 1].y; \
                    o0 = __builtin_amdgcn_mfma_f32_32x32x16_bf16(__builtin_bit_cast(bf16x8, w0), pf[st], o0, 0, 0, 0); \
                    o1 = __builtin_amdgcn_mfma_f32_32x32x16_bf16(__builtin_bit_cast(bf16x8, w1), pf[st], o1, 0, 0, 0); } \
            } while (0)
            int j = a + 1;
            AT_LOAD(j, kA, vA);
            for (;;) {
                AT_LOAD(j > 0 ? j - 1 : 0, kB, vB);
                AT_TILE(j, kA, vA);
                if (j == 0 || __all(carry < -SB_THR)) break;
                --j;
                AT_LOAD(j > 0 ? j - 1 : 0, kA, vA);
                AT_TILE(j, kB, vB);
                if (j == 0 || __all(carry < -SB_THR)) break;
                --j;
            }
#undef AT_LOAD
#undef AT_TILE
            bf16_t* op = O + (size_t)(b * SEQ + 32 * a + r) * CW + h * HD + 4 * hh;
#pragma unroll
            for (int g = 0; g < 4; ++g) {
                u32x2 w0, w1; w0.x = pk2bf(o0[4 * g], o0[4 * g + 1]); w0.y = pk2bf(o0[4 * g + 2], o0[4 * g + 3]); w1.x = pk2bf(o1[4 * g], o1[4 * g + 1]); w1.y = pk2bf(o1[4 * g + 2], o1[4 * g + 3]);
                *(u32x2*)(op + 8 * g) = w0; *(u32x2*)(op + 32 + 8 * g) = w1;
            }
        }
    }
}

__device__ __forceinline__ unsigned ord_key(float s) { const unsigned u = __builtin_bit_cast(unsigned, s); return u ^ ((unsigned)((int)u >> 31) | 0x80000000u); }
__device__ __forceinline__ float ord_val(unsigned k) { const unsigned u = (k & 0x80000000u) ? (k ^ 0x80000000u) : ~k; return __builtin_bit_cast(float, u); }
#define CE(a, b) do { const unsigned _x = (a), _y = (b); (a) = _x > _y ? _x : _y; (b) = _x > _y ? _y : _x; } while (0)
#define SORT16(v) do { CE(v[0], v[1]); CE(v[2], v[3]); CE(v[0], v[2]); CE(v[1], v[3]); CE(v[1], v[2]); CE(v[4], v[5]); CE(v[6], v[7]); CE(v[4], v[6]); CE(v[5], v[7]); CE(v[5], v[6]); CE(v[0], v[4]); CE(v[2], v[6]); CE(v[2], v[4]); CE(v[1], v[5]); CE(v[3], v[7]); CE(v[3], v[5]); CE(v[1], v[2]); CE(v[3], v[4]); CE(v[5], v[6]); CE(v[8], v[9]); CE(v[10], v[11]); CE(v[8], v[10]); CE(v[9], v[11]); CE(v[9], v[10]); CE(v[12], v[13]); CE(v[14], v[15]); CE(v[12], v[14]); CE(v[13], v[15]); CE(v[13], v[14]); CE(v[8], v[12]); CE(v[10], v[14]); CE(v[10], v[12]); CE(v[9], v[13]); CE(v[11], v[15]); CE(v[11], v[13]); CE(v[9], v[10]); CE(v[11], v[12]); CE(v[13], v[14]); CE(v[0], v[8]); CE(v[4], v[12]); CE(v[4], v[8]); CE(v[2], v[10]); CE(v[6], v[14]); CE(v[6], v[10]); CE(v[2], v[4]); CE(v[6], v[8]); CE(v[10], v[12]); CE(v[1], v[9]); CE(v[5], v[13]); CE(v[5], v[9]); CE(v[3], v[11]); CE(v[7], v[15]); CE(v[7], v[11]); CE(v[3], v[5]); CE(v[7], v[9]); CE(v[11], v[13]); CE(v[1], v[2]); CE(v[3], v[4]); CE(v[5], v[6]); CE(v[7], v[8]); CE(v[9], v[10]); CE(v[11], v[12]); CE(v[13], v[14]); } while (0)
#define BMERGE16(v) do { CE(v[0], v[8]); CE(v[1], v[9]); CE(v[2], v[10]); CE(v[3], v[11]); CE(v[4], v[12]); CE(v[5], v[13]); CE(v[6], v[14]); CE(v[7], v[15]); CE(v[0], v[4]); CE(v[1], v[5]); CE(v[2], v[6]); CE(v[3], v[7]); CE(v[8], v[12]); CE(v[9], v[13]); CE(v[10], v[14]); CE(v[11], v[15]); CE(v[0], v[2]); CE(v[1], v[3]); CE(v[4], v[6]); CE(v[5], v[7]); CE(v[8], v[10]); CE(v[9], v[11]); CE(v[12], v[14]); CE(v[13], v[15]); CE(v[0], v[1]); CE(v[2], v[3]); CE(v[4], v[5]); CE(v[6], v[7]); CE(v[8], v[9]); CE(v[10], v[11]); CE(v[12], v[13]); CE(v[14], v[15]); } while (0)

#define MERGE_TOP16(a, b) do { _Pragma("unroll") for (int _i = 0; _i < 16; ++_i) { const unsigned _p = (a)[_i], _q = (b)[15 - _i]; (a)[_i] = _p > _q ? _p : _q; } BMERGE16(a); } while (0)
__device__ static constexpr int CAND_I[50] = {0, 0, 0, 0, 0, 0, 0, 0, 0, 0, 0, 0, 0, 0, 0, 0, 1, 1, 1, 1, 1, 1, 1, 1, 2, 2, 2, 2, 2, 3, 3, 3, 3, 4, 4, 4, 5, 5, 6, 6, 7, 7, 8, 9, 10, 11, 12, 13, 14, 15};
__device__ static constexpr int CAND_J[50] = {0, 1, 2, 3, 4, 5, 6, 7, 8, 9, 10, 11, 12, 13, 14, 15, 0, 1, 2, 3, 4, 5, 6, 7, 0, 1, 2, 3, 4, 0, 1, 2, 3, 0, 1, 2, 0, 1, 0, 1, 0, 1, 0, 0, 0, 0, 0, 0, 0, 0};

__device__ __forceinline__ void phase5_stage(Ctx& F) {
    const f16_t* SKB = (const f16_t*)(F.ws + WS_SKB);
    const int h = F.reg ? (F.rank & 7) : (int)(blockIdx.x & 7);
    const u32x4* src = (const u32x4*)(SKB + (size_t)(h * 2) * 128 * 128);
    u32x4 t[8];
#pragma unroll
    for (int i = 0; i < 8; ++i) t[i] = src[F.tid + NTHR * i];
#pragma unroll
    for (int i = 0; i < 8; ++i) { const int c = F.tid + NTHR * i, row = c >> 4, ch = c & 15; *(LAS u32x4*)(F.lds + row * 272 + ch * 16) = t[i]; }
    __syncthreads();
}
__device__ __forceinline__ void phase5(Ctx& F) {
    const f16_t* QP = (const f16_t*)(F.ws + WS_B);
    u16* EIDX = (u16*)(F.ws + WS_E); float* GATE = (float*)(F.ws + WS_GATE);
    const int r = F.lane & 31, hh = F.lane >> 5;
    LAS unsigned char* tab = F.lds + 73728 + F.wave * 2048 + F.lane * 32;
    const int h = F.reg ? (F.rank & 7) : (int)(blockIdx.x & 7), nbh = F.G >> 3;
    const int tg0 = F.reg ? F.xcc * 64 + (F.rank >> 3) * 8 + F.wave : (int)(blockIdx.x >> 3) + nbh * F.wave, tgstep = F.reg ? 32 : nbh * NWAVES, tgend = F.reg ? F.xcc * 64 + 64 : 512;
    for (int tg = tg0; tg < tgend; tg += tgstep) {
        const int tok = tg * 32 + r;
        unsigned T0[16], T1[16];
#pragma unroll
        for (int p = 0; p < 2; ++p) {
            const int g = h * 2 + p;
            f32x16 acc[4];
#pragma unroll
            for (int mt = 0; mt < 4; ++mt)
#pragma unroll
                for (int i = 0; i < 16; ++i) acc[mt][i] = 0.f;
            const f16_t* qp = QP + (size_t)tok * 2048 + g * 128 + 8 * hh;
            const LAS unsigned char* kp = F.lds + (p * 128 + r) * 272 + 16 * hh;
#pragma unroll
            for (int kk = 0; kk < 8; ++kk) {
                const f16x8 qf = *(const f16x8*)(qp + 16 * kk);
#pragma unroll
                for (int mt = 0; mt < 4; ++mt) { const f16x8 kf = *(const LAS f16x8*)(kp + mt * 32 * 272 + 32 * kk); acc[mt] = __builtin_amdgcn_mfma_f32_32x32x16_f16(kf, qf, acc[mt], 0, 0, 0); }
            }
            unsigned cur[16], nxt[16];
#pragma unroll
            for (int mt = 0; mt < 4; ++mt) {
#pragma unroll
                for (int i = 0; i < 16; ++i) { const int kc = 127 - (32 * mt + (i & 3) + 8 * (i >> 2)); nxt[i] = (ord_key(acc[mt][i]) & ~127u) | (unsigned)(kc - 4 * hh); }
                SORT16(nxt);
                if (mt == 0) {
#pragma unroll
                    for (int i = 0; i < 16; ++i) cur[i] = nxt[i];
                } else MERGE_TOP16(cur, nxt);
            }
#pragma unroll
            for (int i = 0; i < 16; ++i) nxt[i] = (unsigned)__shfl_xor((int)cur[i], 32);
            MERGE_TOP16(cur, nxt);
#pragma unroll
            for (int i = 0; i < 16; ++i) { if (p == 0) T0[i] = cur[i]; else T1[i] = cur[i]; }
        }
        {
            u32x4 w0, w1, w2, w3;
            w0.x = (T0[0] & 127u) | ((T0[1] & 127u) << 8) | ((T0[2] & 127u) << 16) | ((T0[3] & 127u) << 24); w0.y = (T0[4] & 127u) | ((T0[5] & 127u) << 8) | ((T0[6] & 127u) << 16) | ((T0[7] & 127u) << 24);
            w0.z = (T0[8] & 127u) | ((T0[9] & 127u) << 8) | ((T0[10] & 127u) << 16) | ((T0[11] & 127u) << 24); w0.w = (T0[12] & 127u) | ((T0[13] & 127u) << 8) | ((T0[14] & 127u) << 16) | ((T0[15] & 127u) << 24);
            w1.x = (T1[0] & 127u) | ((T1[1] & 127u) << 8) | ((T1[2] & 127u) << 16) | ((T1[3] & 127u) << 24); w1.y = (T1[4] & 127u) | ((T1[5] & 127u) << 8) | ((T1[6] & 127u) << 16) | ((T1[7] & 127u) << 24);
            w1.z = (T1[8] & 127u) | ((T1[9] & 127u) << 8) | ((T1[10] & 127u) << 16) | ((T1[11] & 127u) << 24); w1.w = (T1[12] & 127u) | ((T1[13] & 127u) << 8) | ((T1[14] & 127u) << 16) | ((T1[15] & 127u) << 24);
            *(LAS u32x4*)tab = w0; *(LAS u32x4*)(tab + 16) = w1; (void)w2; (void)w3;
        }
        float s0[16], s1[16];
#pragma unroll
        for (int i = 0; i < 16; ++i) { s0[i] = ord_val(T0[i] & ~127u); s1[i] = ord_val(T1[i] & ~127u); }
        unsigned c0[16], c1[16];
#pragma unroll
        for (int c = 0; c < 16; ++c) c0[c] = (ord_key(s0[CAND_I[c]] + s1[CAND_J[c]]) & ~255u) | (unsigned)(255 - (CAND_I[c] * 16 + CAND_J[c]));
        SORT16(c0);
#pragma unroll
        for (int c = 0; c < 16; ++c) c1[c] = (ord_key(s0[CAND_I[16 + c]] + s1[CAND_J[16 + c]]) & ~255u) | (unsigned)(255 - (CAND_I[16 + c] * 16 + CAND_J[16 + c]));
        SORT16(c1); MERGE_TOP16(c0, c1);
#pragma unroll
        for (int c = 0; c < 16; ++c) c1[c] = (ord_key(s0[CAND_I[32 + c]] + s1[CAND_J[32 + c]]) & ~255u) | (unsigned)(255 - (CAND_I[32 + c] * 16 + CAND_J[32 + c]));
        SORT16(c1); MERGE_TOP16(c0, c1);
#pragma unroll
        for (int c = 0; c < 16; ++c) c1[c] = 0u;
        c1[0] = (ord_key(s0[CAND_I[48]] + s1[CAND_J[48]]) & ~255u) | (unsigned)(255 - (CAND_I[48] * 16 + CAND_J[48]));
        c1[1] = (ord_key(s0[CAND_I[49]] + s1[CAND_J[49]]) & ~255u) | (unsigned)(255 - (CAND_I[49] * 16 + CAND_J[49]));
        CE(c1[0], c1[1]); MERGE_TOP16(c0, c1);
        float sc[16]; unsigned eid[16];
        asm volatile("s_waitcnt lgkmcnt(0)" ::: "memory");
#pragma unroll
        for (int k = 0; k < 16; ++k) {
            const unsigned ci = 255u - (c0[k] & 255u);
            const unsigned b0 = tab[ci >> 4], b1 = tab[16 + (ci & 15u)];
            eid[k] = (127u - b0) * 128u + (127u - b1);
            sc[k] = ord_val(c0[k] & ~255u);
        }
        float sum = 0.f; const float mx = sc[0], r2 = rstd2_of((const float*)(F.ws + WS_SS2), tok);
#pragma unroll
        for (int k = 0; k < 16; ++k) { sc[k] = __expf((sc[k] - mx) * r2); sum += sc[k]; }
        const float inv = 1.0f / sum;
        if (hh == 0) {
            u32x4 w0, w1;
            w0.x = eid[0] | (eid[1] << 16); w0.y = eid[2] | (eid[3] << 16); w0.z = eid[4] | (eid[5] << 16); w0.w = eid[6] | (eid[7] << 16);
            w1.x = eid[8] | (eid[9] << 16); w1.y = eid[10] | (eid[11] << 16); w1.z = eid[12] | (eid[13] << 16); w1.w = eid[14] | (eid[15] << 16);
            u32x4* ep = (u32x4*)(EIDX + (size_t)tok * NSEL + h * 16); ep[0] = w0; ep[1] = w1;
        } else {
            f32x4* gp = (f32x4*)(GATE + (size_t)tok * NSEL + h * 16);
            gp[0] = (f32x4){sc[0] * inv, sc[1] * inv, sc[2] * inv, sc[3] * inv}; gp[1] = (f32x4){sc[4] * inv, sc[5] * inv, sc[6] * inv, sc[7] * inv};
            gp[2] = (f32x4){sc[8] * inv, sc[9] * inv, sc[10] * inv, sc[11] * inv}; gp[3] = (f32x4){sc[12] * inv, sc[13] * inv, sc[14] * inv, sc[15] * inv};
        }
    }
}

__device__ __forceinline__ float gelu_tanh(float x) { const float u = 0.7978845608028654f * (x + 0.044715f * x * x * x); return 0.5f * x * (1.0f + tanhf(u)); }
__device__ __forceinline__ unsigned e16_of(const u32x4& a, const u32x4& b, int i) {
    const unsigned w = (i < 8) ? ((i >> 1) == 0 ? a.x : (i >> 1) == 1 ? a.y : (i >> 1) == 2 ? a.z : a.w) : (((i - 8) >> 1) == 0 ? b.x : ((i - 8) >> 1) == 1 ? b.y : ((i - 8) >> 1) == 2 ? b.z : b.w);
    return (i & 1) ? (w >> 16) : (w & 0xffffu);
}
#ifndef FP4_SWAP
#define FP4_SWAP 0
#endif
__device__ __forceinline__ f16x2 fp4h2(unsigned w, int b) {
    const f16x2 r = b == 0 ? __builtin_amdgcn_cvt_scalef32_pk_f16_fp4(w, 1.0f, 0) : b == 1 ? __builtin_amdgcn_cvt_scalef32_pk_f16_fp4(w, 1.0f, 1) : b == 2 ? __builtin_amdgcn_cvt_scalef32_pk_f16_fp4(w, 1.0f, 2) : __builtin_amdgcn_cvt_scalef32_pk_f16_fp4(w, 1.0f, 3);
    return FP4_SWAP ? (f16x2){r[1], r[0]} : r;
}
#define UM_IDX(k, E) do { E = *(const u32x4*)(EIDX + (size_t)(tok0 + (k) * nws) * NSEL + 8 * cA); } while (0)
#define UM_ISSUE(k, UV, XB, E) do { const u32x4* _xp = (const u32x4*)(X18 + (size_t)(tok0 + (k) * nws) * D + slice * 256 + xoff); \
        _Pragma("unroll") for (int _g = 0; _g < 8; ++_g) { const unsigned _w = (_g >> 1) == 0 ? E.x : (_g >> 1) == 1 ? E.y : (_g >> 1) == 2 ? E.z : E.w; \
            const unsigned char* _r = ub + (size_t)((_g & 1) ? (_w >> 16) : (_w & 0xffffu)) * 128; UV[2 * _g] = *(const u32x4*)_r; UV[2 * _g + 1] = *(const u32x4*)(_r + 64); } \
        XB[0] = _xp[0]; XB[1] = _xp[8]; } while (0)
#define UM_CONSUME(k, UV, XB) do { float dv[8]; \
        i32x8 bx0, bx1; \
        bx0[0] = inLo ? XB[0].x : 0u; bx0[1] = inLo ? XB[0].y : 0u; bx0[2] = inLo ? XB[0].z : 0u; bx0[3] = inLo ? XB[0].w : 0u; bx0[4] = inHi ? XB[0].x : 0u; bx0[5] = inHi ? XB[0].y : 0u; bx0[6] = inHi ? XB[0].z : 0u; bx0[7] = inHi ? XB[0].w : 0u; \
        bx1[0] = inLo ? XB[1].x : 0u; bx1[1] = inLo ? XB[1].y : 0u; bx1[2] = inLo ? XB[1].z : 0u; bx1[3] = inLo ? XB[1].w : 0u; bx1[4] = inHi ? XB[1].x : 0u; bx1[5] = inHi ? XB[1].y : 0u; bx1[6] = inHi ? XB[1].z : 0u; bx1[7] = inHi ? XB[1].w : 0u; \
        _Pragma("unroll") for (int _g = 0; _g < 8; ++_g) { \
            i32x8 ax; ax[0] = UV[2 * _g].x; ax[1] = UV[2 * _g].y; ax[2] = UV[2 * _g].z; ax[3] = UV[2 * _g].w; ax[4] = 0; ax[5] = 0; ax[6] = 0; ax[7] = 0; \
            f32x4 z = {0.f, 0.f, 0.f, 0.f}; \
            z = __builtin_amdgcn_mfma_scale_f32_16x16x128_f8f6f4(ax, bx0, z, 4, 0, 0, 0, 0, 0); \
            ax[0] = UV[2 * _g + 1].x; ax[1] = UV[2 * _g + 1].y; ax[2] = UV[2 * _g + 1].z; ax[3] = UV[2 * _g + 1].w; \
            z = __builtin_amdgcn_mfma_scale_f32_16x16x128_f8f6f4(ax, bx1, z, 4, 0, 0, 0, 0, 0); \
            float v = bq == 0 ? z.x : bq == 1 ? z.y : bq == 2 ? z.z : z.w; \
            v += __builtin_bit_cast(float, __builtin_amdgcn_update_dpp(0, __builtin_bit_cast(int, v), 0xB1, 0xf, 0xf, true)); \
            v += __builtin_bit_cast(float, __builtin_amdgcn_update_dpp(0, __builtin_bit_cast(int, v), 0x4E, 0xf, 0xf, true)); \
            dv[_g] = v; } \
        if (storer) { u32x4 o0; o0.x = pk2h(dv[0], dv[1]); o0.y = pk2h(dv[2], dv[3]); o0.z = pk2h(dv[4], dv[5]); o0.w = pk2h(dv[6], dv[7]); \
            *(u32x4*)(DOTP + ((size_t)(tok0 + (k) * nws) * 4 + slice) * NSEL + 8 * cD) = o0; } } while (0)
__device__ __forceinline__ void phaseU(Ctx& F) {
    const unsigned char* U4 = F.ws + WS_T; const u16* EIDX = (const u16*)(F.ws + WS_E); f16_t* DOTP = (f16_t*)(F.ws + WS_B); const unsigned char* X18 = F.ws + WS_X18;
    const int xl = blockIdx.x & 7, slice = xl & 3, nws = (F.G >> 3) * NWAVES, tok0 = (xl >> 2) * (M / 2) + (blockIdx.x >> 3) * NWAVES + F.wave;
    const int rho = F.lane & 15, kg = F.lane >> 4, bq = rho & 3, aq = rho >> 2;
    const int cA = 4 * aq + kg;
    const int cD = 4 * kg + aq;
    const bool inLo = aq == (kg >> 1), inHi = aq == 2 + (kg >> 1);
    const int xoff = 32 * bq + 16 * (kg & 1);
    const bool storer = bq == 0;
    const unsigned char* ub = U4 + (size_t)slice * (NEXP * 128) + bq * 16;
    const int N = (M / 2 - ((blockIdx.x >> 3) * NWAVES + F.wave) + nws - 1) / nws;
    if (N <= 0) return;
    u32x4 uvA[16], uvB[16]; u32x4 xA[2], xB[2]; u32x4 eA, eB;
    int k0 = 0;
    if (N & 1) { UM_IDX(0, eA); UM_ISSUE(0, uvA, xA, eA); UM_CONSUME(0, uvA, xA); k0 = 1; if (N == 1) return; }
    const int L = N - 1;
    UM_IDX(k0, eA);
    UM_IDX(k0 + 1, eB);
    UM_ISSUE(k0, uvA, xA, eA);
    for (int n = k0; n < N; n += 2) {
        UM_IDX(min(n + 2, L), eA);
        UM_ISSUE(n + 1, uvB, xB, eB);
        UM_CONSUME(n, uvA, xA);
        UM_IDX(min(n + 3, L), eB);
        UM_ISSUE(min(n + 2, L), uvA, xA, eA);
        UM_CONSUME(n + 1, uvB, xB);
    }
}
__device__ __forceinline__ void phaseW(Ctx& F) {
    const f16_t* DOTP = (const f16_t*)(F.ws + WS_B); const float* GATE = (const float*)(F.ws + WS_GATE); const float* SS2 = (const float*)(F.ws + WS_SS2); unsigned char* W8 = F.ws + WS_WGT;
    const u16* EIDX = (const u16*)(F.ws + WS_E); const float* SU = (const float*)(F.ws + WS_T + 16 * MiB); const float* SV = SU + NEXP;
    for (int tok0 = F.gw; tok0 < M; tok0 += 4 * F.NGW) {
        unsigned dp[4][4], ee[4]; f32x2 gt[4]; f32x4 ss[4][4];
#pragma unroll
        for (int u = 0; u < 4; ++u) {
            const int tok = min(tok0 + u * F.NGW, M - 1);
#pragma unroll
            for (int sl = 0; sl < 4; ++sl) dp[u][sl] = *(const unsigned*)(DOTP + ((size_t)tok * 4 + sl) * NSEL + 2 * F.lane);
            gt[u] = *(const f32x2*)(GATE + (size_t)tok * NSEL + 2 * F.lane);
            ee[u] = *(const unsigned*)(EIDX + (size_t)tok * NSEL + 2 * F.lane);
#pragma unroll
            for (int q = 0; q < 4; ++q) ss[u][q] = ((const f32x4*)(SS2 + (size_t)tok * 16))[q];
        }
        float su0[4], su1[4], sv0[4], sv1[4];
#pragma unroll
        for (int u = 0; u < 4; ++u) { const unsigned e0 = ee[u] & 0xffffu, e1 = ee[u] >> 16; su0[u] = SU[e0]; su1[u] = SU[e1]; sv0[u] = SV[e0]; sv1[u] = SV[e1]; }
#pragma unroll
        for (int u = 0; u < 4; ++u) {
            const int tok = tok0 + u * F.NGW;
            const f32x4 a = ss[u][0], b = ss[u][1], c = ss[u][2], d = ss[u][3];
            const float sq = ((a.x + a.y) + (a.z + a.w)) + ((b.x + b.y) + (b.z + b.w)) + ((c.x + c.y) + (c.z + c.w)) + ((d.x + d.y) + (d.z + d.w));
            const float r2 = (1.0f / 4.0f) / sqrtf(sq * (1.0f / D) + EPS);
            float d0 = 0.f, d1 = 0.f;
#pragma unroll
            for (int sl = 0; sl < 4; ++sl) { const f16x2 h = as_h2(dp[u][sl]); d0 += (float)h[0]; d1 += (float)h[1]; }
            if (tok < M) {
                const unsigned pk = (unsigned)__builtin_amdgcn_cvt_pk_fp8_f32(128.f * gt[u].x * gelu_tanh(d0 * r2 * su0[u]) * sv0[u], 128.f * gt[u].y * gelu_tanh(d1 * r2 * su1[u]) * sv1[u], 0, false);
                unsigned char* wp = W8 + (size_t)tok * NSEL + 16 * (F.lane & 7) + (F.lane >> 3);
                wp[0] = (unsigned char)(pk & 0xffu); wp[8] = (unsigned char)((pk >> 8) & 0xffu);
            }
        }
    }
}
typedef int v2i_t __attribute__((ext_vector_type(2)));
__device__ __forceinline__ void phaseV(Ctx& F) {
    const unsigned char* V4 = F.ws + WS_T + 8 * MiB; const u16* EIDX = (const u16*)(F.ws + WS_E); const unsigned char* W8 = F.ws + WS_WGT; const f16_t* X1H = (const f16_t*)(F.ws + WS_A); f16_t* X2 = (f16_t*)(F.ws + WS_B);
    const int xl = blockIdx.x & 7, slice = xl & 3, nws = (F.G >> 3) * NWAVES, tok0 = (xl >> 2) * (M / 2) + (blockIdx.x >> 3) * NWAVES + F.wave;
    const int p = F.lane >> 3, c = F.lane & 7;
    const int j = F.lane & 15, kg = F.lane >> 4;
    const unsigned char* vb = V4 + (size_t)slice * (NEXP * 128) + ((c ^ p) * 16);
    const int N = (M / 2 - ((blockIdx.x >> 3) * NWAVES + F.wave) + nws - 1) / nws;
    if (N <= 0) return;
    LAS unsigned char* fifo = F.lds + F.wave * 16384;
    const int ra = 32 * kg + j, rb = ra + 16;
    const LAS unsigned char* pa = fifo + ra * 128; const LAS unsigned char* pb = fifo + rb * 128;
    const int sa = ra & 7, sb = rb & 7;
    const int L = N - 1;
#define VT_IDX(k, EA, EB) do { const u32x4* _ep = (const u32x4*)(EIDX + (size_t)(tok0 + (k) * nws) * NSEL + p * 16); EA = _ep[0]; EB = _ep[1]; } while (0)
#define VT_DMA(EA, EB) do { _Pragma("unroll") for (int _i = 0; _i < 16; ++_i) \
        __builtin_amdgcn_global_load_lds((const unsigned*)(vb + (size_t)e16_of(EA, EB, _i) * 128), (LAS unsigned*)(fifo + 1024 * _i), 16, 0, 0); } while (0)
#define VT_META(k, WA, WB, X) do { const size_t _t = (size_t)(tok0 + (k) * nws); const u32x4* _wp = (const u32x4*)(W8 + _t * NSEL + 16 * kg); WA = _wp[0]; WB = _wp[4]; \
        const f16_t* _xp = X1H + _t * D + slice * 256 + 64 * kg + j; X[0] = *(const u16*)(_xp); X[1] = *(const u16*)(_xp + 16); X[2] = *(const u16*)(_xp + 32); X[3] = *(const u16*)(_xp + 48); } while (0)
    u32x4 e1a, e1b, wa, wb, wna, wnb; unsigned xc[4], xn[4];
    { u32x4 e0a, e0b; VT_IDX(0, e0a, e0b); VT_DMA(e0a, e0b); }
    VT_IDX(min(1, L), e1a, e1b);
    VT_META(0, wa, wb, xc);
#pragma unroll 1
    for (int n = 0; n < N; ++n) {
        asm volatile("s_waitcnt vmcnt(0)" ::: "memory");
        v2i_t ta[16], tb[16];
#pragma unroll
        for (int q = 0; q < 16; ++q) {
            ta[q] = __builtin_amdgcn_ds_read_tr4_b64_v2i32((LAS v2i_t*)(pa + (((q >> 1) ^ sa) << 4) + ((q & 1) << 3)));
            tb[q] = __builtin_amdgcn_ds_read_tr4_b64_v2i32((LAS v2i_t*)(pb + (((q >> 1) ^ sb) << 4) + ((q & 1) << 3)));
        }
        asm volatile("s_waitcnt lgkmcnt(0)" ::: "memory");
        VT_DMA(e1a, e1b);
        VT_IDX(min(n + 2, L), e1a, e1b);
        VT_META(min(n + 1, L), wna, wnb, xn);
        i32x8 aw; aw[0] = wa.x; aw[1] = wa.y; aw[2] = wa.z; aw[3] = wa.w; aw[4] = wb.x; aw[5] = wb.y; aw[6] = wb.z; aw[7] = wb.w;
        float yv[4] = {0.f, 0.f, 0.f, 0.f};
#pragma unroll
        for (int q = 0; q < 16; ++q) {
            i32x8 bv; bv[0] = ta[q].x; bv[1] = ta[q].y; bv[2] = tb[q].x; bv[3] = tb[q].y; bv[4] = 0; bv[5] = 0; bv[6] = 0; bv[7] = 0;
            f32x4 z = {0.f, 0.f, 0.f, 0.f};
            z = __builtin_amdgcn_mfma_scale_f32_16x16x128_f8f6f4(aw, bv, z, 0, 4, 0, 0, 0, 0);
            yv[q & 3] = ((q >> 2) == kg) ? z.x : yv[q & 3];
        }
        const size_t t = (size_t)(tok0 + n * nws);
        f16_t* op = X2 + t * D + slice * 256 + 64 * kg + j;
#pragma unroll
        for (int m = 0; m < 4; ++m) { const f16_t xh = __builtin_bit_cast(f16_t, (u16)xc[m]); op[16 * m] = (f16_t)((float)xh + yv[m] * (1.0f / 128.0f)); }
        wa = wna; wb = wnb;
#pragma unroll
        for (int m = 0; m < 4; ++m) xc[m] = xn[m];
    }
    asm volatile("s_waitcnt vmcnt(0)" ::: "memory");
#undef VT_IDX
#undef VT_DMA
#undef VT_META
}
__device__ __forceinline__ void phaseN(Ctx& F) {
    const f16_t* X2 = (const f16_t*)(F.ws + WS_B);
    f32x4 g[4];
#pragma unroll
    for (int c = 0; c < 4; ++c) g[c] = *(const f32x4*)(F.gf + 256 * c + 4 * F.lane);
    for (int tok0 = F.gw; tok0 < M; tok0 += 4 * F.NGW) {
        u32x2 xa[4][4];
#pragma unroll
        for (int u = 0; u < 4; ++u) {
            const int tok = min(tok0 + u * F.NGW, M - 1);
#pragma unroll
            for (int c = 0; c < 4; ++c) xa[u][c] = *(const u32x2*)(X2 + (size_t)tok * D + 256 * c + 4 * F.lane);
        }
#pragma unroll
        for (int u = 0; u < 4; ++u) {
            const int tok = tok0 + u * F.NGW;
            f32x4 a[4]; float sq = 0.f;
#pragma unroll
            for (int c = 0; c < 4; ++c) { const f16x2 p0 = as_h2(xa[u][c].x), p1 = as_h2(xa[u][c].y); a[c] = (f32x4){(float)p0[0], (float)p0[1], (float)p1[0], (float)p1[1]};
                sq += (a[c].x * a[c].x + a[c].y * a[c].y) + (a[c].z * a[c].z + a[c].w * a[c].w); }
            const float r3 = 1.0f / sqrtf(wave_sum(sq) * (1.0f / D) + EPS);
            if (tok < M) {
#pragma unroll
                for (int c = 0; c < 4; ++c) *(f32x4*)(F.out + (size_t)tok * D + 256 * c + 4 * F.lane) = a[c] * r3 * g[c];
            }
        }
    }
}

constexpr int NPHASE = 11;
__global__ void __launch_bounds__(NTHR, 2) fwd_kernel(Args args) {
    extern __shared__ __attribute__((aligned(16))) unsigned char lds[];
    Ctx F;
    F.lds = (LAS unsigned char*)lds;
    F.tid = threadIdx.x; F.lane = F.tid & 63; F.wave = __builtin_amdgcn_readfirstlane(F.tid >> 6);
    F.G = gridDim.x; F.gw = blockIdx.x * NWAVES + F.wave; F.NGW = F.G * NWAVES;
    F.x = args.in[0]; F.meta = args.in[1]; F.g1 = args.in[2]; F.w_in = args.in[3]; F.conv_w = args.in[4]; F.w_a = args.in[5]; F.w_b = args.in[6]; F.w_out = args.in[7];
    F.g2 = args.in[8]; F.w_q = args.in[9]; F.subk = args.in[10]; F.pu = args.in[11]; F.pv = args.in[12]; F.gf = args.in[13];
    F.out = args.out; F.ws = args.ws;
    volatile LAS unsigned* MISC = (volatile LAS unsigned*)(F.lds + MISC_OFF);
    if (F.tid < 32) MISC[F.tid] = 0u;
    __syncthreads();
    const int lo = args.ph_lo, hi = args.ph_hi;
    const bool multi = (hi - lo) > 1;
    XcdBarrier bar; bar.bar = (unsigned*)(F.ws + WS_CTL); bar.x = 0; bar.st = nullptr; bar.wave = F.wave;
    if (multi) bar = xcd_barrier_post((unsigned*)(F.ws + WS_CTL), MISC + 8, F.wave);
#define IN(k) (F.lane = lane_id(), F.tid = F.wave * 64 + F.lane, lo <= (k) && (k) < hi)
#define SEAM(k) do { if (IN(k) && IN((k) + 1)) xcd_barrier(bar); } while (0)

    bf16_t* BA = (bf16_t*)(F.ws + WS_B); bf16_t* CU = BA + (size_t)M * CW; bf16_t* Qb = CU + (size_t)M * CW; bf16_t* Kb = (bf16_t*)(F.ws + WS_KU); bf16_t* Vb = (bf16_t*)(F.ws + WS_VT);
    unsigned char* SGA = (unsigned char*)F.out; unsigned char* SGB = SGA + (size_t)M * D;
    bf16_t* MIX = (bf16_t*)(F.ws + WS_B);
    F.reg = 0; F.xcc = 0; F.rank = 0;
    if (IN(0)) { phase0(F); if (DUP_PHASE == 0) { xcd_barrier(bar); phase0(F); } SEAM(0); }
    if (multi && IN(0) && IN(1)) { F.reg = (int)MISC[10]; F.xcc = (int)bar.x; F.rank = (int)MISC[12]; if (F.rank >= 32 || F.xcc >= 8) F.reg = 0; }
    const int vb = F.reg ? F.rank * 8 + F.xcc : (int)blockIdx.x;
#define LSEAM(k) do { if (IN(k) && IN((k) + 1)) { if (F.reg) xcd_local_barrier(bar); else xcd_barrier(bar); } } while (0)
    if (IN(1)) {
        pg8::Gemm g{(const u16*)(F.ws + WS_A), (const u16*)(F.ws + WS_W1T), M, 3072, D, nullptr, nullptr}; pg8::StaticOrder S; S.init(M, 3072, F.G, vb);
        pg8::EpiAdapt<Epi1> E{Epi1{BA, CU, Qb, Kb, Vb}};
        pg8::Gemm g8{(const u16*)(F.ws + WS_X18), (const u16*)(F.ws + WS_WG8), M, 2048, D / 2, nullptr, nullptr}; pg8::StaticOrder S8; S8.init(M, 2048, F.G, vb);
        pg8::EpiAdapt<Epi1g> E8{Epi1g{SGA, SGB}};
        pg8::gemm_phase<pg8::EpiAdapt<Epi1>, pg8::StaticOrder, 0>(F.lds, g, S, E, F.wave);
        pg8::gemm_phase<pg8::EpiAdapt<Epi1g>, pg8::StaticOrder, 2>(F.lds, g8, S8, E8, F.wave);
        if (DUP_PHASE == 1) { xcd_barrier(bar); pg8::gemm_phase<pg8::EpiAdapt<Epi1>, pg8::StaticOrder, 0>(F.lds, g, S, E, F.wave); }
        if (DUP_PHASE == 102) { xcd_barrier(bar); pg8::gemm_phase<pg8::EpiAdapt<Epi1g>, pg8::StaticOrder, 2>(F.lds, g8, S8, E8, F.wave); }
        LSEAM(1);
    }
    if (IN(2)) {
        if (F.NGW == 2048) { float lt[32]; f32x4 lsk; late_load(F, lt, lsk); phase2(F); late_finish(F, lt, lsk); }
        else { if (F.wave & 1) convert_weights_late(F); phase2(F); if (!(F.wave & 1)) convert_weights_late(F); } if (DUP_PHASE == 2) { xcd_barrier(bar); phase2(F); } SEAM(2); }
    if (IN(3)) {
        pg8::PairOrder S; S.S.init(M, D, F.G, vb);
        pg8::Gemm g{(const u16*)(F.ws + WS_A + (size_t)M * CW * 2), (const u16*)(F.ws + WS_WAT), M, D, CW, (const u16*)(F.ws + WS_A), (const u16*)(F.ws + WS_WBT)};
        pg8::EpiAdapt<Epi3a> E{Epi3a{MIX, SGA, SGB}};
        pg8::gemm_phase<pg8::EpiAdapt<Epi3a>, pg8::PairOrder, 0>(F.lds, g, S, E, F.wave);
        if (DUP_PHASE == 3) { xcd_barrier(bar); pg8::gemm_phase<pg8::EpiAdapt<Epi3a>, pg8::PairOrder, 0>(F.lds, g, S, E, F.wave); }
        LSEAM(3);
    }
    if (IN(4)) {
        pg8::Gemm g{(const u16*)MIX, (const u16*)(F.ws + WS_WOT), M, D, D, nullptr, nullptr}; pg8::StaticOrder S; S.init(M, D, F.G, vb);
        pg8::EpiAdapt<Epi3b> E{Epi3b{F.x, (f16_t*)(F.ws + WS_A), (float*)(F.ws + WS_SS2), F.ws + WS_X18}};
        pg8::gemm_phase<pg8::EpiAdapt<Epi3b>, pg8::StaticOrder, 0>(F.lds, g, S, E, F.wave);
        if (DUP_PHASE == 4) { xcd_barrier(bar); pg8::gemm_phase<pg8::EpiAdapt<Epi3b>, pg8::StaticOrder, 0>(F.lds, g, S, E, F.wave); }
        LSEAM(4);
    }
    if (IN(5)) {
        pg8::Gemm g{(const u16*)(F.ws + WS_A), (const u16*)(F.ws + WS_WQT), M, 2048, D, nullptr, nullptr}; pg8::StaticOrder S; S.init(M, 2048, F.G, vb);
        pg8::EpiAdapt<Epi4> E{Epi4{(f16_t*)(F.ws + WS_B)}};
        pg8::gemm_phase<pg8::EpiAdapt<Epi4>, pg8::StaticOrder, 1>(F.lds, g, S, E, F.wave);
        if (DUP_PHASE == 5) { xcd_barrier(bar); pg8::gemm_phase<pg8::EpiAdapt<Epi4>, pg8::StaticOrder, 1>(F.lds, g, S, E, F.wave); }
        LSEAM(5);
    }
    if (IN(6)) { phase5_stage(F); if (F.wave & 1) convert_tables(F); phase5(F); if (!(F.wave & 1)) convert_tables(F); if (DUP_PHASE == 66) { xcd_barrier(bar); convert_tables(F); } if (DUP_PHASE == 6) { xcd_barrier(bar); phase5(F); } SEAM(6); }
    if (IN(7)) { phaseU(F); if (DUP_PHASE == 7) { xcd_barrier(bar); phaseU(F); } SEAM(7); }
    if (IN(8)) { phaseW(F); if (DUP_PHASE == 8) { xcd_barrier(bar); phaseW(F); } SEAM(8); }
    if (IN(9)) { phaseV(F); if (DUP_PHASE == 9) { xcd_barrier(bar); phaseV(F); } SEAM(9); }
    if (DUP_PHASE == 200) { for (int q = 0; q < 10; ++q) xcd_barrier(bar); }
    if (IN(10)) { phaseN(F); if (DUP_PHASE == 10) { xcd_barrier(bar); phaseN(F); } }
#undef IN
#undef SEAM
#undef LSEAM
}

extern "C" void kernel_launch(void* const* d_in, const int* in_sizes, int n_in, void* d_out, int out_size, void* d_ws, size_t ws_size, hipStream_t stream) {
    static int grid = 0;
    if (grid == 0) {
        if (n_in != 14 || out_size != M * D || ws_size < WS_END) { fprintf(stderr, "kernel_launch: unexpected shapes (n_in %d out %d ws %zu)\n", n_in, out_size, ws_size); grid = -1; return; }
        int dev = 0, cus = 0, per_cu = 0;
        if (hipGetDevice(&dev) != hipSuccess || hipDeviceGetAttribute(&cus, hipDeviceAttributeMultiprocessorCount, dev) != hipSuccess) { grid = -1; return; }
        if (hipFuncSetAttribute((const void*)fwd_kernel, hipFuncAttributeMaxDynamicSharedMemorySize, LDS_BYTES) != hipSuccess) { fprintf(stderr, "kernel_launch: hipFuncSetAttribute failed\n"); grid = -1; return; }
        if (hipOccupancyMaxActiveBlocksPerMultiprocessor(&per_cu, (const void*)fwd_kernel, NTHR, LDS_BYTES) != hipSuccess || per_cu < 1) { fprintf(stderr, "kernel_launch: occupancy query says %d\n", per_cu); (void)hipGetLastError(); per_cu = 1; }
        grid = cus;
    }
    if (grid < 0) return;
    (void)hipMemsetAsync((char*)d_ws + WS_CTL, 0, CTL_ZERO_BYTES, stream);
    Args a{};
    for (int i = 0; i < 14; ++i) a.in[i] = (const float*)d_in[i];
    a.out = (float*)d_out; a.ws = (unsigned char*)d_ws;
#if MK_N_LAUNCHES == 1
    a.ph_lo = 0; a.ph_hi = NPHASE;
    hipLaunchKernelGGL(fwd_kernel, dim3(grid), dim3(NTHR), LDS_BYTES, stream, a);
#else
    for (int p = 0; p < NPHASE; ++p) { a.ph_lo = p; a.ph_hi = p + 1; hipLaunchKernelGGL(fwd_kernel, dim3(grid), dim3(NTHR), LDS_BYTES, stream, a); }
#endif
}
```

```cpp
#include <hip/hip_runtime.h>
#include <cstdio>
#include <cstdint>

#ifndef MK_N_LAUNCHES
#define MK_N_LAUNCHES 1
#endif
#ifndef DUP_PHASE
#define DUP_PHASE -1
#endif
#ifndef NAIVE_GEMM
#define NAIVE_GEMM 0
#endif

#define LAS __attribute__((address_space(3)))
#define GAS __attribute__((address_space(1)))
typedef unsigned short bf16_t;
typedef unsigned short u16;
typedef _Float16 f16_t;
typedef short bf16x8 __attribute__((ext_vector_type(8)));
typedef _Float16 f16x8 __attribute__((ext_vector_type(8)));
typedef _Float16 f16x2 __attribute__((ext_vector_type(2)));
typedef float f32x4 __attribute__((ext_vector_type(4)));
typedef float f32x2 __attribute__((ext_vector_type(2)));
typedef unsigned u32x4 __attribute__((ext_vector_type(4)));
typedef unsigned u32x2 __attribute__((ext_vector_type(2)));
typedef float f32x16 __attribute__((ext_vector_type(16)));
typedef int i32x8 __attribute__((ext_vector_type(8)));
typedef int i32x4 __attribute__((ext_vector_type(4)));

constexpr int D = 1024, NB = 8, SEQ = 2048, M = NB * SEQ, NMETA = 16, CW = 512, NH = 8, HD = 64, INW = 5120;
constexpr int PH = 8, NKEY = 128, TOPK = 16, NSEL = 128, NEXP = 16384;
constexpr float EPS = 1e-6f;
constexpr float LOG2E = 1.4426950408889634f, QSCALE = 0.125f * LOG2E;
constexpr float SB_THR = 44.0f;
constexpr int NWAVES = 8, NTHR = 512;

constexpr size_t MiB = 1u << 20;
constexpr size_t WS_CTL = 0, WS_PSQ = 64 * 1024, CTL_ZERO_BYTES = 64 * 1024 + 256 * 1024 + 256;
constexpr size_t WS_W1T = 1 * MiB;
constexpr size_t WS_WG8 = 7 * MiB;
constexpr float GATE_U8_SCALE = 1.0f / 255.0f;
constexpr float GATE_WSCALE = 64.0f, XN8_SCALE = 8.0f;
constexpr size_t WS_WAT = 11 * MiB;
constexpr size_t WS_WBT = 12 * MiB;
constexpr size_t WS_WOT = 13 * MiB;
constexpr size_t WS_WQT = 15 * MiB;
constexpr size_t WS_SKB = 19 * MiB;
constexpr size_t WS_META = 19 * MiB + 512 * 1024;
constexpr size_t WS_SS2 = 20 * MiB;
constexpr size_t WS_A = 24 * MiB;
constexpr size_t WS_B = 56 * MiB;
constexpr size_t WS_KU = 104 * MiB;
constexpr size_t WS_VT = 121 * MiB;
constexpr int LP = 2080;
constexpr size_t WS_T = 140 * MiB;
constexpr size_t WS_X18 = 160 * MiB;
constexpr size_t WS_E = 200 * MiB;
constexpr size_t WS_GATE = WS_E + 4 * MiB, WS_WGT = WS_E + 12 * MiB;
constexpr size_t WS_SS3 = 21 * MiB;
constexpr size_t WS_END = 220 * MiB;

constexpr int LDS_BYTES = 147456;
constexpr int RING_BYTES = 131072;
constexpr int MISC_OFF = LDS_BYTES - 512;

__device__ __forceinline__ unsigned f2bf(float f) { unsigned u = __builtin_bit_cast(unsigned, f); return (u + 0x7fffu + ((u >> 16) & 1u)) >> 16; }
__device__ __forceinline__ float bf2f(unsigned h) { return __builtin_bit_cast(float, (h & 0xffffu) << 16); }
typedef __bf16 bf16x2_t __attribute__((ext_vector_type(2)));
__device__ __forceinline__ unsigned pk2bf(float lo, float hi) { const f32x2 v = {lo, hi}; return __builtin_bit_cast(unsigned, __builtin_convertvector(v, bf16x2_t)); }
__device__ __forceinline__ unsigned pk2h(float lo, float hi) { f16x2 v = {(f16_t)lo, (f16_t)hi}; return __builtin_bit_cast(unsigned, v); }
__device__ __forceinline__ f16x2 as_h2(unsigned w) { return __builtin_bit_cast(f16x2, w); }
__device__ __forceinline__ float bflo(unsigned w) { return __builtin_bit_cast(float, w << 16); }
__device__ __forceinline__ float bfhi(unsigned w) { return __builtin_bit_cast(float, w & 0xffff0000u); }
__device__ __forceinline__ float wave_sum(float v) {
#pragma unroll
    for (int o = 1; o < 64; o <<= 1) v += __shfl_xor(v, o);
    return v;
}
__device__ __forceinline__ float wave_sum_dpp(float v) {
    v += __builtin_bit_cast(float, __builtin_amdgcn_update_dpp(0, __builtin_bit_cast(int, v), 0xB1, 0xf, 0xf, true));
    v += __builtin_bit_cast(float, __builtin_amdgcn_update_dpp(0, __builtin_bit_cast(int, v), 0x4E, 0xf, 0xf, true));
    v += __builtin_bit_cast(float, __builtin_amdgcn_update_dpp(0, __builtin_bit_cast(int, v), 0x141, 0xf, 0xf, true));
    v += __builtin_bit_cast(float, __builtin_amdgcn_update_dpp(0, __builtin_bit_cast(int, v), 0x140, 0xf, 0xf, true));
    const int b = __builtin_bit_cast(int, v);
    return (__builtin_bit_cast(float, __builtin_amdgcn_readlane(b, 0)) + __builtin_bit_cast(float, __builtin_amdgcn_readlane(b, 16))) + (__builtin_bit_cast(float, __builtin_amdgcn_readlane(b, 32)) + __builtin_bit_cast(float, __builtin_amdgcn_readlane(b, 48)));
}
__device__ __forceinline__ float rows_sum(float s) {
    const unsigned u = __builtin_bit_cast(unsigned, s);
    const auto r = __builtin_amdgcn_permlane16_swap(u, u, false, false);
    const unsigned r0 = r[0], r1 = r[1];
    const float t = __builtin_bit_cast(float, r0) + __builtin_bit_cast(float, r1);
    const unsigned v = __builtin_bit_cast(unsigned, t);
    const auto q = __builtin_amdgcn_permlane32_swap(v, v, false, false);
    const unsigned q0 = q[0], q1 = q[1];
    return __builtin_bit_cast(float, q0) + __builtin_bit_cast(float, q1);
}
__device__ __forceinline__ float xlane32(float v, int hh) {
    const unsigned u = __builtin_bit_cast(unsigned, v);
    const auto r = __builtin_amdgcn_permlane32_swap(u, u, false, false);
    const unsigned lo = r[0], hi = r[1];
    return __builtin_bit_cast(float, hh ? lo : hi);
}
__device__ __forceinline__ unsigned wave_max_u(unsigned v) {
#pragma unroll
    for (int o = 1; o < 64; o <<= 1) { unsigned t = (unsigned)__shfl_xor((int)v, o); v = t > v ? t : v; }
    return v;
}
__device__ __forceinline__ int lane_id() { int l; asm volatile("v_mbcnt_lo_u32_b32 %0, -1, 0\n\tv_mbcnt_hi_u32_b32 %0, -1, %0" : "=v"(l)); return l; }
__device__ __forceinline__ float sigmoidf_(float x) { return __builtin_amdgcn_rcpf(1.0f + __builtin_amdgcn_exp2f(-1.4426950408889634f * x)); }

namespace pg8 {
constexpr int BM = 256, BK = 64, HALF = 128, HTB = HALF * BK * 2, STAGE_BYTES = 8 * HTB, NXCD = 8, WGM = 8;
__host__ __device__ __forceinline__ int lds_byte(int r, int c) { const int st = (r >> 4) * 2 + (c >> 5), rr = r & 15, cc = c & 31, ob = rr * 64 + cc * 2; return st * 1024 + (ob ^ (((ob >> 9) & 1) << 5)); }
__host__ __device__ __forceinline__ void stage_rc(int b, int& R, int& C) { const int st = b / 1024, sb = b % 1024, swz = sb ^ (((sb >> 9) & 1) << 5); R = (st >> 1) * 16 + swz / 64; C = (st & 1) * 32 + (swz % 64) / 2; }
__host__ __device__ __forceinline__ int perm32(int rho) { const int n = rho >> 4, i = rho & 15; return 8 * (i >> 2) + 4 * n + (i & 3); }
struct Unit { int pm, pn, which; };
struct Gemm { const u16* A; const u16* Bt; int M, N, K; const u16* A2; const u16* Bt2; };
struct StaticOrder {
    int nM, nN, nwg, G, c;
    __host__ __device__ void init(int M_, int N_, int G_, int c_) { nM = M_ / BM; nN = N_ / BM; nwg = nM * nN; G = G_; c = c_; }
    __host__ __device__ bool next(int i, Unit& u) const {
        const long L = (long)i * G + c; if (L >= nwg) return false;
        int wgid = (int)L; { const int q = nwg / NXCD, r = nwg % NXCD, xcd = wgid % NXCD, off = wgid / NXCD; wgid = (xcd < r ? xcd * (q + 1) : r * (q + 1) + (xcd - r) * q) + off; }
        const int nig = WGM * nN, gid = wgid / nig, fm = gid * WGM, gsz = (nM - fm) < WGM ? (nM - fm) : WGM;
        u.pm = fm + ((wgid % nig) % gsz); u.pn = (wgid % nig) / gsz; u.which = 0; return true;
    }
    __device__ __forceinline__ void a_ready(const Unit&) const {}
    __device__ __forceinline__ void done(const Unit&) const {}
};
struct PairOrder {
    StaticOrder S;
    __host__ __device__ bool next(int i, Unit& u) const { if (!S.next(i >> 1, u)) return false; u.which = i & 1; return true; }
    __device__ __forceinline__ void a_ready(const Unit&) const {}
    __device__ __forceinline__ void done(const Unit&) const {}
};

template <class F> struct EpiAdapt {
    static constexpr bool PERM = true, AFTER_DRAIN = false;
    F f;
    __device__ __forceinline__ void operator()(const f32x4 (&acc)[2][2][4][2], const Unit& u, int wr, int wc, int fr, int fq) const {
        int fr2 = fr; asm volatile("" : "+v"(fr2), "+v"(fq));
        const int col = u.pn * BM + wc * 32 + 8 * fq;
#pragma unroll
        for (int ai = 0; ai < 2; ++ai)
#pragma unroll
            for (int m = 0; m < 4; ++m) {
                const int row = u.pm * BM + ai * HALF + wr * 64 + m * 16 + fr2;
                f(row, col, u.pn + 64 * u.which, wc, acc[ai][0][m][0], acc[ai][0][m][1], acc[ai][1][m][0], acc[ai][1][m][1]);
            }
    }
};

#if NAIVE_GEMM
template <bool F16> __device__ __forceinline__ float dot8(u32x4 a, u32x4 b) {
    float s = 0.f;
#pragma unroll
    for (int i = 0; i < 4; ++i) {
        if (F16) { f16x2 x = as_h2(a[i]), y = as_h2(b[i]); s += (float)x[0] * (float)y[0] + (float)x[1] * (float)y[1]; }
        else s += bflo(a[i]) * bflo(b[i]) + bfhi(a[i]) * bfhi(b[i]);
    }
    return s;
}
template <class Epi, class Sched, int FMT>
__device__ __forceinline__ void gemm_phase(LAS unsigned char* lds, const Gemm g, const Sched& S, const Epi& E, const int wid) {
    constexpr bool F16 = FMT == 1;
    const int lane = lane_id(), tid = wid * 64 + lane, wr = wid >> 2, wc = wid & 3, fr = lane & 15, fq = lane >> 4;
    Unit u;
    for (int ui = 0; S.next(ui, u); ++ui) {
        f32x4 acc[2][2][4][2];
        for (int ai = 0; ai < 2; ++ai) for (int m = 0; m < 4; ++m) {
            const int row = u.pm * BM + ai * HALF + wr * 64 + m * 16 + fr;
            float a16[16];
            for (int j = 0; j < 16; ++j) a16[j] = 0.f;
            const u32x4* ap = (const u32x4*)(g.A + (size_t)row * g.K);
            for (int k8 = 0; k8 < g.K / 8; ++k8) {
                const u32x4 av = ap[k8];
#pragma unroll
                for (int j = 0; j < 16; ++j) {
                    const int col = u.pn * BM + (j >> 3) * HALF + wc * 32 + 8 * fq + (j & 7);
                    const u32x4 bv = ((const u32x4*)(g.Bt + (size_t)col * g.K))[k8];
                    a16[j] += dot8<F16>(av, bv);
                }
            }
            acc[ai][0][m][0] = (f32x4){a16[0], a16[1], a16[2], a16[3]}; acc[ai][0][m][1] = (f32x4){a16[4], a16[5], a16[6], a16[7]};
            acc[ai][1][m][0] = (f32x4){a16[8], a16[9], a16[10], a16[11]}; acc[ai][1][m][1] = (f32x4){a16[12], a16[13], a16[14], a16[15]};
        }
        E(acc, u, wr, wc, fr, fq);
    }
    __syncthreads();
}
#else
template <class Epi, class Sched, int FMT>
__device__ __forceinline__ void gemm_phase(LAS unsigned char* lds, const Gemm g, const Sched& S, const Epi& E, const int wid) {
    constexpr bool ALIGN_EPI = true; constexpr bool F16 = FMT == 1;
    const int lane = lane_id(), tid = wid * 64 + lane, wr = wid >> 2, wc = wid & 3, fr = lane & 15, fq = lane >> 4;
    const int K = g.K; int nt = K / BK;
    if constexpr (FMT == 2) asm volatile("" : "+s"(nt));
    unsigned voffA[2], voffB[2];
#pragma unroll
    for (int i = 0; i < 2; ++i) { int R, C; stage_rc(tid * 16 + i * 8192, R, C); const int Rb = Epi::PERM ? ((R & ~31) + perm32(R & 31)) : R;
        voffA[i] = (unsigned)(R * K + C) * 2u; voffB[i] = (unsigned)(Rb * K + C) * 2u; }
    const unsigned kstep = (unsigned)(BK * 2);
    const unsigned hstep = (unsigned)HALF * (unsigned)K * 2u;
    const unsigned tstep = 2u * hstep;
    const unsigned ldsw = (unsigned)wid * 1024u;
    const int aoff = lds_byte(wr * 64 + fr, fq * 8), boff = lds_byte(wc * 32 + fr, fq * 8);
#define PG8_SA(b, h) (((b) * 2 + (h)) * HTB)
#define PG8_SB(b, h) ((4 + (b) * 2 + (h)) * HTB)
#define PG8_STAGE(bufoff, gbase, goff, voff) do { unsigned _go = (goff); asm volatile("" : "+s"(_go));   \
        _Pragma("unroll") for (int _i = 0; _i < 2; ++_i) \
        __builtin_amdgcn_global_load_lds((const unsigned*)((gbase) + (_go + (voff)[_i])), (LAS unsigned*)(lds + (bufoff) + ldsw + _i * 8192), 16, 0, 0); } while (0)
#define PG8_LDA(dst, b, h) do { _Pragma("unroll") for (int m = 0; m < 4; ++m) _Pragma("unroll") for (int k = 0; k < 2; ++k) dst[m][k] = *(const LAS bf16x8*)(lds + PG8_SA(b, h) + aoff + m * 2048 + k * 1024); } while (0)
#define PG8_LDB(dst, b, h) do { _Pragma("unroll") for (int n = 0; n < 2; ++n) _Pragma("unroll") for (int k = 0; k < 2; ++k) dst[n][k] = *(const LAS bf16x8*)(lds + PG8_SB(b, h) + boff + n * 2048 + k * 1024); } while (0)
#define PG8_MMA(ai, bj, At, Bt) do { __builtin_amdgcn_s_setprio(1); _Pragma("unroll") for (int m = 0; m < 4; ++m) _Pragma("unroll") for (int n = 0; n < 2; ++n) { \
        if constexpr (FMT == 2) { const i32x8 _a = __builtin_shufflevector(__builtin_bit_cast(i32x4, Bt[n][0]), __builtin_bit_cast(i32x4, Bt[n][1]), 0, 1, 2, 3, 4, 5, 6, 7), \
                                      _b = __builtin_shufflevector(__builtin_bit_cast(i32x4, At[m][0]), __builtin_bit_cast(i32x4, At[m][1]), 0, 1, 2, 3, 4, 5, 6, 7); \
            acc[ai][bj][m][n] = __builtin_amdgcn_mfma_scale_f32_16x16x128_f8f6f4(_a, _b, acc[ai][bj][m][n], 0, 0, 0, 0, 0, 0); } \
        else { _Pragma("unroll") for (int k = 0; k < 2; ++k) { \
        if (F16) acc[ai][bj][m][n] = __builtin_amdgcn_mfma_f32_16x16x32_f16(__builtin_bit_cast(f16x8, Bt[n][k]), __builtin_bit_cast(f16x8, At[m][k]), acc[ai][bj][m][n], 0, 0, 0); \
        else acc[ai][bj][m][n] = __builtin_amdgcn_mfma_f32_16x16x32_bf16(Bt[n][k], At[m][k], acc[ai][bj][m][n], 0, 0, 0); } } } __builtin_amdgcn_s_setprio(0); } while (0)
#define PG8_WAIT_V(n) asm volatile("s_waitcnt vmcnt(" #n ")" ::: "memory")
#define PG8_WAIT_L(n) asm volatile("s_waitcnt lgkmcnt(" #n ")" ::: "memory")
#define PG8_BAR __builtin_amdgcn_s_barrier()
#define PG8_SCHED __builtin_amdgcn_sched_barrier(0)
    Unit cur, nxt; int ui = 0;
    if (!S.next(0, cur)) return;
    f32x4 acc[2][2][4][2];
#pragma unroll
    for (int a = 0; a < 2; ++a)
#pragma unroll
        for (int b = 0; b < 2; ++b)
#pragma unroll
            for (int m = 0; m < 4; ++m)
#pragma unroll
                for (int n = 0; n < 2; ++n) acc[a][b][m][n] = (f32x4){0.f, 0.f, 0.f, 0.f};
    bf16x8 At[4][2], B0[2][2], B1[2][2];
    const char* pA = (const char*)(cur.which ? g.A2 : g.A); const char* pB = (const char*)(cur.which ? g.Bt2 : g.Bt);
    unsigned cA = (unsigned)cur.pm * tstep, cB = (unsigned)cur.pn * tstep;
    S.a_ready(cur);
    {
        PG8_STAGE(PG8_SB(0, 0), pB, cB, voffB); PG8_STAGE(PG8_SB(0, 1), pB, cB + hstep, voffB); PG8_STAGE(PG8_SA(0, 0), pA, cA, voffA); PG8_STAGE(PG8_SA(0, 1), pA, cA + hstep, voffA);
        if (wr == 1) PG8_BAR;
        PG8_WAIT_V(2); PG8_BAR;
        PG8_STAGE(PG8_SB(1, 0), pB, cB + kstep, voffB); PG8_STAGE(PG8_SA(1, 0), pA, cA + kstep, voffA); PG8_STAGE(PG8_SB(1, 1), pB, cB + hstep + kstep, voffB);
        PG8_WAIT_V(6); PG8_BAR;
    }
    for (;;) {
        const bool has_next = S.next(ui + 1, nxt);
        const char* qA = has_next ? (const char*)(nxt.which ? g.A2 : g.A) : pA; const char* qB = has_next ? (const char*)(nxt.which ? g.Bt2 : g.Bt) : pB;
        const unsigned nA = has_next ? (unsigned)nxt.pm * tstep : cA, nB = has_next ? (unsigned)nxt.pn * tstep : cB;
        for (int t = 0; t < nt; t += 2) {
            const bool last = (t == nt - 2);
            const unsigned a1 = cA + (unsigned)(t + 1) * kstep;
            const char* rA = last ? qA : pA; const char* rB = last ? qB : pB;
            const unsigned a2 = last ? nA : cA + (unsigned)(t + 2) * kstep, b2 = last ? nB : cB + (unsigned)(t + 2) * kstep;
            const unsigned a3 = a2 + kstep, b3 = b2 + kstep;
            if (last && has_next) S.a_ready(nxt);
            PG8_LDB(B0, 0, 0); PG8_LDB(B1, 0, 1); PG8_SCHED; PG8_LDA(At, 0, 0); PG8_STAGE(PG8_SA(1, 1), pA, a1 + hstep, voffA);
            PG8_WAIT_V(8); PG8_WAIT_L(0); PG8_BAR; PG8_MMA(0, 0, At, B0); PG8_MMA(0, 1, At, B1); PG8_BAR; PG8_SCHED;
            PG8_LDA(At, 0, 1); PG8_STAGE(PG8_SB(0, 0), rB, b2, voffB); PG8_STAGE(PG8_SB(0, 1), rB, b2 + hstep, voffB); PG8_STAGE(PG8_SA(0, 0), rA, a2, voffA);
            PG8_WAIT_V(8); PG8_WAIT_L(0); PG8_BAR; PG8_MMA(1, 0, At, B0); PG8_MMA(1, 1, At, B1); PG8_BAR; PG8_SCHED;
            PG8_LDB(B0, 1, 0); PG8_LDB(B1, 1, 1); PG8_SCHED; PG8_LDA(At, 1, 0); PG8_STAGE(PG8_SA(0, 1), rA, a2 + hstep, voffA);
            PG8_WAIT_V(8); PG8_WAIT_L(0); PG8_BAR; PG8_MMA(0, 0, At, B0); PG8_MMA(0, 1, At, B1); PG8_BAR; PG8_SCHED;
            PG8_LDA(At, 1, 1); PG8_STAGE(PG8_SB(1, 0), rB, b3, voffB); PG8_STAGE(PG8_SB(1, 1), rB, b3 + hstep, voffB); PG8_STAGE(PG8_SA(1, 0), rA, a3, voffA);
            PG8_WAIT_V(8); PG8_WAIT_L(0); PG8_BAR; PG8_MMA(1, 0, At, B0); PG8_MMA(1, 1, At, B1); PG8_BAR; PG8_SCHED;
        }
        if constexpr (ALIGN_EPI) { if (wr == 0) PG8_BAR; }
        E(acc, cur, wr, wc, fr, fq); S.done(cur);
        if (!has_next) break;
#pragma unroll
        for (int a = 0; a < 2; ++a)
#pragma unroll
            for (int b = 0; b < 2; ++b)
#pragma unroll
                for (int m = 0; m < 4; ++m)
#pragma unroll
                    for (int n = 0; n < 2; ++n) acc[a][b][m][n] = (f32x4){0.f, 0.f, 0.f, 0.f};
        cur = nxt; cA = nA; cB = nB; pA = qA; pB = qB; ++ui;
        if constexpr (ALIGN_EPI) { if (wr == 1) PG8_BAR; }
    }
    PG8_WAIT_V(0);
    if constexpr (!ALIGN_EPI) { if (wr == 0) PG8_BAR; }
    PG8_BAR;
#undef PG8_SA
#undef PG8_SB
#undef PG8_STAGE
#undef PG8_LDA
#undef PG8_LDB
#undef PG8_MMA
#undef PG8_WAIT_V
#undef PG8_WAIT_L
#undef PG8_BAR
#undef PG8_SCHED
}
#endif
}

#define XB_TMO      128
#define XB_XCNT(j)  (256  + 64 * (j))
#define XB_XSUB(j)  (1280 + 64 * (j))
#define XB_XGEN(j)  (2304 + 64 * (j))
#define XB_TOP      3328
#define XB_TOPGEN   3392
#define XCD_BAR_WORDS 3456
#define XB_SPIN_CAP (1u << 20)
__device__ __forceinline__ unsigned xb_ld(unsigned* p)              { return __hip_atomic_load(p, __ATOMIC_RELAXED, __HIP_MEMORY_SCOPE_AGENT); }
__device__ __forceinline__ unsigned xb_add(unsigned* p, unsigned v) { return __hip_atomic_fetch_add(p, v, __ATOMIC_RELAXED, __HIP_MEMORY_SCOPE_AGENT); }
__device__ __forceinline__ unsigned xb_xcc_id() { return (unsigned)__builtin_amdgcn_s_getreg((3 << 11) | 20) & 0xFu; }
#define XB_SPIN(cond, bar) do { unsigned _sp = 0; while (cond) { __builtin_amdgcn_s_sleep(1); \
    if ((++_sp & 255u) == 0u) { if (xb_ld(&(bar)[XB_TMO])) break; if (_sp > XB_SPIN_CAP) { atomicAdd(&(bar)[XB_TMO], 1u); break; } } } } while (0)
struct XcdBarrier { unsigned* bar; unsigned x; volatile LAS unsigned* st; int wave; };
__device__ __forceinline__ XcdBarrier xcd_barrier_post(unsigned* bar, volatile LAS unsigned* st, int wave) {
    XcdBarrier b; b.bar = bar; b.x = xb_xcc_id(); b.st = st; b.wave = wave;
    if (wave == 0 && lane_id() == 0) st[4] = xb_add(&bar[XB_XCNT(b.x)], 1u);
    return b;
}
__device__ __forceinline__ void xcd_barrier_complete(unsigned* bar, unsigned x, unsigned& nloc, unsigned& nx, unsigned& regular) {
    const unsigned G = gridDim.x * gridDim.y * gridDim.z;
    unsigned sum, cnt, mine, low8, sp = 0u;
    for (;;) {
        sum = 0u; cnt = 0u; mine = 0u; low8 = 0u;
#pragma unroll
        for (unsigned j = 0; j < 16; ++j) { const unsigned c = xb_ld(&bar[XB_XCNT(j)]); sum += c; cnt += (c > 0u) ? 1u : 0u; mine = (j == x) ? c : mine; low8 += (j < 8u && c == 32u) ? 1u : 0u; }
        if (sum == G) break;
        __builtin_amdgcn_s_sleep(1);
        if ((++sp & 255u) == 0u) { if (xb_ld(&bar[XB_TMO])) break; if (sp > XB_SPIN_CAP) { atomicAdd(&bar[XB_TMO], 1u); break; } }
    }
    nloc = mine > 0u ? mine : 1u; nx = cnt > 0u ? cnt : 1u;
    regular = (G == 256u && sum == G && cnt == 8u && low8 == 8u) ? 1u : 0u;
}
__device__ __forceinline__ void xcd_barrier(const XcdBarrier& b) {
    asm volatile("s_waitcnt vmcnt(0)" ::: "memory");
    __syncthreads();
    if (b.wave == 0 && lane_id() == 0) {
        unsigned* bar = b.bar;
        __builtin_amdgcn_s_waitcnt(0);
        unsigned nloc = b.st[0], nx = b.st[1];
        if (nloc == 0u) { unsigned reg; xcd_barrier_complete(bar, b.x, nloc, nx, reg); b.st[0] = nloc; b.st[1] = nx; b.st[2] = reg; }
        const unsigned old = xb_add(&bar[XB_XSUB(b.x)], 1u);
        const unsigned gen = old / nloc;
        if (old + 1u == (gen + 1u) * nloc) {
            __builtin_amdgcn_fence(__ATOMIC_RELEASE, "agent");
            asm volatile("s_waitcnt vmcnt(0)" ::: "memory");
            const unsigned og = xb_add(&bar[XB_TOP], 1u);
            const unsigned tg = og / nx;
            __builtin_amdgcn_fence(__ATOMIC_ACQUIRE, "agent");
            if (og + 1u == (tg + 1u) * nx) xb_add(&bar[XB_TOPGEN], 1u);
            else XB_SPIN(xb_ld(&bar[XB_TOPGEN]) == tg, bar);
            xb_add(&bar[XB_XGEN(b.x)], 1u);
            asm volatile("s_waitcnt vmcnt(0)" ::: "memory");
        } else {
            __builtin_amdgcn_fence(__ATOMIC_ACQUIRE, "agent");
            asm volatile("s_waitcnt vmcnt(0)" ::: "memory");
            XB_SPIN(xb_ld(&bar[XB_XGEN(b.x)]) == gen, bar);
        }
    }
    __syncthreads();
}

#define XB_LSUB(j)  (3520 + 64 * (j))
__device__ __forceinline__ void xcd_local_barrier(const XcdBarrier& b) {
    asm volatile("s_waitcnt vmcnt(0)" ::: "memory");
    __syncthreads();
    if (b.wave == 0 && lane_id() == 0) {
        unsigned* bar = b.bar;
        __builtin_amdgcn_s_waitcnt(0);
        const unsigned nloc = b.st[0];
        const unsigned old = xb_add(&bar[XB_LSUB(b.x)], 1u);
        const unsigned tgt = (old / nloc + 1u) * nloc;
        __builtin_amdgcn_fence(__ATOMIC_ACQUIRE, "agent");
        asm volatile("s_waitcnt vmcnt(0)" ::: "memory");
        XB_SPIN(xb_ld(&bar[XB_LSUB(b.x)]) < tgt, bar);
    }
    __syncthreads();
}

struct Args { const float* in[14]; float* out; unsigned char* ws; int ph_lo, ph_hi; };
struct Ctx {
    LAS unsigned char* lds;
    int tid, lane, wave, G, gw, NGW;
    int reg, xcc, rank;
    const float *x, *meta, *g1, *w_in, *conv_w, *w_a, *w_b, *w_out, *g2, *w_q, *subk, *pu, *pv, *gf;
    float* out; unsigned char* ws;
};

__device__ __forceinline__ float one_or(const float* s, int i) { return s ? s[i] : 1.0f; }
template <bool F16>
__device__ __forceinline__ void p0_transpose_item(const float* W, int K, int N, const float* scale, u16* WT, int scol0, int drow0, int k0, LAS float* scr, int lane, float mul = 1.0f) {
#pragma unroll
    for (int i = 0; i < 32; ++i) { const int kk = 2 * i + (lane >> 5); scr[kk * 33 + (lane & 31)] = W[(size_t)(k0 + kk) * N + scol0 + (lane & 31)] * (one_or(scale, k0 + kk) * mul); }
    asm volatile("s_waitcnt lgkmcnt(0)" ::: "memory");
    const int c = lane & 7;
#pragma unroll
    for (int j = 0; j < 4; ++j) { const int n = (lane >> 3) + 8 * j; const LAS float* s = scr + (8 * c) * 33 + n;
        u32x4 o;
        if (F16) { o.x = pk2h(s[0 * 33], s[1 * 33]); o.y = pk2h(s[2 * 33], s[3 * 33]); o.z = pk2h(s[4 * 33], s[5 * 33]); o.w = pk2h(s[6 * 33], s[7 * 33]); }
        else { o.x = pk2bf(s[0 * 33], s[1 * 33]); o.y = pk2bf(s[2 * 33], s[3 * 33]); o.z = pk2bf(s[4 * 33], s[5 * 33]); o.w = pk2bf(s[6 * 33], s[7 * 33]); }
        *(u32x4*)(WT + (size_t)(drow0 + n) * K + k0 + 8 * c) = o; }
    asm volatile("s_waitcnt lgkmcnt(0)" ::: "memory");
}
__device__ __forceinline__ void p0_transpose_item8(const float* W, int K, int N, const float* scale, float mul, unsigned char* WT8, int scol0, int drow0, int k0, LAS float* scr, int lane) {
#pragma unroll
    for (int i = 0; i < 32; ++i) { const int kk = 2 * i + (lane >> 5); scr[kk * 33 + (lane & 31)] = W[(size_t)(k0 + kk) * N + scol0 + (lane & 31)] * (mul * one_or(scale, k0 + kk)); }
    asm volatile("s_waitcnt lgkmcnt(0)" ::: "memory");
    const int n = lane & 31, hf = lane >> 5; const LAS float* s = scr + (32 * hf) * 33 + n;
    unsigned w[8];
#pragma unroll
    for (int j = 0; j < 8; ++j) w[j] = (unsigned)__builtin_amdgcn_cvt_pk_fp8_f32(s[(4 * j + 2) * 33], s[(4 * j + 3) * 33], __builtin_amdgcn_cvt_pk_fp8_f32(s[(4 * j) * 33], s[(4 * j + 1) * 33], 0, false), true);
    u32x4* op = (u32x4*)(WT8 + (size_t)(drow0 + n) * K + k0 + 32 * hf);
    op[0] = (u32x4){w[0], w[1], w[2], w[3]}; op[1] = (u32x4){w[4], w[5], w[6], w[7]};
    asm volatile("s_waitcnt lgkmcnt(0)" ::: "memory");
}
template <int KR> __device__ __forceinline__ void tr_load(const float* W, int N, int scol0, int k0, int lane, float (&t)[KR / 2]) {
#pragma unroll
    for (int i = 0; i < KR / 2; ++i) t[i] = __builtin_nontemporal_load(&W[(size_t)(k0 + 2 * i + (lane >> 5)) * N + scol0 + (lane & 31)]);
}
template <int KR, int FMT> __device__ __forceinline__ void tr_finish(const float (&t)[KR / 2], const float* scale, float mul, void* WT, int ldk, int drow0, int k0, LAS float* scr, int lane) {
#pragma unroll
    for (int i = 0; i < KR / 2; ++i) scr[(2 * i + (lane >> 5)) * 33 + (lane & 31)] = t[i];
    asm volatile("s_waitcnt lgkmcnt(0)" ::: "memory");
    if constexpr (FMT != 2) {
        constexpr int NJ = KR / 16;
        const int c = lane & (KR / 8 - 1), nl = lane / (KR / 8);
        f32x4 ga = {mul, mul, mul, mul}, gb = ga; if (scale) { ga = *(const f32x4*)(scale + k0 + 8 * c) * mul; gb = *(const f32x4*)(scale + k0 + 8 * c + 4) * mul; }
#pragma unroll
        for (int j = 0; j < NJ; ++j) { const int n = nl + (512 / KR) * j; const LAS float* s = scr + (8 * c) * 33 + n;
            u32x4 o;
            if constexpr (FMT == 1) { o.x = pk2h(s[0 * 33] * ga.x, s[1 * 33] * ga.y); o.y = pk2h(s[2 * 33] * ga.z, s[3 * 33] * ga.w); o.z = pk2h(s[4 * 33] * gb.x, s[5 * 33] * gb.y); o.w = pk2h(s[6 * 33] * gb.z, s[7 * 33] * gb.w); }
            else { o.x = pk2bf(s[0 * 33] * ga.x, s[1 * 33] * ga.y); o.y = pk2bf(s[2 * 33] * ga.z, s[3 * 33] * ga.w); o.z = pk2bf(s[4 * 33] * gb.x, s[5 * 33] * gb.y); o.w = pk2bf(s[6 * 33] * gb.z, s[7 * 33] * gb.w); }
            *(u32x4*)((u16*)WT + (size_t)(drow0 + n) * ldk + k0 + 8 * c) = o; }
    } else {
        constexpr int KL = KR / 2;
        const int n = lane & 31, hf = lane >> 5; const LAS float* s = scr + (KL * hf) * 33 + n;
        unsigned w[KL / 4];
#pragma unroll
        for (int j = 0; j < KL / 4; ++j) { const f32x4 gq = *(const f32x4*)(scale + k0 + KL * hf + 4 * j) * mul;
            w[j] = (unsigned)__builtin_amdgcn_cvt_pk_fp8_f32(s[(4 * j + 2) * 33] * gq.z, s[(4 * j + 3) * 33] * gq.w, __builtin_amdgcn_cvt_pk_fp8_f32(s[(4 * j) * 33] * gq.x, s[(4 * j + 1) * 33] * gq.y, 0, false), true); }
        unsigned char* op = (unsigned char*)WT + (size_t)(drow0 + n) * ldk + k0 + KL * hf;
        if constexpr (KL == 32) { ((u32x4*)op)[0] = (u32x4){w[0], w[1], w[2], w[3]}; ((u32x4*)op)[1] = (u32x4){w[4], w[5], w[6], w[7]}; }
        else { *(u32x2*)op = (u32x2){w[0], w[1]}; }
    }
    asm volatile("s_waitcnt lgkmcnt(0)" ::: "memory");
}
__device__ __forceinline__ int w1_srccol(int n) {
    if (n < 512 || n >= 1536) return n;
    const int t = (n - 512) >> 8, r = (n - 512) & 255;
    return r < 128 ? 512 + 128 * t + r : 1024 + 128 * t + (r - 128);
}

__device__ __forceinline__ void phase0(Ctx& F) {
    f32x4 xv[4][4]; int xr[4];
#pragma unroll
    for (int u = 0; u < 4; ++u) { xr[u] = min(F.gw + u * F.NGW, M - 1); const f32x4* xp = (const f32x4*)(F.x + (size_t)xr[u] * D) + F.lane;
#pragma unroll
        for (int j = 0; j < 4; ++j) xv[u][j] = __builtin_nontemporal_load(xp + 64 * j); }
    const bool trfast = F.NGW == 2048;
    float tA[32], tB[8];
    const int itA = F.gw, kbA = itA / 160, nbA = itA % 160, itB = 2048 + (F.gw >> 2), kbB = itB / 160, nbB = itB % 160, k0B = kbB * 64 + 16 * (F.gw & 3);
    if (trfast) { tr_load<64>(F.w_in, INW, nbA < 96 ? w1_srccol(nbA * 32) : nbA * 32, kbA * 64, F.lane, tA); tr_load<16>(F.w_in, INW, nbB < 96 ? w1_srccol(nbB * 32) : nbB * 32, k0B, F.lane, tB); }
    {
        LAS float* mn = (LAS float*)F.lds;
        LAS float* red = (LAS float*)(F.lds + 67584);
        {
            const int r = F.wave * 2; float va[16], vb[16], gg[16]; float sa = 0.f, sb = 0.f;
#pragma unroll
            for (int j = 0; j < 16; ++j) { va[j] = F.meta[r * D + j * 64 + F.lane]; vb[j] = F.meta[(r + 1) * D + j * 64 + F.lane]; gg[j] = F.g1[j * 64 + F.lane]; }
#pragma unroll
            for (int j = 0; j < 16; ++j) { sa += va[j] * va[j]; sb += vb[j] * vb[j]; }
            const float ra = __builtin_amdgcn_rsqf(wave_sum_dpp(sa) * (1.0f / D) + EPS), rb = __builtin_amdgcn_rsqf(wave_sum_dpp(sb) * (1.0f / D) + EPS);
#pragma unroll
            for (int j = 0; j < 16; ++j) { const int k = j * 64 + F.lane; *(LAS f32x2*)(mn + k * 16 + (k >> 4) * 4 + r) = (f32x2){va[j] * ra * gg[j], vb[j] * rb * gg[j]}; }
        }
        __syncthreads();
        bf16_t* MK = (bf16_t*)(F.ws + WS_META); bf16_t* MV = MK + 16 * 512; float* MCA = (float*)(MV + 16 * 512); float* MUA = MCA + 16 * 512;
        for (int cgx = blockIdx.x; cgx < 256; cgx += F.G) {
            const int cg = (cgx & 7) * 32 + (cgx >> 3);
            const int j = F.tid & 7, kq = F.tid >> 3;
            const int gc = cg * 8 + j, which = gc >> 9, cc = gc & 511;
            const int scol = which == 0 ? 2048 + cc : which == 1 ? 2560 + cc : which == 2 ? 512 + cc : 1024 + cc;
            float wv[16];
#pragma unroll
            for (int kk = 0; kk < 16; ++kk) wv[kk] = F.w_in[(size_t)(kq * 16 + kk) * INW + scol];
            float acc[16];
#pragma unroll
            for (int r = 0; r < 16; ++r) acc[r] = 0.f;
#pragma unroll
            for (int kk = 0; kk < 16; ++kk) {
#pragma unroll
                for (int r4 = 0; r4 < 4; ++r4) { const f32x4 mv = *(const LAS f32x4*)(mn + (kq * 16 + kk) * 16 + kq * 4 + r4 * 4);
                    acc[r4 * 4 + 0] += mv.x * wv[kk]; acc[r4 * 4 + 1] += mv.y * wv[kk]; acc[r4 * 4 + 2] += mv.z * wv[kk]; acc[r4 * 4 + 3] += mv.w * wv[kk]; }
            }
#pragma unroll
            for (int r = 0; r < 16; ++r) red[(kq * 16 + r) * 8 + kq * 8 + j] = acc[r];
            __syncthreads();
            if (F.tid < 128) {
                const int r = F.tid >> 3, jj = F.tid & 7; float sm = 0.f;
                for (int q = 0; q < 64; ++q) sm += red[(q * 16 + r) * 8 + q * 8 + jj];
                const int gc2 = cg * 8 + jj, wh = gc2 >> 9, c2 = gc2 & 511;
                if (wh == 0) { MK[r * 512 + c2] = (bf16_t)f2bf(sm); bf16_t* KU = (bf16_t*)(F.ws + WS_KU);
                    for (int b = 0; b < NB; ++b) KU[((size_t)(b * NH + (c2 >> 6)) * LP + 16 + r) * HD + (c2 & 63)] = (bf16_t)f2bf(sm); }
                else if (wh == 1) { MV[r * 512 + c2] = (bf16_t)f2bf(sm); bf16_t* VT = (bf16_t*)(F.ws + WS_VT);
                    for (int b = 0; b < NB; ++b) VT[((size_t)(b * NH + (c2 >> 6)) * HD + (c2 & 63)) * LP + 16 + r] = (bf16_t)f2bf(sm); }
                else if (wh == 2) MCA[r * 512 + c2] = sm; else MUA[r * 512 + c2] = sm;
            }
            __syncthreads();
        }
    }
    {
        bf16_t* KU = (bf16_t*)(F.ws + WS_KU); bf16_t* VT = (bf16_t*)(F.ws + WS_VT);
        for (int i = blockIdx.x * NTHR + F.tid; i < 64 * 16 * 64; i += F.G * NTHR) {
            const int bh = i >> 10, rr = (i >> 6) & 15, dd = i & 63;
            KU[((size_t)bh * LP + rr) * HD + dd] = 0; VT[((size_t)bh * HD + dd) * LP + rr] = 0;
        }
    }
    {
        LAS float* scr = (LAS float*)(F.lds + F.wave * 16384);
        constexpr int I1 = 16 * 160;
        if (trfast) {
            if (nbA < 96) tr_finish<64, 0>(tA, F.g1, 1.0f, F.ws + WS_W1T, D, nbA * 32, kbA * 64, scr, F.lane); else tr_finish<64, 2>(tA, F.g1, GATE_WSCALE, F.ws + WS_WG8, D, (nbA - 96) * 32, kbA * 64, scr, F.lane);
            if (nbB < 96) tr_finish<16, 0>(tB, F.g1, 1.0f, F.ws + WS_W1T, D, nbB * 32, k0B, scr, F.lane); else tr_finish<16, 2>(tB, F.g1, GATE_WSCALE, F.ws + WS_WG8, D, (nbB - 96) * 32, k0B, scr, F.lane);
        } else
        for (int it = F.gw; it < I1; it += F.NGW) { const int kb = it / 160, nb = it % 160;
            if (nb < 96) p0_transpose_item<false>(F.w_in, D, INW, F.g1, (u16*)(F.ws + WS_W1T), w1_srccol(nb * 32), nb * 32, kb * 64, scr, F.lane);
            else p0_transpose_item8(F.w_in, D, INW, F.g1, GATE_WSCALE, F.ws + WS_WG8, nb * 32, (nb - 96) * 32, kb * 64, scr, F.lane); }
    }
    {
        bf16_t* XN = (bf16_t*)(F.ws + WS_A); unsigned char* XN8 = F.ws + WS_X18;
        for (int m0 = F.gw; m0 < M; m0 += 4 * F.NGW) {
            f32x4 v[4][4]; int mr[4];
#pragma unroll
            for (int u = 0; u < 4; ++u) {
#pragma unroll
                for (int j = 0; j < 4; ++j) v[u][j] = xv[u][j];
                mr[u] = xr[u]; }
            const int m1 = m0 + 4 * F.NGW;
            if (m1 < M) {
#pragma unroll
                for (int u = 0; u < 4; ++u) { xr[u] = min(m1 + u * F.NGW, M - 1); const f32x4* xp = (const f32x4*)(F.x + (size_t)xr[u] * D) + F.lane;
#pragma unroll
                    for (int j = 0; j < 4; ++j) xv[u][j] = __builtin_nontemporal_load(xp + 64 * j); }
            }
#pragma unroll
            for (int u = 0; u < 4; ++u) {
                float s = 0.f;
#pragma unroll
                for (int j = 0; j < 4; ++j) s += (v[u][j].x * v[u][j].x + v[u][j].y * v[u][j].y) + (v[u][j].z * v[u][j].z + v[u][j].w * v[u][j].w);
                const float rstd = __builtin_amdgcn_rsqf(wave_sum_dpp(s) * (1.0f / D) + EPS);
                u32x2* o8 = (u32x2*)(XN + (size_t)mr[u] * D) + F.lane; unsigned* o4 = (unsigned*)(XN8 + (size_t)mr[u] * D) + F.lane; const float r8 = rstd * XN8_SCALE;
#pragma unroll
                for (int j = 0; j < 4; ++j) { u32x2 o; o.x = pk2bf(v[u][j].x * rstd, v[u][j].y * rstd); o.y = pk2bf(v[u][j].z * rstd, v[u][j].w * rstd); o8[64 * j] = o;
                    o4[64 * j] = (unsigned)__builtin_amdgcn_cvt_pk_fp8_f32(v[u][j].z * r8, v[u][j].w * r8, __builtin_amdgcn_cvt_pk_fp8_f32(v[u][j].x * r8, v[u][j].y * r8, 0, false), true); }
            }
        }
    }
}
struct LateItem { const float* W; const float* scale; u16* WT; int K, N, kb, nb, f16; float mul; };
__device__ __forceinline__ LateItem late_item(Ctx& F, int it) {
    constexpr int IA = 8 * 32, IB = 8 * 32, IO = 16 * 32;
    LateItem L; int r = it;
    if (r < IA) { L = LateItem{F.w_a, nullptr, (u16*)(F.ws + WS_WAT), CW, D, r / 32, r % 32, 0, 1.0f}; return L; } r -= IA;
    if (r < IB) { L = LateItem{F.w_b, nullptr, (u16*)(F.ws + WS_WBT), CW, D, r / 32, r % 32, 0, 1.0f}; return L; } r -= IB;
    if (r < IO) { L = LateItem{F.w_out, nullptr, (u16*)(F.ws + WS_WOT), D, D, r / 32, r % 32, 0, GATE_U8_SCALE}; return L; } r -= IO;
    L = LateItem{F.w_q, F.g2, (u16*)(F.ws + WS_WQT), D, 2048, r / 64, r % 64, 1, 1.0f}; return L;
}
__device__ __forceinline__ void late_load(Ctx& F, float (&t)[32], f32x4& sk) {
    const LateItem L = late_item(F, F.gw);
    tr_load<64>(L.W, L.N, L.nb * 32, L.kb * 64, F.lane, t);
    const int gt = blockIdx.x * NTHR + F.tid; sk = ((const f32x4*)F.subk)[min(gt, 16 * 128 * 128 / 4 - 1)];
}
__device__ __forceinline__ void late_finish(Ctx& F, const float (&t)[32], const f32x4& sk) {
    LAS float* scr = (LAS float*)(F.lds + 65536 + F.wave * 8448);
    const LateItem L = late_item(F, F.gw);
    if (L.f16) tr_finish<64, 1>(t, L.scale, L.mul, L.WT, L.K, L.nb * 32, L.kb * 64, scr, F.lane); else tr_finish<64, 0>(t, L.scale, L.mul, L.WT, L.K, L.nb * 32, L.kb * 64, scr, F.lane);
    const int gt = blockIdx.x * NTHR + F.tid;
    if (gt < 16 * 128 * 128 / 4) { u32x2 o; o.x = pk2h(sk.x, sk.y); o.y = pk2h(sk.z, sk.w); ((u32x2*)(F.ws + WS_SKB))[gt] = o; }
}
__device__ __forceinline__ void convert_weights_late(Ctx& F) {
    LAS float* scr = (LAS float*)(F.lds + 65536 + F.wave * 8448);
    constexpr int IA = 8 * 32, IB = 8 * 32, IO = 16 * 32, IQ = 16 * 64, NIT = IA + IB + IO + IQ;
    for (int it = F.gw; it < NIT; it += F.NGW) {
        int r = it;
        if (r < IA) { const int kb = r / 32, nb = r % 32; p0_transpose_item<false>(F.w_a, CW, D, nullptr, (u16*)(F.ws + WS_WAT), nb * 32, nb * 32, kb * 64, scr, F.lane); continue; } r -= IA;
        if (r < IB) { const int kb = r / 32, nb = r % 32; p0_transpose_item<false>(F.w_b, CW, D, nullptr, (u16*)(F.ws + WS_WBT), nb * 32, nb * 32, kb * 64, scr, F.lane); continue; } r -= IB;
        if (r < IO) { const int kb = r / 32, nb = r % 32; p0_transpose_item<false>(F.w_out, D, D, nullptr, (u16*)(F.ws + WS_WOT), nb * 32, nb * 32, kb * 64, scr, F.lane, GATE_U8_SCALE); continue; } r -= IO;
        { const int kb = r / 64, nb = r % 64; p0_transpose_item<true>(F.w_q, D, 2048, F.g2, (u16*)(F.ws + WS_WQT), nb * 32, nb * 32, kb * 64, scr, F.lane); }
    }
    const int gt = blockIdx.x * NTHR + F.tid, NT = F.G * NTHR;
    f16_t* SKB = (f16_t*)(F.ws + WS_SKB);
    for (int i = gt; i < 16 * 128 * 128 / 4; i += NT) { const f32x4 v = ((const f32x4*)F.subk)[i]; u32x2 o; o.x = pk2h(v.x, v.y); o.y = pk2h(v.z, v.w); ((u32x2*)SKB)[i] = o; }
}
__device__ __forceinline__ unsigned fp4_code(float x, float inv) {
    const float a = fabsf(x) * inv;
    const unsigned idx = (unsigned)(a >= 0.25f) + (unsigned)(a >= 0.75f) + (unsigned)(a >= 1.25f) + (unsigned)(a >= 1.75f) + (unsigned)(a >= 2.5f) + (unsigned)(a >= 3.5f) + (unsigned)(a >= 5.0f);
    return idx | (x < 0.f ? 8u : 0u);
}
__device__ __forceinline__ float clamp6(float x) { return __builtin_fminf(__builtin_fmaxf(x, -6.0f), 6.0f); }
__device__ __forceinline__ unsigned fp4_pack8(f32x4 a, f32x4 b, float inv) {
    unsigned w = 0;
    w = __builtin_amdgcn_cvt_scalef32_pk_fp4_f32(w, clamp6(a.x * inv), clamp6(a.y * inv), 1.0f, 0);
    w = __builtin_amdgcn_cvt_scalef32_pk_fp4_f32(w, clamp6(a.z * inv), clamp6(a.w * inv), 1.0f, 1);
    w = __builtin_amdgcn_cvt_scalef32_pk_fp4_f32(w, clamp6(b.x * inv), clamp6(b.y * inv), 1.0f, 2);
    w = __builtin_amdgcn_cvt_scalef32_pk_fp4_f32(w, clamp6(b.z * inv), clamp6(b.w * inv), 1.0f, 3);
    return w;
}
__device__ __forceinline__ float wave_max(float v) {
    v = fmaxf(v, __builtin_bit_cast(float, __builtin_amdgcn_update_dpp(0, __builtin_bit_cast(int, v), 0xB1, 0xf, 0xf, true)));
    v = fmaxf(v, __builtin_bit_cast(float, __builtin_amdgcn_update_dpp(0, __builtin_bit_cast(int, v), 0x4E, 0xf, 0xf, true)));
    v = fmaxf(v, __builtin_bit_cast(float, __builtin_amdgcn_update_dpp(0, __builtin_bit_cast(int, v), 0x141, 0xf, 0xf, true)));
    v = fmaxf(v, __builtin_bit_cast(float, __builtin_amdgcn_update_dpp(0, __builtin_bit_cast(int, v), 0x140, 0xf, 0xf, true)));
    const int b = __builtin_bit_cast(int, v);
    return fmaxf(fmaxf(__builtin_bit_cast(float, __builtin_amdgcn_readlane(b, 0)), __builtin_bit_cast(float, __builtin_amdgcn_readlane(b, 16))), fmaxf(__builtin_bit_cast(float, __builtin_amdgcn_readlane(b, 32)), __builtin_bit_cast(float, __builtin_amdgcn_readlane(b, 48))));
}
__device__ __forceinline__ void convert_tables(Ctx& F) {
    unsigned char* U4 = F.ws + WS_T; unsigned char* V4 = F.ws + WS_T + 8 * MiB; float* SU = (float*)(F.ws + WS_T + 16 * MiB); float* SV = SU + NEXP;
    f32x4 g[4];
#pragma unroll
    for (int j = 0; j < 4; ++j) g[j] = *(const f32x4*)(F.g2 + 256 * j + 4 * F.lane);
    for (int t0 = F.gw; t0 < 2 * NEXP; t0 += 4 * F.NGW) {
        f32x4 v[4][4];
#pragma unroll
        for (int u = 0; u < 4; ++u) { const int t = min(t0 + u * F.NGW, 2 * NEXP - 1); const float* src = (t < NEXP ? F.pu : F.pv) + (size_t)(t & (NEXP - 1)) * D + 4 * F.lane;
#pragma unroll
            for (int j = 0; j < 4; ++j) v[u][j] = __builtin_nontemporal_load((const f32x4*)(src + 256 * j)); }
#pragma unroll
        for (int u = 0; u < 4; ++u) {
            const int t = t0 + u * F.NGW; const bool isu = t < NEXP; const int row = t & (NEXP - 1);
            float m = 0.f;
#pragma unroll
            for (int j = 0; j < 4; ++j) { if (isu) v[u][j] = v[u][j] * g[j]; m = fmaxf(m, fmaxf(fmaxf(fabsf(v[u][j].x), fabsf(v[u][j].y)), fmaxf(fabsf(v[u][j].z), fabsf(v[u][j].w)))); }
            m = fmaxf(wave_max(m), 1.0e-30f);
            const float sc = m * 0.125f, inv = 8.0f * __builtin_amdgcn_rcpf(m);
            if (t < 2 * NEXP) {
                unsigned char* dst = (isu ? U4 : V4) + (size_t)row * 128 + 2 * F.lane;
#pragma unroll
                for (int j = 0; j < 4; ++j) { unsigned w = 0;
                    w = __builtin_amdgcn_cvt_scalef32_pk_fp4_f32(w, v[u][j].x * inv, v[u][j].y * inv, 1.0f, 0);
                    w = __builtin_amdgcn_cvt_scalef32_pk_fp4_f32(w, v[u][j].z * inv, v[u][j].w * inv, 1.0f, 1);
                    *(u16*)(dst + (size_t)j * (NEXP * 128)) = (u16)w; }
                if (F.lane == 0) (isu ? SU : SV)[row] = sc;
            }
        }
    }
}

__device__ __forceinline__ u32x4 pack8bf(f32x4 a, f32x4 b) { u32x4 w; w.x = pk2bf(a.x, a.y); w.y = pk2bf(a.z, a.w); w.z = pk2bf(b.x, b.y); w.w = pk2bf(b.z, b.w); return w; }
__device__ __forceinline__ u32x4 pack8h(f32x4 a, f32x4 b) { u32x4 w; w.x = pk2h(a.x, a.y); w.y = pk2h(a.z, a.w); w.z = pk2h(b.x, b.y); w.w = pk2h(b.z, b.w); return w; }
__device__ __forceinline__ void unpack8bf(u32x4 w, f32x4& a, f32x4& b) { a = (f32x4){bflo(w.x), bfhi(w.x), bflo(w.y), bfhi(w.y)}; b = (f32x4){bflo(w.z), bfhi(w.z), bflo(w.w), bfhi(w.w)}; }
__device__ __forceinline__ unsigned sig4u8(f32x4 v) {
    unsigned w = 0u;
    w = __builtin_amdgcn_cvt_pk_u8_f32(sigmoidf_(v.x) * 255.f, 0, w); w = __builtin_amdgcn_cvt_pk_u8_f32(sigmoidf_(v.y) * 255.f, 1, w);
    w = __builtin_amdgcn_cvt_pk_u8_f32(sigmoidf_(v.z) * 255.f, 2, w); w = __builtin_amdgcn_cvt_pk_u8_f32(sigmoidf_(v.w) * 255.f, 3, w);
    return w; }
__device__ __forceinline__ unsigned sig4u8k(f32x4 a, float k) {
    unsigned w = 0u;
    constexpr float c = 1.0f / 255.0f, lc = -7.994353436858858f;
    w = __builtin_amdgcn_cvt_pk_u8_f32(__builtin_amdgcn_rcpf(c + __builtin_amdgcn_exp2f(__builtin_fmaf(a.x, k, lc))), 0, w); w = __builtin_amdgcn_cvt_pk_u8_f32(__builtin_amdgcn_rcpf(c + __builtin_amdgcn_exp2f(__builtin_fmaf(a.y, k, lc))), 1, w);
    w = __builtin_amdgcn_cvt_pk_u8_f32(__builtin_amdgcn_rcpf(c + __builtin_amdgcn_exp2f(__builtin_fmaf(a.z, k, lc))), 2, w); w = __builtin_amdgcn_cvt_pk_u8_f32(__builtin_amdgcn_rcpf(c + __builtin_amdgcn_exp2f(__builtin_fmaf(a.w, k, lc))), 3, w);
    return w; }
__device__ __forceinline__ f32x4 u8x4f(unsigned w) { return (f32x4){(float)(w & 0xffu), (float)((w >> 8) & 0xffu), (float)((w >> 16) & 0xffu), (float)(w >> 24)}; }
__device__ __forceinline__ f32x4 sig4(f32x4 v) { return (f32x4){sigmoidf_(v.x), sigmoidf_(v.y), sigmoidf_(v.z), sigmoidf_(v.w)}; }

struct Epi1 {
    bf16_t *BA, *CU, *Q, *K, *V;
    __device__ __forceinline__ void operator()(int row, int col, int pn, int wc, f32x4 l0, f32x4 l1, f32x4 h0, f32x4 h1) const {
        if (pn < 2) { bf16_t* p = BA + (size_t)row * CW + col; *(u32x4*)p = pack8bf(l0, l1); *(u32x4*)(p + 128) = pack8bf(h0, h1); }
        else if (pn < 6) { bf16_t* p = CU + (size_t)row * CW + (pn - 2) * 128 + (col & 255); *(u32x4*)p = pack8bf(l0 * h0, l1 * h1); }
        else if (pn < 8) { bf16_t* p = Q + (size_t)row * CW + (col - 1536); *(u32x4*)p = pack8bf(l0 * QSCALE, l1 * QSCALE); *(u32x4*)(p + 128) = pack8bf(h0 * QSCALE, h1 * QSCALE); }
        else if (pn < 10) { const int c = col - 2048, b = row >> 11, t = row & (SEQ - 1);
            *(u32x4*)(K + ((size_t)(b * NH + (c >> 6)) * LP + 32 + t) * HD + (c & 63)) = pack8bf(l0, l1);
            *(u32x4*)(K + ((size_t)(b * NH + ((c + 128) >> 6)) * LP + 32 + t) * HD + (c & 63)) = pack8bf(h0, h1); }
        else { const int c = col - 2560, b = row >> 11, t = row & (SEQ - 1);
            bf16_t* p0 = V + ((size_t)(b * NH + (c >> 6)) * HD + (c & 63)) * LP + 32 + t; bf16_t* p1 = V + ((size_t)(b * NH + ((c + 128) >> 6)) * HD + (c & 63)) * LP + 32 + t;
            const u32x4 wl = pack8bf(l0, l1), wh = pack8bf(h0, h1);
            p0[0] = (bf16_t)(wl.x & 0xffffu); p0[LP] = (bf16_t)(wl.x >> 16); p0[2 * LP] = (bf16_t)(wl.y & 0xffffu); p0[3 * LP] = (bf16_t)(wl.y >> 16);
            p0[4 * LP] = (bf16_t)(wl.z & 0xffffu); p0[5 * LP] = (bf16_t)(wl.z >> 16); p0[6 * LP] = (bf16_t)(wl.w & 0xffffu); p0[7 * LP] = (bf16_t)(wl.w >> 16);
            p1[0] = (bf16_t)(wh.x & 0xffffu); p1[LP] = (bf16_t)(wh.x >> 16); p1[2 * LP] = (bf16_t)(wh.y & 0xffffu); p1[3 * LP] = (bf16_t)(wh.y >> 16);
            p1[4 * LP] = (bf16_t)(wh.z & 0xffffu); p1[5 * LP] = (bf16_t)(wh.z >> 16); p1[6 * LP] = (bf16_t)(wh.w & 0xffffu); p1[7 * LP] = (bf16_t)(wh.w >> 16); }
    }
};
struct Epi1g {
    unsigned char *SGA, *SGB;
    __device__ __forceinline__ void operator()(int row, int col, int pn, int wc, f32x4 l0, f32x4 l1, f32x4 h0, f32x4 h1) const {
        constexpr float r = 1.0f / (GATE_WSCALE * XN8_SCALE);
        unsigned char* p = (pn < 4 ? SGA : SGB) + (size_t)row * D + (col & 1023); u32x2 a, b; constexpr float kk = -1.4426950408889634f * r; a.x = sig4u8k(l0, kk); a.y = sig4u8k(l1, kk); b.x = sig4u8k(h0, kk); b.y = sig4u8k(h1, kk); *(u32x2*)p = a; *(u32x2*)(p + 128) = b;
    }
};
struct EpiNull { float* sink; __device__ __forceinline__ void operator()(int row, int col, int pn, int wc, f32x4 l0, f32x4 l1, f32x4 h0, f32x4 h1) const { const f32x4 t = l0 + l1 + h0 + h1; if (t.x == 1234.5f) sink[0] = t.y; } };
struct Epi3a {
    bf16_t* MIX; const unsigned char* SGA; const unsigned char* SGB;
    __device__ __forceinline__ void operator()(int row, int col, int pn, int wc, f32x4 l0, f32x4 l1, f32x4 h0, f32x4 h1) const {
        const bool add = pn >= 64;
        bf16_t* p = MIX + (size_t)row * D + col; const unsigned char* s = (add ? SGB : SGA) + (size_t)row * D + col;
        const u32x2 ga = *(const u32x2*)s, gb = *(const u32x2*)(s + 128);
        l0 = l0 * u8x4f(ga.x); l1 = l1 * u8x4f(ga.y); h0 = h0 * u8x4f(gb.x); h1 = h1 * u8x4f(gb.y);
        if (add) { f32x4 a, b, c, d; unpack8bf(*(const u32x4*)p, a, b); unpack8bf(*(const u32x4*)(p + 128), c, d); l0 += a; l1 += b; h0 += c; h1 += d; }
        *(u32x4*)p = pack8bf(l0, l1); *(u32x4*)(p + 128) = pack8bf(h0, h1);
    }
};
struct Epi3b {
    const float* x; f16_t* X1H; float* SS2; unsigned char* X18;
    __device__ __forceinline__ void operator()(int row, int col, int pn, int wc, f32x4 l0, f32x4 l1, f32x4 h0, f32x4 h1) const {
        const float* xp = x + (size_t)row * D + col; f16_t* hp = X1H + (size_t)row * D + col;
        l0 += __builtin_nontemporal_load((const f32x4*)xp); l1 += __builtin_nontemporal_load((const f32x4*)(xp + 4)); h0 += __builtin_nontemporal_load((const f32x4*)(xp + 128)); h1 += __builtin_nontemporal_load((const f32x4*)(xp + 132));
        *(u32x4*)hp = pack8h(l0, l1); *(u32x4*)(hp + 128) = pack8h(h0, h1);
        { unsigned char* bp = X18 + (size_t)row * D + col; u32x2 a, b; const f32x4 m0 = l0 * 4.f, m1 = l1 * 4.f, m2 = h0 * 4.f, m3 = h1 * 4.f;
          a.x = (unsigned)__builtin_amdgcn_cvt_pk_fp8_f32(m0.z, m0.w, __builtin_amdgcn_cvt_pk_fp8_f32(m0.x, m0.y, 0, false), true); a.y = (unsigned)__builtin_amdgcn_cvt_pk_fp8_f32(m1.z, m1.w, __builtin_amdgcn_cvt_pk_fp8_f32(m1.x, m1.y, 0, false), true);
          b.x = (unsigned)__builtin_amdgcn_cvt_pk_fp8_f32(m2.z, m2.w, __builtin_amdgcn_cvt_pk_fp8_f32(m2.x, m2.y, 0, false), true); b.y = (unsigned)__builtin_amdgcn_cvt_pk_fp8_f32(m3.z, m3.w, __builtin_amdgcn_cvt_pk_fp8_f32(m3.x, m3.y, 0, false), true);
          *(u32x2*)bp = a; *(u32x2*)(bp + 128) = b; }
        float s = (l0.x * l0.x + l0.y * l0.y) + (l0.z * l0.z + l0.w * l0.w) + (l1.x * l1.x + l1.y * l1.y) + (l1.z * l1.z + l1.w * l1.w)
                + (h0.x * h0.x + h0.y * h0.y) + (h0.z * h0.z + h0.w * h0.w) + (h1.x * h1.x + h1.y * h1.y) + (h1.z * h1.z + h1.w * h1.w);
        s = rows_sum(s);
        if (lane_id() < 16) SS2[(size_t)row * 16 + pn * 4 + wc] = s;
    }
};
__device__ __forceinline__ float rstd2_of(const float* SS2, int row) {
    const f32x4* p = (const f32x4*)(SS2 + (size_t)row * 16); const f32x4 a = p[0], b = p[1], c = p[2], d = p[3];
    const float s = ((a.x + a.y) + (a.z + a.w)) + ((b.x + b.y) + (b.z + b.w)) + ((c.x + c.y) + (c.z + c.w)) + ((d.x + d.y) + (d.z + d.w));
    return __builtin_amdgcn_rsqf(s * (1.0f / D) + EPS);
}
struct Epi4 {
    f16_t* QP;
    __device__ __forceinline__ void operator()(int row, int col, int pn, int wc, f32x4 l0, f32x4 l1, f32x4 h0, f32x4 h1) const {
        f16_t* p = QP + (size_t)row * 2048 + col;
        *(u32x4*)p = pack8h(l0, l1); *(u32x4*)(p + 128) = pack8h(h0, h1);
    }
};

__device__ __forceinline__ void phase2(Ctx& F) {
    const bf16_t* BA = (const bf16_t*)(F.ws + WS_B); const bf16_t* CU = BA + (size_t)M * CW; const bf16_t* Q = CU + (size_t)M * CW;
    bf16_t* O = (bf16_t*)(F.ws + WS_A); bf16_t* YA = O + (size_t)M * CW;
    const bf16_t* MK = (const bf16_t*)(F.ws + WS_META); const bf16_t* MV = MK + 16 * 512; const float* MCA = (const float*)(MV + 16 * 512); const float* MUA = MCA + 16 * 512;
    {
        const int gt = (F.reg ? F.xcc * 32 + F.rank : (int)blockIdx.x) * NTHR + F.tid, NT = F.G * NTHR;
        for (int it = gt; it < (M / 8) * 64; it += NT) {
            const int strip = it >> 6, c = (it & 63) * 8, r0 = strip * 8, t0 = r0 & (SEQ - 1);
            u32x4 cu[8], ba[8];
#pragma unroll
            for (int q = 0; q < 8; ++q) { cu[q] = *(const u32x4*)(CU + (size_t)(r0 + q) * CW + c); ba[q] = *(const u32x4*)(BA + (size_t)(r0 + q) * CW + c); }
            const f32x4 wa0 = *(const f32x4*)(F.conv_w + c), wa1 = *(const f32x4*)(F.conv_w + c + 4), wb0 = *(const f32x4*)(F.conv_w + CW + c), wb1 = *(const f32x4*)(F.conv_w + CW + c + 4),
                        wc0 = *(const f32x4*)(F.conv_w + 2 * CW + c), wc1 = *(const f32x4*)(F.conv_w + 2 * CW + c + 4);
            f32x4 p2a, p2b, p1a, p1b;
            if (t0 != 0) { unpack8bf(*(const u32x4*)(CU + (size_t)(r0 - 2) * CW + c), p2a, p2b); unpack8bf(*(const u32x4*)(CU + (size_t)(r0 - 1) * CW + c), p1a, p1b); }
            else { p2a = *(const f32x4*)(MCA + 14 * 512 + c) * *(const f32x4*)(MUA + 14 * 512 + c); p2b = *(const f32x4*)(MCA + 14 * 512 + c + 4) * *(const f32x4*)(MUA + 14 * 512 + c + 4);
                   p1a = *(const f32x4*)(MCA + 15 * 512 + c) * *(const f32x4*)(MUA + 15 * 512 + c); p1b = *(const f32x4*)(MCA + 15 * 512 + c + 4) * *(const f32x4*)(MUA + 15 * 512 + c + 4); }
#pragma unroll
            for (int q = 0; q < 8; ++q) {
                f32x4 ca, cb, ga, gb; unpack8bf(cu[q], ca, cb); unpack8bf(ba[q], ga, gb);
                const f32x4 ya = ga * (wa0 * p2a + wb0 * p1a + wc0 * ca), yb = gb * (wa1 * p2b + wb1 * p1b + wc1 * cb);
                *(u32x4*)(YA + (size_t)(r0 + q) * CW + c) = pack8bf(ya, yb);
                p2a = p1a; p2b = p1b; p1a = ca; p1b = cb;
            }
        }
    }
    {
        const bf16_t* KU = (const bf16_t*)(F.ws + WS_KU); const bf16_t* VT = (const bf16_t*)(F.ws + WS_VT);
        const int r = F.lane & 31, hh = F.lane >> 5;
        const int item0 = F.reg ? F.xcc * 512 + F.rank * 8 + F.wave : F.gw, istep = F.reg ? 256 : F.NGW, iend = F.reg ? F.xcc * 512 + 512 : 64 * 64;
        for (int item = item0; item < iend; item += istep) {
            const int bh = item >> 6, a = item & 63, b = bh >> 3, h = bh & 7;
            const bf16_t* qp = Q + (size_t)(b * SEQ + 32 * a + r) * CW + h * HD + 8 * hh;
            bf16x8 qf[4];
#pragma unroll
            for (int kk = 0; kk < 4; ++kk) qf[kk] = *(const bf16x8*)(qp + 16 * kk);
            const bf16_t* kb = KU + (size_t)bh * LP * HD + (size_t)r * HD + 8 * hh;
            const bf16_t* vb0 = VT + ((size_t)bh * HD + r) * LP + 4 * hh;
            f32x16 o0, o1;
#pragma unroll
            for (int i = 0; i < 16; ++i) { o0[i] = 0.f; o1[i] = 0.f; }
            float carry = 0.f;
            bf16x8 kA[4]; u32x2 vA[8];
            LAS unsigned char* timg = F.lds + F.wave * 8192;
            const unsigned char* ksrc = (const unsigned char*)(KU + (size_t)bh * LP * HD) + (F.lane >> 3) * 128 + (((F.lane & 7) ^ (F.lane >> 3)) * 16);
            const unsigned char* vsrc = (const unsigned char*)(VT + (size_t)bh * HD * LP) + (size_t)(F.lane >> 2) * (LP * 2) + (((F.lane & 3) ^ ((F.lane >> 4) & 3)) * 16);
            const LAS unsigned char* kfr = timg + (r * 8) * 16;
            const LAS unsigned char* vfr = timg + 4096 + r * 64;
            const int ksw = r & 7, vsw = (r >> 2) & 3;
#define AT_DMA(jj) do { const int _j = (jj); _Pragma("unroll") for (int _i = 0; _i < 4; ++_i) \
                    __builtin_amdgcn_global_load_lds((const unsigned*)(ksrc + (size_t)_j * 4096 + _i * 1024), (LAS unsigned*)(timg + _i * 1024), 16, 0, 0); \
                _Pragma("unroll") for (int _i = 0; _i < 4; ++_i) \
                    __builtin_amdgcn_global_load_lds((const unsigned*)(vsrc + (size_t)_j * 64 + (size_t)_i * 16 * (LP * 2)), (LAS unsigned*)(timg + 4096 + _i * 1024), 16, 0, 0); } while (0)
#define AT_FRAGS(KF, VF) do { _Pragma("unroll") for (int kk = 0; kk < 4; ++kk) KF[kk] = *(const LAS bf16x8*)(kfr + (((hh + 2 * kk) ^ ksw) << 4)); \
                _Pragma("unroll") for (int mt = 0; mt < 2; ++mt) _Pragma("unroll") for (int st = 0; st < 2; ++st) { const int q0 = 4 * st + hh, q1 = q0 + 2; \
                    VF[(mt * 2 + st) * 2] = *(const LAS u32x2*)(vfr + mt * 2048 + (((q0 >> 1) ^ vsw) << 4) + ((q0 & 1) << 3)); \
                    VF[(mt * 2 + st) * 2 + 1] = *(const LAS u32x2*)(vfr + mt * 2048 + (((q1 >> 1) ^ vsw) << 4) + ((q1 & 1) << 3)); } \
                asm volatile("s_waitcnt lgkmcnt(0)" ::: "memory"); } while (0)
#define AT_TILE(jj, KF, VF) do { const int jt = (jj); f32x16 sc; \
                _Pragma("unroll") for (int i = 0; i < 16; ++i) sc[i] = 0.f; \
                _Pragma("unroll") for (int kk = 0; kk < 4; ++kk) sc = __builtin_amdgcn_mfma_f32_32x32x16_bf16(KF[kk], qf[kk], sc, 0, 0, 0); \
                float lm[16], ls[16], ex[16], gs[4], pg[4]; \
                const bool diag = (jt == a + 1), first = (jt == 0); \
                _Pragma("unroll") for (int i = 0; i < 16; ++i) { \
                    const int key = (i & 3) + 8 * (i >> 2) + 4 * hh; \
                    const bool valid = diag ? (key < r) : (first ? (key >= 16) : true); \
                    const float z = sc[i]; \
                    const float sp = fmaxf(z, 0.f) + __builtin_amdgcn_logf(1.0f + __builtin_amdgcn_exp2f(-fabsf(z)));     \
                    lm[i] = valid ? -sp : 0.f; ls[i] = valid ? (z - sp) : -1.0e30f; } \
                _Pragma("unroll") for (int g = 0; g < 4; ++g) { ex[4 * g + 3] = 0.f; ex[4 * g + 2] = lm[4 * g + 3]; ex[4 * g + 1] = ex[4 * g + 2] + lm[4 * g + 2]; ex[4 * g] = ex[4 * g + 1] + lm[4 * g + 1]; gs[g] = ex[4 * g] + lm[4 * g]; } \
                _Pragma("unroll") for (int g = 0; g < 4; ++g) pg[g] = xlane32(gs[g], hh); \
                float os[4], pi[4], off[4]; \
                os[3] = 0.f; os[2] = gs[3]; os[1] = os[2] + gs[2]; os[0] = os[1] + gs[1]; \
                pi[3] = pg[3]; pi[2] = pi[3] + pg[2]; pi[1] = pi[2] + pg[1]; pi[0] = pi[1] + pg[0]; \
                _Pragma("unroll") for (int g = 0; g < 4; ++g) off[g] = carry + os[g] + (hh == 0 ? pi[g] : (pi[g] - pg[g])); \
                const float total = os[0] + gs[0] + pi[0]; \
                float pv[16]; \
                _Pragma("unroll") for (int i = 0; i < 16; ++i) pv[i] = __builtin_amdgcn_exp2f(ls[i] + off[i >> 2] + ex[i]); \
                carry += total; \
                bf16x8 pf[2]; \
                _Pragma("unroll") for (int st = 0; st < 2; ++st) { u32x4 w; w.x = pk2bf(pv[8 * st], pv[8 * st + 1]); w.y = pk2bf(pv[8 * st + 2], pv[8 * st + 3]); w.z = pk2bf(pv[8 * st + 4], pv[8 * st + 5]); w.w = pk2bf(pv[8 * st + 6], pv[8 * st + 7]); pf[st] = __builtin_bit_cast(bf16x8, w); } \
                _Pragma("unroll") for (int st = 0; st < 2; ++st) { \
                    u32x4 w0; w0.x = VF[st * 2].x; w0.y = VF[st * 2].y; w0.z = VF[st * 2 + 1].x; w0.w = VF[st * 2 + 1].y; \
                    u32x4 w1; w1.x = VF[(2 + st) * 2].x; w1.y = VF[(2 + st) * 2].y; w1.z = VF[(2 + st) * 2 + 1].x; w1.w = VF[(2 + st) * 2 + 1].y; \
                    o0 = __builtin_amdgcn_mfma_f32_32x32x16_bf16(__builtin_bit_cast(bf16x8, w0), pf[st], o0, 0, 0, 0); \
                    o1 = __builtin_amdgcn_mfma_f32_32x32x16_bf16(__builtin_bit_cast(bf16x8, w1), pf[st], o1, 0, 0, 0); } \
            } while (0)
            int j = a + 1;
            AT_DMA(j);
#pragma unroll
            for (int kk = 0; kk < 4; ++kk) asm volatile("" : "+v"(qf[kk]));
            for (;;) {
                asm volatile("s_waitcnt vmcnt(0)" ::: "memory");
                AT_FRAGS(kA, vA);
                AT_DMA(j > 0 ? j - 1 : 0);
                AT_TILE(j, kA, vA);
                if (j == 0 || __all(carry < -SB_THR * LOG2E)) break;
                --j;
            }
            asm volatile("s_waitcnt vmcnt(0)" ::: "memory");
#undef AT_DMA
#undef AT_FRAGS
#undef AT_TILE
            bf16_t* op = O + (size_t)(b * SEQ + 32 * a + r) * CW + h * HD + 4 * hh;
#pragma unroll
            for (int g = 0; g < 4; ++g) {
                u32x2 w0, w1; w0.x = pk2bf(o0[4 * g], o0[4 * g + 1]); w0.y = pk2bf(o0[4 * g + 2], o0[4 * g + 3]); w1.x = pk2bf(o1[4 * g], o1[4 * g + 1]); w1.y = pk2bf(o1[4 * g + 2], o1[4 * g + 3]);
                *(u32x2*)(op + 8 * g) = w0; *(u32x2*)(op + 32 + 8 * g) = w1;
            }
        }
    }
}

__device__ __forceinline__ unsigned ord_key(float s) { return __builtin_bit_cast(unsigned, s); }
__device__ __forceinline__ float ord_val(unsigned k) { return __builtin_bit_cast(float, k); }
__device__ __forceinline__ unsigned kmax(unsigned a, unsigned b) { unsigned r; asm("v_max_f32 %0, %1, %2" : "=v"(r) : "v"(a), "v"(b)); return r; }
__device__ __forceinline__ unsigned kmin(unsigned a, unsigned b) { unsigned r; asm("v_min_f32 %0, %1, %2" : "=v"(r) : "v"(a), "v"(b)); return r; }
constexpr unsigned KEY_PAD = 0xff800000u;
#define CE(a, b) do { const unsigned _x = (a), _y = (b); (a) = kmax(_x, _y); (b) = kmin(_x, _y); } while (0)
#define SORT16(v) do { CE(v[0], v[1]); CE(v[2], v[3]); CE(v[0], v[2]); CE(v[1], v[3]); CE(v[1], v[2]); CE(v[4], v[5]); CE(v[6], v[7]); CE(v[4], v[6]); CE(v[5], v[7]); CE(v[5], v[6]); CE(v[0], v[4]); CE(v[2], v[6]); CE(v[2], v[4]); CE(v[1], v[5]); CE(v[3], v[7]); CE(v[3], v[5]); CE(v[1], v[2]); CE(v[3], v[4]); CE(v[5], v[6]); CE(v[8], v[9]); CE(v[10], v[11]); CE(v[8], v[10]); CE(v[9], v[11]); CE(v[9], v[10]); CE(v[12], v[13]); CE(v[14], v[15]); CE(v[12], v[14]); CE(v[13], v[15]); CE(v[13], v[14]); CE(v[8], v[12]); CE(v[10], v[14]); CE(v[10], v[12]); CE(v[9], v[13]); CE(v[11], v[15]); CE(v[11], v[13]); CE(v[9], v[10]); CE(v[11], v[12]); CE(v[13], v[14]); CE(v[0], v[8]); CE(v[4], v[12]); CE(v[4], v[8]); CE(v[2], v[10]); CE(v[6], v[14]); CE(v[6], v[10]); CE(v[2], v[4]); CE(v[6], v[8]); CE(v[10], v[12]); CE(v[1], v[9]); CE(v[5], v[13]); CE(v[5], v[9]); CE(v[3], v[11]); CE(v[7], v[15]); CE(v[7], v[11]); CE(v[3], v[5]); CE(v[7], v[9]); CE(v[11], v[13]); CE(v[1], v[2]); CE(v[3], v[4]); CE(v[5], v[6]); CE(v[7], v[8]); CE(v[9], v[10]); CE(v[11], v[12]); CE(v[13], v[14]); } while (0)
#define BMERGE16(v) do { CE(v[0], v[8]); CE(v[1], v[9]); CE(v[2], v[10]); CE(v[3], v[11]); CE(v[4], v[12]); CE(v[5], v[13]); CE(v[6], v[14]); CE(v[7], v[15]); CE(v[0], v[4]); CE(v[1], v[5]); CE(v[2], v[6]); CE(v[3], v[7]); CE(v[8], v[12]); CE(v[9], v[13]); CE(v[10], v[14]); CE(v[11], v[15]); CE(v[0], v[2]); CE(v[1], v[3]); CE(v[4], v[6]); CE(v[5], v[7]); CE(v[8], v[10]); CE(v[9], v[11]); CE(v[12], v[14]); CE(v[13], v[15]); CE(v[0], v[1]); CE(v[2], v[3]); CE(v[4], v[5]); CE(v[6], v[7]); CE(v[8], v[9]); CE(v[10], v[11]); CE(v[12], v[13]); CE(v[14], v[15]); } while (0)

#define MERGE_TOP16(a, b) do { _Pragma("unroll") for (int _i = 0; _i < 16; ++_i) { const unsigned _p = (a)[_i], _q = (b)[15 - _i]; (a)[_i] = kmax(_p, _q); } BMERGE16(a); } while (0)
__device__ static constexpr int CAND_I[50] = {0, 0, 0, 0, 0, 0, 0, 0, 0, 0, 0, 0, 0, 0, 0, 0, 1, 1, 1, 1, 1, 1, 1, 1, 2, 2, 2, 2, 2, 3, 3, 3, 3, 4, 4, 4, 5, 5, 6, 6, 7, 7, 8, 9, 10, 11, 12, 13, 14, 15};
__device__ static constexpr int CAND_J[50] = {0, 1, 2, 3, 4, 5, 6, 7, 8, 9, 10, 11, 12, 13, 14, 15, 0, 1, 2, 3, 4, 5, 6, 7, 0, 1, 2, 3, 4, 0, 1, 2, 3, 0, 1, 2, 0, 1, 0, 1, 0, 1, 0, 0, 0, 0, 0, 0, 0, 0};

struct TabB { f32x4 v[4][4]; };
__device__ __forceinline__ void tab_issue(Ctx& F, TabB& B, int batch) {
#pragma unroll
    for (int u = 0; u < 4; ++u) { const int t = min(F.gw + (4 * batch + u) * F.NGW, 2 * NEXP - 1); const float* src = (t < NEXP ? F.pu : F.pv) + (size_t)(t & (NEXP - 1)) * D + 4 * F.lane;
#pragma unroll
        for (int j = 0; j < 4; ++j) B.v[u][j] = __builtin_nontemporal_load((const f32x4*)(src + 256 * j)); }
}
__device__ __forceinline__ void tab_finish(Ctx& F, TabB& B, int batch) {
    unsigned char* U4 = F.ws + WS_T; unsigned char* V4 = F.ws + WS_T + 8 * MiB; float* SU = (float*)(F.ws + WS_T + 16 * MiB); float* SV = SU + NEXP;
#pragma unroll
    for (int u = 0; u < 4; ++u) {
        const int t = F.gw + (4 * batch + u) * F.NGW; const bool isu = t < NEXP; const int row = t & (NEXP - 1);
        float m = 0.f;
#pragma unroll
        for (int j = 0; j < 4; ++j) { if (isu) B.v[u][j] = B.v[u][j] * *(const f32x4*)(F.g2 + 256 * j + 4 * F.lane); m = fmaxf(m, fmaxf(fmaxf(fabsf(B.v[u][j].x), fabsf(B.v[u][j].y)), fmaxf(fabsf(B.v[u][j].z), fabsf(B.v[u][j].w)))); }
        m = fmaxf(wave_max(m), 1.0e-30f);
        const float sc = m * 0.125f, inv = 8.0f / m;
        if (t < 2 * NEXP) {
            unsigned char* dst = (isu ? U4 : V4) + (size_t)row * 128 + 2 * F.lane;
#pragma unroll
            for (int j = 0; j < 4; ++j) { unsigned w = 0;
                w = __builtin_amdgcn_cvt_scalef32_pk_fp4_f32(w, clamp6(B.v[u][j].x * inv), clamp6(B.v[u][j].y * inv), 1.0f, 0);
                w = __builtin_amdgcn_cvt_scalef32_pk_fp4_f32(w, clamp6(B.v[u][j].z * inv), clamp6(B.v[u][j].w * inv), 1.0f, 1);
                *(u16*)(dst + (size_t)j * (NEXP * 128)) = (u16)w; }
            if (F.lane == 0) (isu ? SU : SV)[row] = sc;
        }
    }
}
__device__ __forceinline__ void phase5_stage(Ctx& F) {
    const f16_t* SKB = (const f16_t*)(F.ws + WS_SKB);
    const int h = F.reg ? (F.rank & 7) : (int)(blockIdx.x & 7);
    const u32x4* src = (const u32x4*)(SKB + (size_t)(h * 2) * 128 * 128);
    u32x4 t[8];
#pragma unroll
    for (int i = 0; i < 8; ++i) t[i] = src[F.tid + NTHR * i];
#pragma unroll
    for (int i = 0; i < 8; ++i) { const int c = F.tid + NTHR * i, row = c >> 4, ch = c & 15; *(LAS u32x4*)(F.lds + row * 272 + ch * 16) = t[i]; }
    __syncthreads();
}
template <bool STREAM>
__device__ __forceinline__ void phase5(Ctx& F) {
    const f16_t* QP = (const f16_t*)(F.ws + WS_B);
    u16* EIDX = (u16*)(F.ws + WS_E); float* GATE = (float*)(F.ws + WS_GATE);
    const int r = F.lane & 31, hh = F.lane >> 5;
    LAS unsigned char* tab = F.lds + 73728 + F.wave * 2048 + F.lane * 32;
    const int h = F.reg ? (F.rank & 7) : (int)(blockIdx.x & 7), nbh = F.G >> 3;
    const int tg0 = F.reg ? F.xcc * 64 + (F.rank >> 3) * 8 + F.wave : (int)(blockIdx.x >> 3) + nbh * F.wave, tgstep = F.reg ? 32 : nbh * NWAVES, tgend = F.reg ? F.xcc * 64 + 64 : 512;
    TabB tb; int nb = 0;
    f16x8 qf[8];
#define P5_LOADQ(tk, gg) do { const f16_t* _q = QP + (size_t)(tk) * 2048 + (gg) * 128 + 8 * hh; _Pragma("unroll") for (int kk = 0; kk < 8; ++kk) qf[kk] = *(const f16x8*)(_q + 16 * kk); } while (0)
#define P5_HOOK() do { if (STREAM) { if (nb > 0) tab_finish(F, tb, nb - 1); if (nb < 4) { tab_issue(F, tb, nb); } ++nb; } } while (0)
    if (tg0 < tgend) P5_LOADQ(tg0 * 32 + r, h * 2);
    P5_HOOK();
    unsigned K0[16], K1[16]; int tokK = 0; bool have = false;
#pragma unroll
    for (int i = 0; i < 16; ++i) { K0[i] = 0u; K1[i] = 0u; }
    for (int tg = tg0; tg < tgend; tg += tgstep) {
        const int tok = tg * 32 + r;
        unsigned T0[16], T1[16];
#pragma unroll
        for (int p = 0; p < 2; ++p) {
            const int g = h * 2 + p;
            const LAS unsigned char* kp = F.lds + (p * 128 + r) * 272 + 16 * hh;
            unsigned cur[16], nxt[16];
#pragma unroll
            for (int mh = 0; mh < 2; ++mh) {
                f32x16 acc[2];
#pragma unroll
                for (int m2 = 0; m2 < 2; ++m2)
#pragma unroll
                    for (int i = 0; i < 16; ++i) acc[m2][i] = 0.f;
#pragma unroll
                for (int kk = 0; kk < 8; ++kk) {
#pragma unroll
                    for (int m2 = 0; m2 < 2; ++m2) { const f16x8 kf = *(const LAS f16x8*)(kp + (2 * mh + m2) * 32 * 272 + 32 * kk); acc[m2] = __builtin_amdgcn_mfma_f32_32x32x16_f16(kf, qf[kk], acc[m2], 0, 0, 0); }
                }
                if (mh == 1) {
                    if (p == 0) P5_LOADQ(tok, g + 1); else { const int tn = min(tg + tgstep, tgend - 1); P5_LOADQ(tn * 32 + r, h * 2); }
                    if (p == 0) P5_HOOK();
                }
#pragma unroll
                for (int m2 = 0; m2 < 2; ++m2) { const int mt = 2 * mh + m2;
#pragma unroll
                    for (int i = 0; i < 16; ++i) nxt[i] = (ord_key(acc[m2][i]) | 127u) ^ (unsigned)(32 * mt + (i & 3) + 8 * (i >> 2));
                    SORT16(nxt);
                    if (mt == 0) {
#pragma unroll
                        for (int i = 0; i < 16; ++i) cur[i] = nxt[i];
                    } else MERGE_TOP16(cur, nxt);
                }
            }
#pragma unroll
            for (int i = 0; i < 16; ++i) cur[i] ^= (unsigned)(4 * hh);
#pragma unroll
            for (int i = 0; i < 16; ++i) nxt[i] = (unsigned)__shfl_xor((int)cur[i], 32);
            MERGE_TOP16(cur, nxt);
#pragma unroll
            for (int i = 0; i < 16; ++i) { if (p == 0) T0[i] = cur[i]; else T1[i] = cur[i]; }
        }
        if (!have && tg + tgstep < tgend) {
#pragma unroll
            for (int i = 0; i < 16; ++i) { K0[i] = T0[i]; K1[i] = T1[i]; }
            tokK = tok; have = true; continue;
        }
        const bool useK = have && hh == 0; have = false;
        const int tokf = useK ? tokK : tok;
#pragma unroll
        for (int i = 0; i < 16; ++i) { T0[i] = useK ? K0[i] : T0[i]; T1[i] = useK ? K1[i] : T1[i]; }
        {
            u32x4 w0, w1, w2, w3;
            w0.x = (T0[0] & 127u) | ((T0[1] & 127u) << 8) | ((T0[2] & 127u) << 16) | ((T0[3] & 127u) << 24); w0.y = (T0[4] & 127u) | ((T0[5] & 127u) << 8) | ((T0[6] & 127u) << 16) | ((T0[7] & 127u) << 24);
            w0.z = (T0[8] & 127u) | ((T0[9] & 127u) << 8) | ((T0[10] & 127u) << 16) | ((T0[11] & 127u) << 24); w0.w = (T0[12] & 127u) | ((T0[13] & 127u) << 8) | ((T0[14] & 127u) << 16) | ((T0[15] & 127u) << 24);
            w1.x = (T1[0] & 127u) | ((T1[1] & 127u) << 8) | ((T1[2] & 127u) << 16) | ((T1[3] & 127u) << 24); w1.y = (T1[4] & 127u) | ((T1[5] & 127u) << 8) | ((T1[6] & 127u) << 16) | ((T1[7] & 127u) << 24);
            w1.z = (T1[8] & 127u) | ((T1[9] & 127u) << 8) | ((T1[10] & 127u) << 16) | ((T1[11] & 127u) << 24); w1.w = (T1[12] & 127u) | ((T1[13] & 127u) << 8) | ((T1[14] & 127u) << 16) | ((T1[15] & 127u) << 24);
            *(LAS u32x4*)tab = w0; *(LAS u32x4*)(tab + 16) = w1; (void)w2; (void)w3;
        }
        float s0[16], s1[16];
#pragma unroll
        for (int i = 0; i < 16; ++i) { s0[i] = ord_val(T0[i] & ~127u); s1[i] = ord_val(T1[i] & ~127u); }
        unsigned c0[16], c1[16];
#pragma unroll
        for (int c = 0; c < 16; ++c) c0[c] = (ord_key(s0[CAND_I[c]] + s1[CAND_J[c]]) & ~255u) | (unsigned)(255 - (CAND_I[c] * 16 + CAND_J[c]));
        SORT16(c0);
#pragma unroll
        for (int c = 0; c < 16; ++c) c1[c] = (ord_key(s0[CAND_I[16 + c]] + s1[CAND_J[16 + c]]) & ~255u) | (unsigned)(255 - (CAND_I[16 + c] * 16 + CAND_J[16 + c]));
        SORT16(c1); MERGE_TOP16(c0, c1);
#pragma unroll
        for (int c = 0; c < 16; ++c) c1[c] = (ord_key(s0[CAND_I[32 + c]] + s1[CAND_J[32 + c]]) & ~255u) | (unsigned)(255 - (CAND_I[32 + c] * 16 + CAND_J[32 + c]));
        SORT16(c1); MERGE_TOP16(c0, c1);
#pragma unroll
        for (int c = 0; c < 16; ++c) c1[c] = KEY_PAD;
        c1[0] = (ord_key(s0[CAND_I[48]] + s1[CAND_J[48]]) & ~255u) | (unsigned)(255 - (CAND_I[48] * 16 + CAND_J[48]));
        c1[1] = (ord_key(s0[CAND_I[49]] + s1[CAND_J[49]]) & ~255u) | (unsigned)(255 - (CAND_I[49] * 16 + CAND_J[49]));
        CE(c1[0], c1[1]); MERGE_TOP16(c0, c1);
        float sc[16]; unsigned eid[16];
        asm volatile("s_waitcnt lgkmcnt(0)" ::: "memory");
#pragma unroll
        for (int k = 0; k < 16; ++k) {
            const unsigned ci = 255u - (c0[k] & 255u);
            const unsigned b0 = tab[ci >> 4], b1 = tab[16 + (ci & 15u)];
            eid[k] = (127u - b0) * 128u + (127u - b1);
            sc[k] = ord_val(c0[k] & ~255u);
        }
        float sum = 0.f; const float mx = sc[0], r2 = rstd2_of((const float*)(F.ws + WS_SS2), tokf);
        const float r2l = r2 * LOG2E;
#pragma unroll
        for (int k = 0; k < 16; ++k) { sc[k] = __builtin_amdgcn_exp2f((sc[k] - mx) * r2l); sum += sc[k]; }
        const float inv = __builtin_amdgcn_rcpf(sum);
        {
            u32x4 w0, w1;
            w0.x = eid[0] | (eid[1] << 16); w0.y = eid[2] | (eid[3] << 16); w0.z = eid[4] | (eid[5] << 16); w0.w = eid[6] | (eid[7] << 16);
            w1.x = eid[8] | (eid[9] << 16); w1.y = eid[10] | (eid[11] << 16); w1.z = eid[12] | (eid[13] << 16); w1.w = eid[14] | (eid[15] << 16);
            u32x4* ep = (u32x4*)(EIDX + (size_t)tokf * NSEL + h * 16); ep[0] = w0; ep[1] = w1;
            f32x4* gp = (f32x4*)(GATE + (size_t)tokf * NSEL + h * 16);
            gp[0] = (f32x4){sc[0] * inv, sc[1] * inv, sc[2] * inv, sc[3] * inv}; gp[1] = (f32x4){sc[4] * inv, sc[5] * inv, sc[6] * inv, sc[7] * inv};
            gp[2] = (f32x4){sc[8] * inv, sc[9] * inv, sc[10] * inv, sc[11] * inv}; gp[3] = (f32x4){sc[12] * inv, sc[13] * inv, sc[14] * inv, sc[15] * inv};
        }
        P5_HOOK();
    }
    if (STREAM) { while (nb <= 4) P5_HOOK(); }
#undef P5_LOADQ
#undef P5_HOOK
}

__device__ __forceinline__ float gelu_tanh(float x) { const float u = 0.7978845608028654f * (x + 0.044715f * x * x * x); return x * __builtin_amdgcn_rcpf(1.0f + __builtin_amdgcn_exp2f(-2.0f * LOG2E * u)); }
__device__ __forceinline__ unsigned e16_of(const u32x4& a, const u32x4& b, int i) {
    const unsigned w = (i < 8) ? ((i >> 1) == 0 ? a.x : (i >> 1) == 1 ? a.y : (i >> 1) == 2 ? a.z : a.w) : (((i - 8) >> 1) == 0 ? b.x : ((i - 8) >> 1) == 1 ? b.y : ((i - 8) >> 1) == 2 ? b.z : b.w);
    return (i & 1) ? (w >> 16) : (w & 0xffffu);
}
#ifndef FP4_SWAP
#define FP4_SWAP 0
#endif
__device__ __forceinline__ f16x2 fp4h2(unsigned w, int b) {
    const f16x2 r = b == 0 ? __builtin_amdgcn_cvt_scalef32_pk_f16_fp4(w, 1.0f, 0) : b == 1 ? __builtin_amdgcn_cvt_scalef32_pk_f16_fp4(w, 1.0f, 1) : b == 2 ? __builtin_amdgcn_cvt_scalef32_pk_f16_fp4(w, 1.0f, 2) : __builtin_amdgcn_cvt_scalef32_pk_f16_fp4(w, 1.0f, 3);
    return FP4_SWAP ? (f16x2){r[1], r[0]} : r;
}
#define UM_IDX(k, E) do { E = *(const u32x4*)(EIDX + (size_t)(tok0 + (k) * nws) * NSEL + 8 * cA); } while (0)
#define UM_ISSUE(k, UV, XB, E) do { const u32x4* _xp = (const u32x4*)(X18 + (size_t)(tok0 + (k) * nws) * D + slice * 256 + xoff); \
        _Pragma("unroll") for (int _g = 0; _g < 8; ++_g) { const unsigned _w = (_g >> 1) == 0 ? E.x : (_g >> 1) == 1 ? E.y : (_g >> 1) == 2 ? E.z : E.w; \
            const unsigned char* _r = ub + (size_t)((_g & 1) ? (_w >> 16) : (_w & 0xffffu)) * 128; UV[2 * _g] = *(const u32x4*)_r; UV[2 * _g + 1] = *(const u32x4*)(_r + 64); } \
        XB[0] = _xp[0]; XB[1] = _xp[8]; } while (0)
#define UM_CONSUME(k, UV, XB) do { float dv[8]; \
        i32x8 bx0, bx1; \
        bx0[0] = inLo ? XB[0].x : 0u; bx0[1] = inLo ? XB[0].y : 0u; bx0[2] = inLo ? XB[0].z : 0u; bx0[3] = inLo ? XB[0].w : 0u; bx0[4] = inHi ? XB[0].x : 0u; bx0[5] = inHi ? XB[0].y : 0u; bx0[6] = inHi ? XB[0].z : 0u; bx0[7] = inHi ? XB[0].w : 0u; \
        bx1[0] = inLo ? XB[1].x : 0u; bx1[1] = inLo ? XB[1].y : 0u; bx1[2] = inLo ? XB[1].z : 0u; bx1[3] = inLo ? XB[1].w : 0u; bx1[4] = inHi ? XB[1].x : 0u; bx1[5] = inHi ? XB[1].y : 0u; bx1[6] = inHi ? XB[1].z : 0u; bx1[7] = inHi ? XB[1].w : 0u; \
        _Pragma("unroll") for (int _g = 0; _g < 8; ++_g) { \
            i32x8 ax; ax[0] = UV[2 * _g].x; ax[1] = UV[2 * _g].y; ax[2] = UV[2 * _g].z; ax[3] = UV[2 * _g].w; ax[4] = 0; ax[5] = 0; ax[6] = 0; ax[7] = 0; \
            f32x4 z = {0.f, 0.f, 0.f, 0.f}; \
            z = __builtin_amdgcn_mfma_scale_f32_16x16x128_f8f6f4(ax, bx0, z, 4, 0, 0, 0, 0, 0); \
            ax[0] = UV[2 * _g + 1].x; ax[1] = UV[2 * _g + 1].y; ax[2] = UV[2 * _g + 1].z; ax[3] = UV[2 * _g + 1].w; \
            z = __builtin_amdgcn_mfma_scale_f32_16x16x128_f8f6f4(ax, bx1, z, 4, 0, 0, 0, 0, 0); \
            float v = bq == 0 ? z.x : bq == 1 ? z.y : bq == 2 ? z.z : z.w; \
            v += __builtin_bit_cast(float, __builtin_amdgcn_update_dpp(0, __builtin_bit_cast(int, v), 0xB1, 0xf, 0xf, true)); \
            v += __builtin_bit_cast(float, __builtin_amdgcn_update_dpp(0, __builtin_bit_cast(int, v), 0x4E, 0xf, 0xf, true)); \
            dv[_g] = v; } \
        if (storer) { u32x4 o0; o0.x = pk2h(dv[0], dv[1]); o0.y = pk2h(dv[2], dv[3]); o0.z = pk2h(dv[4], dv[5]); o0.w = pk2h(dv[6], dv[7]); \
            *(u32x4*)(DOTP + ((size_t)(tok0 + (k) * nws) * 4 + slice) * NSEL + 8 * cD) = o0; } } while (0)
__device__ __forceinline__ void phaseU(Ctx& F) {
    const unsigned char* U4 = F.ws + WS_T; const u16* EIDX = (const u16*)(F.ws + WS_E); f16_t* DOTP = (f16_t*)(F.ws + WS_B); const unsigned char* X18 = F.ws + WS_X18;
    const int xl = blockIdx.x & 7, slice = xl & 3, nws = (F.G >> 3) * NWAVES, tok0 = (xl >> 2) * (M / 2) + (blockIdx.x >> 3) * NWAVES + F.wave;
    const int rho = F.lane & 15, kg = F.lane >> 4, bq = rho & 3, aq = rho >> 2;
    const int cA = 4 * aq + kg;
    const int cD = 4 * kg + aq;
    const bool inLo = aq == (kg >> 1), inHi = aq == 2 + (kg >> 1);
    const int xoff = 32 * bq + 16 * (kg & 1);
    const bool storer = bq == 0;
    const unsigned char* ub = U4 + (size_t)slice * (NEXP * 128) + bq * 16;
    const int N = (M / 2 - ((blockIdx.x >> 3) * NWAVES + F.wave) + nws - 1) / nws;
    if (N <= 0) return;
    u32x4 uvA[16], uvB[16]; u32x4 xA[2], xB[2]; u32x4 eA, eB;
    int k0 = 0;
    if (N & 1) { UM_IDX(0, eA); UM_ISSUE(0, uvA, xA, eA); UM_CONSUME(0, uvA, xA); k0 = 1; if (N == 1) return; }
    const int L = N - 1;
    UM_IDX(k0, eA);
    UM_IDX(k0 + 1, eB);
    UM_ISSUE(k0, uvA, xA, eA);
    for (int n = k0; n < N; n += 2) {
        UM_IDX(min(n + 2, L), eA);
        UM_ISSUE(n + 1, uvB, xB, eB);
        UM_CONSUME(n, uvA, xA);
        UM_IDX(min(n + 3, L), eB);
        if (n + 2 > L) eA = (u32x4){0u, 0u, 0u, 0u};
        UM_ISSUE(min(n + 2, L), uvA, xA, eA);
        UM_CONSUME(n + 1, uvB, xB);
    }
}
__device__ __forceinline__ void phaseW(Ctx& F) {
    const f16_t* DOTP = (const f16_t*)(F.ws + WS_B); const float* GATE = (const float*)(F.ws + WS_GATE); const float* SS2 = (const float*)(F.ws + WS_SS2); unsigned char* W8 = F.ws + WS_WGT;
    const u16* EIDX = (const u16*)(F.ws + WS_E); const float* SU = (const float*)(F.ws + WS_T + 16 * MiB); const float* SV = SU + NEXP;
    for (int tok0 = F.gw; tok0 < M; tok0 += 8 * F.NGW) {
        unsigned dp[8][4], ee[8]; f32x2 gt[8]; float ss[8];
#pragma unroll
        for (int u = 0; u < 8; ++u) {
            const int tok = min(tok0 + u * F.NGW, M - 1);
#pragma unroll
            for (int sl = 0; sl < 4; ++sl) dp[u][sl] = *(const unsigned*)(DOTP + ((size_t)tok * 4 + sl) * NSEL + 2 * F.lane);
            gt[u] = *(const f32x2*)(GATE + (size_t)tok * NSEL + 2 * F.lane);
            ee[u] = *(const unsigned*)(EIDX + (size_t)tok * NSEL + 2 * F.lane);
            ss[u] = SS2[(size_t)tok * 16 + (F.lane & 15)];
        }
        float su0[8], su1[8], sv0[8], sv1[8];
#pragma unroll
        for (int u = 0; u < 8; ++u) { const unsigned e0 = ee[u] & 0xffffu, e1 = ee[u] >> 16; su0[u] = SU[e0]; su1[u] = SU[e1]; sv0[u] = SV[e0]; sv1[u] = SV[e1]; }
#pragma unroll
        for (int u = 0; u < 8; ++u) {
            const int tok = tok0 + u * F.NGW;
            float sq = ss[u];
            sq += __builtin_bit_cast(float, __builtin_amdgcn_update_dpp(0, __builtin_bit_cast(int, sq), 0xB1, 0xf, 0xf, true)); sq += __builtin_bit_cast(float, __builtin_amdgcn_update_dpp(0, __builtin_bit_cast(int, sq), 0x4E, 0xf, 0xf, true));
            sq += __builtin_bit_cast(float, __builtin_amdgcn_update_dpp(0, __builtin_bit_cast(int, sq), 0x141, 0xf, 0xf, true)); sq += __builtin_bit_cast(float, __builtin_amdgcn_update_dpp(0, __builtin_bit_cast(int, sq), 0x140, 0xf, 0xf, true));
            const float r2 = 0.25f * __builtin_amdgcn_rsqf(sq * (1.0f / D) + EPS);
            float d0 = 0.f, d1 = 0.f;
#pragma unroll
            for (int sl = 0; sl < 4; ++sl) { const f16x2 h = as_h2(dp[u][sl]); d0 += (float)h[0]; d1 += (float)h[1]; }
            if (tok < M) {
                const unsigned pk = (unsigned)__builtin_amdgcn_cvt_pk_fp8_f32(128.f * gt[u].x * gelu_tanh(d0 * r2 * su0[u]) * sv0[u], 128.f * gt[u].y * gelu_tanh(d1 * r2 * su1[u]) * sv1[u], 0, false);
                unsigned char* wp = W8 + (size_t)tok * NSEL + 16 * (F.lane & 7) + (F.lane >> 3);
                wp[0] = (unsigned char)(pk & 0xffu); wp[8] = (unsigned char)((pk >> 8) & 0xffu);
            }
        }
    }
}
typedef int v2i_t __attribute__((ext_vector_type(2)));
__device__ __forceinline__ void phaseV(Ctx& F) {
    const unsigned char* V4 = F.ws + WS_T + 8 * MiB; const u16* EIDX = (const u16*)(F.ws + WS_E); const unsigned char* W8 = F.ws + WS_WGT; const f16_t* X1H = (const f16_t*)(F.ws + WS_A); f16_t* X2 = (f16_t*)(F.ws + WS_B);
    const int xl = blockIdx.x & 7, slice = xl & 3, nws = (F.G >> 3) * NWAVES, tok0 = (xl >> 2) * (M / 2) + (blockIdx.x >> 3) * NWAVES + F.wave;
    const int p = F.lane >> 3, c = F.lane & 7;
    const int j = F.lane & 15, kg = F.lane >> 4;
    const unsigned char* vb = V4 + (size_t)slice * (NEXP * 128) + ((c ^ p) * 16);
    const int N = (M / 2 - ((blockIdx.x >> 3) * NWAVES + F.wave) + nws - 1) / nws;
    if (N <= 0) return;
    LAS unsigned char* fifo = F.lds + F.wave * 16384;
    const int ra = 32 * kg + j, rb = ra + 16;
    const LAS unsigned char* pa = fifo + ra * 128; const LAS unsigned char* pb = fifo + rb * 128;
    const int sa = ra & 7, sb = rb & 7;
    const int L = N - 1;
    unsigned* PSQ = (unsigned*)(F.ws + WS_PSQ);
    float psp = 0.f;
    LAS float* psl = (LAS float*)(F.lds + 131072 + 4096 + F.wave * 256);
#define VT_PUBLISH(idx, val) __hip_atomic_store(PSQ + (size_t)(idx), (val), __ATOMIC_RELAXED, __HIP_MEMORY_SCOPE_SYSTEM)
#define VT_IDX(k, EA, EB) do { const u32x4* _ep = (const u32x4*)(EIDX + (size_t)(tok0 + (k) * nws) * NSEL + p * 16); EA = _ep[0]; EB = _ep[1]; } while (0)
#define VT_DMA(EA, EB) do { _Pragma("unroll") for (int _i = 0; _i < 16; ++_i) \
        __builtin_amdgcn_global_load_lds((const unsigned*)(vb + (size_t)e16_of(EA, EB, _i) * 128), (LAS unsigned*)(fifo + 1024 * _i), 16, 0, 0); } while (0)
#define VT_META(k, WA, WB, X) do { const size_t _t = (size_t)(tok0 + (k) * nws); const u32x4* _wp = (const u32x4*)(W8 + _t * NSEL + 16 * kg); WA = _wp[0]; WB = _wp[4]; \
        const f16_t* _xp = X1H + _t * D + slice * 256 + 64 * kg + j; X[0] = *(const u16*)(_xp); X[1] = *(const u16*)(_xp + 16); X[2] = *(const u16*)(_xp + 32); X[3] = *(const u16*)(_xp + 48); } while (0)
    u32x4 e1a, e1b, wa, wb, wna, wnb; unsigned xc[4], xn[4];
    { u32x4 e0a, e0b; VT_IDX(0, e0a, e0b); VT_DMA(e0a, e0b); }
    VT_IDX(min(1, L), e1a, e1b);
    VT_META(0, wa, wb, xc);
#pragma unroll 1
    for (int n = 0; n < N; ++n) {
        asm volatile("s_waitcnt vmcnt(0)" ::: "memory");
        v2i_t ta[16], tb[16];
#pragma unroll
        for (int q = 0; q < 16; ++q) {
            ta[q] = __builtin_amdgcn_ds_read_tr4_b64_v2i32((LAS v2i_t*)(pa + (((q >> 1) ^ sa) << 4) + ((q & 1) << 3)));
            tb[q] = __builtin_amdgcn_ds_read_tr4_b64_v2i32((LAS v2i_t*)(pb + (((q >> 1) ^ sb) << 4) + ((q & 1) << 3)));
        }
        asm volatile("s_waitcnt lgkmcnt(0)" ::: "memory");
        if (n == L) { e1a = (u32x4){0u, 0u, 0u, 0u}; e1b = e1a; }
        VT_DMA(e1a, e1b);
        VT_IDX(min(n + 2, L), e1a, e1b);
        VT_META(min(n + 1, L), wna, wnb, xn);
        i32x8 aw; aw[0] = wa.x; aw[1] = wa.y; aw[2] = wa.z; aw[3] = wa.w; aw[4] = wb.x; aw[5] = wb.y; aw[6] = wb.z; aw[7] = wb.w;
        float yv[4] = {0.f, 0.f, 0.f, 0.f};
#pragma unroll
        for (int q = 0; q < 16; ++q) {
            i32x8 bv; bv[0] = ta[q].x; bv[1] = ta[q].y; bv[2] = tb[q].x; bv[3] = tb[q].y; bv[4] = 0; bv[5] = 0; bv[6] = 0; bv[7] = 0;
            f32x4 z = {0.f, 0.f, 0.f, 0.f};
            z = __builtin_amdgcn_mfma_scale_f32_16x16x128_f8f6f4(aw, bv, z, 0, 4, 0, 0, 0, 0);
            yv[q & 3] = ((q >> 2) == kg) ? z.x : yv[q & 3];
        }
        const size_t t = (size_t)(tok0 + n * nws);
        f16_t* op = X2 + t * D + slice * 256 + 64 * kg + j;
        float ps = 0.f;
#pragma unroll
        for (int m = 0; m < 4; ++m) { const f16_t xh = __builtin_bit_cast(f16_t, (u16)xc[m]); const f16_t x2h = (f16_t)((float)xh + yv[m] * (1.0f / 128.0f)); op[16 * m] = x2h; ps += (float)x2h * (float)x2h; }
        psp = fmaxf(wave_sum_dpp(ps), 1.0e-30f);
        if (F.lane == 0) psl[n & 63] = psp;
        wa = wna; wb = wnb;
#pragma unroll
        for (int m = 0; m < 4; ++m) xc[m] = xn[m];
    }
    asm volatile("s_waitcnt lgkmcnt(0)" ::: "memory");
    for (int n0 = 0; n0 < N; n0 += 64) { const int nn = n0 + F.lane; if (nn < N) VT_PUBLISH((size_t)(tok0 + nn * nws) * 4 + slice, __builtin_bit_cast(unsigned, psl[nn & 63])); }
    asm volatile("s_waitcnt vmcnt(0)" ::: "memory");
    {
        const f32x4 g4 = *(const f32x4*)(F.gf + slice * 256 + 4 * F.lane);
        for (int n0 = 0; n0 < N; n0 += 32) {
            u32x2 xw[32];
#pragma unroll
            for (int u = 0; u < 32; ++u) { const int tk = tok0 + min(n0 + u, L) * nws;
                xw[u] = __builtin_nontemporal_load((const u32x2*)(X2 + (size_t)tk * D + slice * 256 + 4 * F.lane)); }
            const unsigned* pp = PSQ + (size_t)(tok0 + min(n0 + (F.lane & 31), L) * nws) * 4;
            u32x4 pq; unsigned sp = 0u;
            for (;;) {
                asm volatile("global_load_dwordx4 %0, %1, off sc0 sc1\n\ts_waitcnt vmcnt(0)" : "=&v"(pq) : "v"(pp) : "memory");
                const bool ok = pq.x != 0u && pq.y != 0u && pq.z != 0u && pq.w != 0u;
                if (__builtin_amdgcn_ballot_w64(ok) == ~0ull || ++sp > (1u << 20)) break;
                __builtin_amdgcn_s_sleep(8);
            }
#pragma unroll
            for (int u = 0; u < 32; ++u) {
                const int tk = tok0 + min(n0 + u, L) * nws;
                const float qa = __builtin_bit_cast(float, __builtin_amdgcn_readlane((int)pq.x, u)), qb = __builtin_bit_cast(float, __builtin_amdgcn_readlane((int)pq.y, u)),
                            qc = __builtin_bit_cast(float, __builtin_amdgcn_readlane((int)pq.z, u)), qd = __builtin_bit_cast(float, __builtin_amdgcn_readlane((int)pq.w, u));
                const float r3 = __builtin_amdgcn_rsqf(((qa + qb) + (qc + qd)) * (1.0f / D) + EPS);
                const f16x2 p0 = as_h2(xw[u].x), p1 = as_h2(xw[u].y);
                if (n0 + u < N) *(f32x4*)(F.out + (size_t)tk * D + slice * 256 + 4 * F.lane) = (f32x4){(float)p0[0], (float)p0[1], (float)p1[0], (float)p1[1]} * r3 * g4;
            }
        }
    }
#undef VT_PUBLISH
#undef VT_IDX
#undef VT_DMA
#undef VT_META
}

constexpr int NPHASE = 11;
__global__ void __launch_bounds__(NTHR, 2) fwd_kernel(Args args) {
    extern __shared__ __attribute__((aligned(16))) unsigned char lds[];
    Ctx F;
    F.lds = (LAS unsigned char*)lds;
    F.tid = threadIdx.x; F.lane = F.tid & 63; F.wave = __builtin_amdgcn_readfirstlane(F.tid >> 6);
    F.G = gridDim.x; F.gw = blockIdx.x * NWAVES + F.wave; F.NGW = F.G * NWAVES;
    F.x = args.in[0]; F.meta = args.in[1]; F.g1 = args.in[2]; F.w_in = args.in[3]; F.conv_w = args.in[4]; F.w_a = args.in[5]; F.w_b = args.in[6]; F.w_out = args.in[7];
    F.g2 = args.in[8]; F.w_q = args.in[9]; F.subk = args.in[10]; F.pu = args.in[11]; F.pv = args.in[12]; F.gf = args.in[13];
    F.out = args.out; F.ws = args.ws;
    volatile LAS unsigned* MISC = (volatile LAS unsigned*)(F.lds + MISC_OFF);
    if (F.tid < 32) MISC[F.tid] = 0u;
    __syncthreads();
    const int lo = args.ph_lo, hi = args.ph_hi;
    const bool multi = (hi - lo) > 1;
    XcdBarrier bar; bar.bar = (unsigned*)(F.ws + WS_CTL); bar.x = 0; bar.st = nullptr; bar.wave = F.wave;
    if (multi) bar = xcd_barrier_post((unsigned*)(F.ws + WS_CTL), MISC + 8, F.wave);
#define IN(k) (F.lane = lane_id(), F.tid = F.wave * 64 + F.lane, lo <= (k) && (k) < hi)
#define SEAM(k) do { if (IN(k) && IN((k) + 1)) xcd_barrier(bar); } while (0)

    bf16_t* BA = (bf16_t*)(F.ws + WS_B); bf16_t* CU = BA + (size_t)M * CW; bf16_t* Qb = CU + (size_t)M * CW; bf16_t* Kb = (bf16_t*)(F.ws + WS_KU); bf16_t* Vb = (bf16_t*)(F.ws + WS_VT);
    unsigned char* SGA = (unsigned char*)F.out; unsigned char* SGB = SGA + (size_t)M * D;
    bf16_t* MIX = (bf16_t*)(F.ws + WS_B);
    F.reg = 0; F.xcc = 0; F.rank = 0;
    if (IN(0)) { phase0(F); if (DUP_PHASE == 0) { xcd_barrier(bar); phase0(F); } SEAM(0); }
    if (multi && IN(0) && IN(1)) { F.reg = (int)MISC[10]; F.xcc = (int)bar.x; F.rank = (int)MISC[12]; if (F.rank >= 32 || F.xcc >= 8) F.reg = 0; }
    const int vb = F.reg ? F.rank * 8 + F.xcc : (int)blockIdx.x;
#define LSEAM(k) do { if (IN(k) && IN((k) + 1)) { if (F.reg) xcd_local_barrier(bar); else xcd_barrier(bar); } } while (0)
    if (IN(1)) {
        pg8::Gemm g{(const u16*)(F.ws + WS_A), (const u16*)(F.ws + WS_W1T), M, 3072, D, nullptr, nullptr}; pg8::StaticOrder S; S.init(M, 3072, F.G, vb);
        pg8::EpiAdapt<Epi1> E{Epi1{BA, CU, Qb, Kb, Vb}};
        pg8::Gemm g8{(const u16*)(F.ws + WS_X18), (const u16*)(F.ws + WS_WG8), M, 2048, D / 2, nullptr, nullptr}; pg8::StaticOrder S8; S8.init(M, 2048, F.G, vb);
        pg8::EpiAdapt<Epi1g> E8{Epi1g{SGA, SGB}};
        pg8::gemm_phase<pg8::EpiAdapt<Epi1>, pg8::StaticOrder, 0>(F.lds, g, S, E, F.wave);
        pg8::gemm_phase<pg8::EpiAdapt<Epi1g>, pg8::StaticOrder, 2>(F.lds, g8, S8, E8, F.wave);
        if (DUP_PHASE == 1) { xcd_barrier(bar); pg8::gemm_phase<pg8::EpiAdapt<Epi1>, pg8::StaticOrder, 0>(F.lds, g, S, E, F.wave); }
        if (DUP_PHASE == 102) { xcd_barrier(bar); pg8::gemm_phase<pg8::EpiAdapt<Epi1g>, pg8::StaticOrder, 2>(F.lds, g8, S8, E8, F.wave); }
        LSEAM(1);
    }
    if (IN(2)) {
        if (F.NGW == 2048) { float lt[32]; f32x4 lsk; late_load(F, lt, lsk); phase2(F); late_finish(F, lt, lsk); }
        else { if (F.wave & 1) convert_weights_late(F); phase2(F); if (!(F.wave & 1)) convert_weights_late(F); } if (DUP_PHASE == 2) { xcd_barrier(bar); phase2(F); } SEAM(2); }
    if (IN(3)) {
        pg8::PairOrder S; S.S.init(M, D, F.G, vb);
        pg8::Gemm g{(const u16*)(F.ws + WS_A + (size_t)M * CW * 2), (const u16*)(F.ws + WS_WAT), M, D, CW, (const u16*)(F.ws + WS_A), (const u16*)(F.ws + WS_WBT)};
        pg8::EpiAdapt<Epi3a> E{Epi3a{MIX, SGA, SGB}};
        pg8::gemm_phase<pg8::EpiAdapt<Epi3a>, pg8::PairOrder, 0>(F.lds, g, S, E, F.wave);
        if (DUP_PHASE == 3) { xcd_barrier(bar); pg8::gemm_phase<pg8::EpiAdapt<Epi3a>, pg8::PairOrder, 0>(F.lds, g, S, E, F.wave); }
        LSEAM(3);
    }
    if (IN(4)) {
        pg8::Gemm g{(const u16*)MIX, (const u16*)(F.ws + WS_WOT), M, D, D, nullptr, nullptr}; pg8::StaticOrder S; S.init(M, D, F.G, vb);
        pg8::EpiAdapt<Epi3b> E{Epi3b{F.x, (f16_t*)(F.ws + WS_A), (float*)(F.ws + WS_SS2), F.ws + WS_X18}};
        pg8::gemm_phase<pg8::EpiAdapt<Epi3b>, pg8::StaticOrder, 0>(F.lds, g, S, E, F.wave);
        if (DUP_PHASE == 4) { xcd_barrier(bar); pg8::gemm_phase<pg8::EpiAdapt<Epi3b>, pg8::StaticOrder, 0>(F.lds, g, S, E, F.wave); }
        LSEAM(4);
    }
    if (IN(5)) {
        pg8::Gemm g{(const u16*)(F.ws + WS_A), (const u16*)(F.ws + WS_WQT), M, 2048, D, nullptr, nullptr}; pg8::StaticOrder S; S.init(M, 2048, F.G, vb);
        pg8::EpiAdapt<Epi4> E{Epi4{(f16_t*)(F.ws + WS_B)}};
        pg8::gemm_phase<pg8::EpiAdapt<Epi4>, pg8::StaticOrder, 1>(F.lds, g, S, E, F.wave);
        if (DUP_PHASE == 5) { xcd_barrier(bar); pg8::gemm_phase<pg8::EpiAdapt<Epi4>, pg8::StaticOrder, 1>(F.lds, g, S, E, F.wave); }
        LSEAM(5);
    }
    if (IN(6)) { phase5_stage(F);
        if (F.wave & 1) convert_tables(F); phase5<false>(F); if (!(F.wave & 1)) convert_tables(F); if (DUP_PHASE == 66) { xcd_barrier(bar); convert_tables(F); } if (DUP_PHASE == 6) { xcd_barrier(bar); phase5<false>(F); } SEAM(6); }
    if (IN(7)) { phaseU(F); if (DUP_PHASE == 7) { xcd_barrier(bar); phaseU(F); } SEAM(7); }
    if (IN(8)) { phaseW(F); if (DUP_PHASE == 8) { xcd_barrier(bar); phaseW(F); } SEAM(8); }
    if (IN(9)) { phaseV(F); }
    if (DUP_PHASE == 200) { for (int q = 0; q < 10; ++q) xcd_barrier(bar); }
#undef IN
#undef SEAM
#undef LSEAM
}

extern "C" void kernel_launch(void* const* d_in, const int* in_sizes, int n_in, void* d_out, int out_size, void* d_ws, size_t ws_size, hipStream_t stream) {
    static int grid = 0;
    if (grid == 0) {
        if (n_in != 14 || out_size != M * D || ws_size < WS_END) { fprintf(stderr, "kernel_launch: unexpected shapes (n_in %d out %d ws %zu)\n", n_in, out_size, ws_size); grid = -1; return; }
        int dev = 0, cus = 0, per_cu = 0;
        if (hipGetDevice(&dev) != hipSuccess || hipDeviceGetAttribute(&cus, hipDeviceAttributeMultiprocessorCount, dev) != hipSuccess) { grid = -1; return; }
        if (hipFuncSetAttribute((const void*)fwd_kernel, hipFuncAttributeMaxDynamicSharedMemorySize, LDS_BYTES) != hipSuccess) { fprintf(stderr, "kernel_launch: hipFuncSetAttribute failed\n"); grid = -1; return; }
        if (hipOccupancyMaxActiveBlocksPerMultiprocessor(&per_cu, (const void*)fwd_kernel, NTHR, LDS_BYTES) != hipSuccess || per_cu < 1) { fprintf(stderr, "kernel_launch: occupancy query says %d\n", per_cu); (void)hipGetLastError(); per_cu = 1; }
        grid = cus;
    }
    if (grid < 0) return;
    (void)hipMemsetAsync((char*)d_ws + WS_CTL, 0, CTL_ZERO_BYTES, stream);
    Args a{};
    for (int i = 0; i < 14; ++i) a.in[i] = (const float*)d_in[i];
    a.out = (float*)d_out; a.ws = (unsigned char*)d_ws;
#if MK_N_LAUNCHES == 1
    a.ph_lo = 0; a.ph_hi = NPHASE;
    hipLaunchKernelGGL(fwd_kernel, dim3(grid), dim3(NTHR), LDS_BYTES, stream, a);
#else
    for (int p = 0; p < NPHASE; ++p) { a.ph_lo = p; a.ph_hi = p + 1; hipLaunchKernelGGL(fwd_kernel, dim3(grid), dim3(NTHR), LDS_BYTES, stream, a); }
#endif
}
```
